# Optimizing an MI355X kernel written in HIP

```python
import math
import jax
import jax.numpy as jnp
from jax import lax
import numpy as np

D_MODEL = 1024
BATCH = 16
SEQ = 2048
DEPTH = 2
DEC_BATCH = 1
DEC_SEQ = 16384
PAST_LEN = 128

GRID_W = 64
N_MIXERS = 2
N_RET_LAYERS = (DEPTH + 1) // 2
N_NA_LAYERS = DEPTH // 2
RET_HEADS = 4
RET_DK = 256
RET_DV = 512
RET_QK_W = RET_HEADS * RET_DK
RET_V_W = RET_HEADS * RET_DV
RET_CHUNK = 128
ROPE_BASE = 10000.0
NA_HEADS = 32
NA_HD = D_MODEL // NA_HEADS
NA_KH = 8
NA_KW = 16
N_EXPERTS = 16
EXPERT_FF = 1024
CAPACITY_FACTOR = 2
DN_ALPHA = (2 * DEPTH) ** 0.25
DN_BETA = (8 * DEPTH) ** -0.25
LN_EPS = 1e-5
GN_EPS = 1e-6

kernel_name = "hybrid_retention_natten_ecmoe_encoder"


def layer_norm(x, g, b):
    xf = x.astype(jnp.float32)
    mu = jnp.mean(xf, axis=-1, keepdims=True)
    var = jnp.mean(jnp.square(xf - mu), axis=-1, keepdims=True)
    y = (xf - mu) * lax.rsqrt(var + LN_EPS)
    return (y * g.astype(jnp.float32) + b.astype(jnp.float32)).astype(x.dtype)


def head_group_norm(y):
    yf = y.astype(jnp.float32)
    mu = jnp.mean(yf, axis=-1, keepdims=True)
    var = jnp.mean(jnp.square(yf - mu), axis=-1, keepdims=True)
    return ((yf - mu) * lax.rsqrt(var + GN_EPS)).astype(y.dtype)


def rotary_tables(S, dim):
    inv = 1.0 / (ROPE_BASE ** (jnp.arange(0, dim, 2, dtype=jnp.float32) / dim))
    ang = jnp.arange(S, dtype=jnp.float32)[:, None] * inv[None, :]
    return jnp.cos(ang), jnp.sin(ang)


def apply_rotary(x, cos, sin):
    half = x.shape[-1] // 2
    x1, x2 = x[..., :half], x[..., half:]
    c = cos[None, :, None, :].astype(x.dtype)
    s = sin[None, :, None, :].astype(x.dtype)
    return jnp.concatenate([x1 * c - x2 * s, x1 * s + x2 * c], axis=-1)


def chunk_retention(q, k, v, log_g, inclusive):
    B, S, H, DK = q.shape
    DV = v.shape[-1]
    C = RET_CHUNK
    NC = S // C
    dt = q.dtype
    i = jnp.arange(C, dtype=jnp.float32)
    diff = i[:, None] - i[None, :]
    mask = (diff >= 0) if inclusive else (diff > 0)
    dmask = jnp.where(mask[None], jnp.exp(log_g[:, None, None] * jnp.maximum(diff, 0.0)[None]), 0.0).astype(dt)
    cross_decay = jnp.exp(log_g[None, :] * (i[:, None] + 1.0)).astype(dt)
    state_decay = jnp.exp(log_g[None, :] * (C - 1.0 - i[:, None])).astype(dt)
    chunk_decay = jnp.exp(log_g * C).astype(dt)

    def to_chunks(a):
        return a.reshape(B, NC, C, H, a.shape[-1]).transpose(1, 0, 2, 3, 4)

    def step(R, inp):
        qc, kc, vc = inp
        scores = jnp.einsum('bihd,bjhd->bhij', qc, kc) * dmask[None]
        o = jnp.einsum('bhij,bjhe->bihe', scores, vc)
        o = o + jnp.einsum('bihd,bhde->bihe', qc, R) * cross_decay[None, :, :, None]
        R = R * chunk_decay[None, :, None, None] + jnp.einsum(
            'bjhd,bjhe->bhde', kc * state_decay[None, :, :, None], vc)
        return R, o

    R0 = jnp.zeros((B, H, DK, DV), dt)
    _, o = lax.scan(step, R0, (to_chunks(q), to_chunks(k), to_chunks(v)))
    return o.transpose(1, 0, 2, 3, 4).reshape(B, S, H, DV)


def retention(x, w_in, decay_logit, w_out):
    B, S, _ = x.shape
    proj = x @ w_in
    q, k, v, g = jnp.split(proj, [RET_QK_W, 2 * RET_QK_W, 2 * RET_QK_W + RET_V_W], axis=-1)
    q = q.reshape(B, S, RET_HEADS, RET_DK)
    k = k.reshape(B, S, RET_HEADS, RET_DK) * (RET_DK ** -0.5)
    v = v.reshape(B, S, RET_HEADS, RET_DV)
    cos, sin = rotary_tables(S, RET_DK)
    q = apply_rotary(q, cos, sin)
    k = apply_rotary(k, cos, sin)
    log_g = jax.nn.log_sigmoid(decay_logit.astype(jnp.float32))
    y_fwd = chunk_retention(q, k, v, log_g[0], True)
    y_bwd = jnp.flip(chunk_retention(jnp.flip(q, 1), jnp.flip(k, 1), jnp.flip(v, 1), log_g[1], False), 1)
    y = head_group_norm(y_fwd + y_bwd).reshape(B, S, RET_V_W)
    return (jax.nn.silu(g) * y) @ w_out


def neighbourhood_attention(x, w_in, rpb, w_out):
    B, S, D = x.shape
    rows = S // GRID_W
    kh = min(NA_KH, rows)
    qkv = (x @ w_in).reshape(B, rows, GRID_W, 3, NA_HEADS, NA_HD)
    q = qkv[:, :, :, 0] * (NA_HD ** -0.5)
    k = qkv[:, :, :, 1]
    v = qkv[:, :, :, 2]
    cols = jnp.arange(GRID_W)
    col_start = jnp.clip(cols - NA_KW // 2, 0, GRID_W - NA_KW)
    col_idx = col_start[:, None] + jnp.arange(NA_KW)[None, :]
    col_off = col_idx - cols[:, None] + (NA_KW - 1)
    bias_cols = rpb[:, :, col_off]

    def row_block(r):
        rs = jnp.clip(r - kh // 2, 0, rows - kh)
        k_rows = lax.dynamic_slice_in_dim(k, rs, kh, axis=1)
        v_rows = lax.dynamic_slice_in_dim(v, rs, kh, axis=1)
        k_g = k_rows[:, :, col_idx]
        v_g = v_rows[:, :, col_idx]
        q_r = lax.dynamic_index_in_dim(q, r, axis=1, keepdims=False)
        row_off = rs + jnp.arange(kh) - r + (NA_KH - 1)
        bias = bias_cols[:, row_off].transpose(0, 2, 1, 3)
        s = jnp.einsum('bwhd,bawkhd->bhwak', q_r, k_g) + bias[None].astype(q_r.dtype)
        p = jax.nn.softmax(s.reshape(B, NA_HEADS, GRID_W, kh * NA_KW).astype(jnp.float32), axis=-1)
        p = p.astype(v_g.dtype).reshape(B, NA_HEADS, GRID_W, kh, NA_KW)
        return jnp.einsum('bhwak,bawkhd->bwhd', p, v_g)

    o = lax.map(row_block, jnp.arange(rows))
    o = o.transpose(1, 0, 2, 3, 4).reshape(B, S, D)
    return o @ w_out


def expert_choice_ffn(x, w_router, w_gate, w_up, w_down):
    B, S, D = x.shape
    T = B * S
    cap = CAPACITY_FACTOR * T // N_EXPERTS
    xt = x.reshape(T, D)
    aff = jax.nn.softmax((xt @ w_router).astype(jnp.float32), axis=-1)
    gates, idx = lax.top_k(aff.T, cap)
    xe = xt[idx]
    h = jax.nn.silu(jnp.einsum('ecd,edf->ecf', xe, w_gate)) * jnp.einsum('ecd,edf->ecf', xe, w_up)
    ye = jnp.einsum('ecf,efd->ecd', h, w_down) * gates[..., None].astype(x.dtype)
    y = jnp.zeros((T, D), x.dtype).at[idx.reshape(-1)].add(ye.reshape(-1, D))
    return y.reshape(B, S, D)


def trunk(x, ret_w_in, ret_decay, ret_w_out, na_w_in, na_rpb, na_w_out,
          ln_mix_g, ln_mix_b, ln_ffn_g, ln_ffn_b, w_router, w_gate, w_up, w_down):
    for i in range(DEPTH):
        j = i // N_MIXERS
        if i % N_MIXERS == 0:
            h = retention(x, ret_w_in[j], ret_decay[j], ret_w_out[j])
        else:
            h = neighbourhood_attention(x, na_w_in[j], na_rpb[j], na_w_out[j])
        x = layer_norm(DN_ALPHA * x + h, ln_mix_g[i], ln_mix_b[i])
        f = expert_choice_ffn(x, w_router[i], w_gate[i], w_up[i], w_down[i])
        x = layer_norm(DN_ALPHA * x + f, ln_ffn_g[i], ln_ffn_b[i])
    return x


def _xavier(key, shape, fan_in, fan_out, scale=1.0):
    std = scale * math.sqrt(2.0 / (fan_in + fan_out))
    return jax.random.normal(key, shape, jnp.float32) * std


def setup_inputs(seed: int = 0) -> dict:
    key = jax.random.key(seed)
    ks = jax.random.split(key, 24)
    D = D_MODEL
    x_prompt = jax.random.normal(ks[0], (BATCH, SEQ, D), jnp.float32)
    x_sample = jax.random.normal(ks[1], (DEC_BATCH, DEC_SEQ, D), jnp.float32)
    r_q = jax.random.normal(ks[2], (N_RET_LAYERS, D, RET_QK_W), jnp.float32) * D ** -0.5
    r_k = jax.random.normal(ks[3], (N_RET_LAYERS, D, RET_QK_W), jnp.float32) * D ** -0.5
    r_v = _xavier(ks[4], (N_RET_LAYERS, D, RET_V_W), D, RET_V_W, DN_BETA)
    r_g = jax.random.normal(ks[5], (N_RET_LAYERS, D, RET_V_W), jnp.float32) * D ** -0.5
    ret_w_in = jnp.concatenate([r_q, r_k, r_v, r_g], axis=-1)
    g0 = 1.0 - 2.0 ** (-5.0 - np.arange(RET_HEADS))
    base_logit = jnp.asarray(np.log(g0 / (1.0 - g0)), jnp.float32)
    ret_decay = base_logit[None, None, :] + 0.1 * jax.random.normal(ks[6], (N_RET_LAYERS, 2, RET_HEADS), jnp.float32)
    ret_w_out = _xavier(ks[7], (N_RET_LAYERS, RET_V_W, D), RET_V_W, D, DN_BETA)
    n_qk = jax.random.normal(ks[8], (N_NA_LAYERS, D, 2 * D), jnp.float32) * D ** -0.5
    n_v = _xavier(ks[9], (N_NA_LAYERS, D, D), D, D, DN_BETA)
    na_w_in = jnp.concatenate([n_qk, n_v], axis=-1)
    na_rpb = 0.1 * jax.random.normal(ks[10], (N_NA_LAYERS, NA_HEADS, 2 * NA_KH - 1, 2 * NA_KW - 1), jnp.float32)
    na_w_out = _xavier(ks[11], (N_NA_LAYERS, D, D), D, D, DN_BETA)
    ln_mix_g = 1.0 + 0.02 * jax.random.normal(ks[12], (DEPTH, D), jnp.float32)
    ln_mix_b = 0.02 * jax.random.normal(ks[13], (DEPTH, D), jnp.float32)
    ln_ffn_g = 1.0 + 0.02 * jax.random.normal(ks[14], (DEPTH, D), jnp.float32)
    ln_ffn_b = 0.02 * jax.random.normal(ks[15], (DEPTH, D), jnp.float32)
    w_router = jax.random.normal(ks[16], (DEPTH, D, N_EXPERTS), jnp.float32) * D ** -0.5
    w_gate = _xavier(ks[17], (DEPTH, N_EXPERTS, D, EXPERT_FF), D, EXPERT_FF, DN_BETA)
    w_up = _xavier(ks[18], (DEPTH, N_EXPERTS, D, EXPERT_FF), D, EXPERT_FF, DN_BETA)
    w_down = _xavier(ks[19], (DEPTH, N_EXPERTS, EXPERT_FF, D), EXPERT_FF, D, DN_BETA)
    return {"x_prompt": x_prompt, "x_sample": x_sample,
            "ret_w_in": ret_w_in, "ret_decay": ret_decay, "ret_w_out": ret_w_out,
            "na_w_in": na_w_in, "na_rpb": na_rpb, "na_w_out": na_w_out,
            "ln_mix_g": ln_mix_g, "ln_mix_b": ln_mix_b, "ln_ffn_g": ln_ffn_g, "ln_ffn_b": ln_ffn_b,
            "w_router": w_router, "w_gate": w_gate, "w_up": w_up, "w_down": w_down}


def reference(x_prompt, x_sample, ret_w_in, ret_decay, ret_w_out, na_w_in, na_rpb, na_w_out,
              ln_mix_g, ln_mix_b, ln_ffn_g, ln_ffn_b, w_router, w_gate, w_up, w_down):
    y_prompt = trunk(x_prompt, ret_w_in, ret_decay, ret_w_out, na_w_in, na_rpb, na_w_out,
                     ln_mix_g, ln_mix_b, ln_ffn_g, ln_ffn_b, w_router, w_gate, w_up, w_down)
    y_sample = trunk(x_sample, ret_w_in, ret_decay, ret_w_out, na_w_in, na_rpb, na_w_out,
                     ln_mix_g, ln_mix_b, ln_ffn_g, ln_ffn_b, w_router, w_gate, w_up, w_down)
    return (y_prompt, y_sample)
```

```cpp
#include <hip/hip_runtime.h>
#include <hip/hip_cooperative_groups.h>
#include <cstdio>
namespace cg = cooperative_groups;

typedef unsigned short bf16_t;
typedef short bf16x8 __attribute__((ext_vector_type(8)));
typedef float f32x16 __attribute__((ext_vector_type(16)));
typedef float f32x4 __attribute__((ext_vector_type(4)));
typedef unsigned long long u64;

constexpr int D = 1024;
constexpr int T_ALL = 49152;
constexpr int T_PROMPT = 32768;
constexpr int T3 = 16384;
constexpr float ALPHA = 1.41421356237309515f;
constexpr float LN_EPS = 1e-5f, GN_EPS = 1e-6f;
constexpr int CAP_P = 4096, CAP_S = 2048;

constexpr size_t R_WIN = 0;
constexpr size_t R_WOUT = R_WIN + 6144ull * 1024 * 2;
constexpr size_t R_ROT = R_WOUT + 1024ull * 2048 * 2;
constexpr size_t R_Q = R_ROT + 16384ull * 128 * 8;
constexpr size_t R_K = R_Q + (size_t)T3 * 1024 * 2;
constexpr size_t R_KT = R_K + (size_t)T3 * 1024 * 2;
constexpr size_t R_VT = R_KT + (size_t)T3 * 1024 * 2;
constexpr size_t R_G = R_VT + (size_t)T3 * 2048 * 2;
constexpr size_t R_P = R_G + (size_t)T3 * 2048 * 2;
constexpr size_t R_UR = R_P + 128ull * 4 * 128 * 128 * 2;
constexpr size_t R_O = R_UR + 2ull * 128 * 4 * 512 * 256 * 2;
constexpr size_t R_END = R_O + (size_t)T3 * 2048 * 2;
constexpr size_t UNIT = (size_t)T_ALL * 1024 * 2;
constexpr size_t M_XB = 0;
constexpr size_t M_XB2 = 2 * UNIT;
constexpr size_t M_YE = 0;
constexpr size_t M_H = 2 * UNIT;
constexpr size_t M_WGU = M_H + 2ull * T_ALL * 1024 * 2;
constexpr size_t M_WD = M_WGU + 16ull * 2048 * 1024 * 2;
constexpr size_t M_AFF = M_WD + 16ull * 1024 * 1024 * 2;
constexpr size_t M_IDX = M_AFF + (size_t)T_ALL * 16 * 4;
constexpr size_t M_GATE = M_IDX + 2ull * T_ALL * 4;
constexpr size_t M_POS = M_GATE + 2ull * T_ALL * 4;
constexpr size_t M_NWIN = M_POS + (size_t)T_ALL * 16 * 4;
constexpr size_t M_NWOUT = M_NWIN + 3072ull * 1024 * 2;
constexpr size_t M_END = M_NWOUT + 1024ull * 1024 * 2;
constexpr size_t N_Q = 3 * UNIT;
constexpr size_t N_K = 0;
constexpr size_t N_VT = UNIT;

struct Params {
    const float *x_prompt, *x_sample, *ret_w_in, *ret_decay, *ret_w_out, *na_w_in, *na_rpb, *na_w_out;
    const float *ln_mix_g, *ln_mix_b, *ln_ffn_g, *ln_ffn_b, *w_router, *w_gate, *w_up, *w_down;
    float* out;
    char* ws;
    int ph_lo, ph_hi;
};

typedef __bf16 bf16x2_t __attribute__((ext_vector_type(2)));
typedef float f32x2_t __attribute__((ext_vector_type(2)));
__device__ __forceinline__ unsigned pk_bf16(float lo, float hi) {
    f32x2_t v = {lo, hi};
    bf16x2_t b = __builtin_convertvector(v, bf16x2_t);
    return __builtin_bit_cast(unsigned, b);
}
__device__ __forceinline__ bf16_t f2bf(float f) { return (bf16_t)(pk_bf16(f, 0.f) & 0xffffu); }
__device__ __forceinline__ float bf_lo(unsigned u) { return __uint_as_float(u << 16); }
__device__ __forceinline__ float bf_hi(unsigned u) { return __uint_as_float(u & 0xffff0000u); }
__device__ __forceinline__ float silu_f(float g) { return g / (1.f + __expf(-g)); }
__device__ __forceinline__ float wave_sum(float v) {
#pragma unroll
    for (int o = 32; o > 0; o >>= 1) v += __shfl_xor(v, o, 64);
    return v;
}
__device__ __forceinline__ uint4 scale8(uint4 v, float s) {
    uint4 r;
    r.x = pk_bf16(bf_lo(v.x) * s, bf_hi(v.x) * s);
    r.y = pk_bf16(bf_lo(v.y) * s, bf_hi(v.y) * s);
    r.z = pk_bf16(bf_lo(v.z) * s, bf_hi(v.z) * s);
    r.w = pk_bf16(bf_lo(v.w) * s, bf_hi(v.w) * s);
    return r;
}
__device__ __forceinline__ float log2_sigmoid(float x) { return -log1pf(expf(-x)) * 1.44269504088896341f; }

__device__ __forceinline__ int lds_off(int row, int c8) { return row * 128 + ((c8 ^ ((row >> 1) & 7)) << 4); }

template <bool SWAP> __device__ __forceinline__ int epi_m(int wm, int mi, int r, int lane) {
    return SWAP ? (wm * 64 + mi * 32 + (lane & 31)) : (wm * 64 + mi * 32 + 8 * (r >> 2) + 4 * (lane >> 5) + (r & 3));
}
template <bool SWAP> __device__ __forceinline__ int epi_n(int wn, int ni, int r, int lane) {
    return SWAP ? (wn * 64 + ni * 32 + 8 * (r >> 2) + 4 * (lane >> 5) + (r & 3)) : (wn * 64 + ni * 32 + (lane & 31));
}

template <class P, bool SWAP>
__device__ __forceinline__ void gemm_core(P& p, char* smem, int nk, const int TID) {
    const int tid = TID, lane = tid & 63, w = tid >> 6, wm = w >> 1, wn = w & 1;
    const int c8 = tid & 7, r0 = tid >> 3;
    f32x16 acc[2][2];
#pragma unroll
    for (int i = 0; i < 2; ++i)
#pragma unroll
        for (int j = 0; j < 2; ++j)
#pragma unroll
            for (int r = 0; r < 16; ++r) acc[i][j][r] = 0.f;
    uint4 va[4], vb[4];
#pragma unroll
    for (int i = 0; i < 4; ++i) { va[i] = p.ldA(r0 + 32 * i, 0, c8); vb[i] = p.ldB(r0 + 32 * i, 0, c8); }
#pragma unroll
    for (int i = 0; i < 4; ++i) {
        *(uint4*)(smem + lds_off(r0 + 32 * i, c8)) = va[i];
        *(uint4*)(smem + 16384 + lds_off(r0 + 32 * i, c8)) = vb[i];
    }
    __syncthreads();
    for (int kt = 0; kt < nk; ++kt) {
        char* cur = smem + (kt & 1) * 32768;
        char* nxt = smem + ((kt + 1) & 1) * 32768;
        const bool more = (kt + 1 < nk);
        if (more) {
#pragma unroll
            for (int i = 0; i < 4; ++i) { va[i] = p.ldA(r0 + 32 * i, kt + 1, c8); vb[i] = p.ldB(r0 + 32 * i, kt + 1, c8); }
        }
        p.pre(kt, acc, wm, wn, lane);
#pragma unroll
        for (int ks = 0; ks < 4; ++ks) {
            bf16x8 a[2], b[2];
#pragma unroll
            for (int mi = 0; mi < 2; ++mi) a[mi] = *(const bf16x8*)(cur + lds_off(wm * 64 + mi * 32 + (lane & 31), ks * 2 + (lane >> 5)));
#pragma unroll
            for (int ni = 0; ni < 2; ++ni) b[ni] = *(const bf16x8*)(cur + 16384 + lds_off(wn * 64 + ni * 32 + (lane & 31), ks * 2 + (lane >> 5)));
#pragma unroll
            for (int mi = 0; mi < 2; ++mi)
#pragma unroll
                for (int ni = 0; ni < 2; ++ni) {
                    if (SWAP) acc[mi][ni] = __builtin_amdgcn_mfma_f32_32x32x16_bf16(b[ni], a[mi], acc[mi][ni], 0, 0, 0);
                    else      acc[mi][ni] = __builtin_amdgcn_mfma_f32_32x32x16_bf16(a[mi], b[ni], acc[mi][ni], 0, 0, 0);
                }
        }
        if (more) {
#pragma unroll
            for (int i = 0; i < 4; ++i) {
                *(uint4*)(nxt + lds_off(r0 + 32 * i, c8)) = va[i];
                *(uint4*)(nxt + 16384 + lds_off(r0 + 32 * i, c8)) = vb[i];
            }
        }
        __syncthreads();
    }
    p.epi(acc, wm, wn, lane);
}

struct NoPre { __device__ __forceinline__ void pre(int, f32x16 (&)[2][2], int, int, int) {} };

template <bool SWAP> struct PolProj : NoPre {
    const float* xA; const bf16_t* Bt; char* ws; int m0, n0, smask;
    __device__ __forceinline__ uint4 ldA(int row, int kt, int c8) const {
        const float4* s = (const float4*)(xA + (size_t)(m0 + row) * 1024 + kt * 64 + c8 * 8);
        float4 a = s[0], b = s[1];
        return make_uint4(pk_bf16(a.x, a.y), pk_bf16(a.z, a.w), pk_bf16(b.x, b.y), pk_bf16(b.z, b.w));
    }
    __device__ __forceinline__ uint4 ldB(int row, int kt, int c8) const { return *(const uint4*)(Bt + (size_t)(n0 + row) * 1024 + kt * 64 + c8 * 8); }
    __device__ __forceinline__ void epi(f32x16 (&acc)[2][2], int wm, int wn, int lane) const {
        const int sec = n0 >> 10;
        bf16_t* Qb = (bf16_t*)(ws + R_Q); bf16_t* Kb = (bf16_t*)(ws + R_K); bf16_t* Ktb = (bf16_t*)(ws + R_KT);
        bf16_t* Vtb = (bf16_t*)(ws + R_VT); bf16_t* Gb = (bf16_t*)(ws + R_G);
        const float2* rot = (const float2*)(ws + R_ROT);
        if (sec == 0) {
            const int cb = (n0 & 1023) + wn * 64;
            const int ib = ((cb & 255) >> 6) * 32;
#pragma unroll
            for (int mi = 0; mi < 2; ++mi) {
                const int tok = m0 + epi_m<true>(wm, mi, 0, lane);
                const float2* rr = rot + (size_t)(tok & smask) * 128 + ib;
#pragma unroll
                for (int g = 0; g < 4; ++g) {
                    const int j0 = 8 * g + 4 * (lane >> 5);
                    float o1[4], o2[4];
#pragma unroll
                    for (int e = 0; e < 4; ++e) {
                        float2 cs = rr[j0 + e];
                        float x1 = acc[mi][0][g * 4 + e], x2 = acc[mi][1][g * 4 + e];
                        o1[e] = x1 * cs.x - x2 * cs.y; o2[e] = x1 * cs.y + x2 * cs.x;
                    }
                    bf16_t* dst = Qb + (size_t)tok * 1024 + cb + j0;
                    *(uint2*)dst = make_uint2(pk_bf16(o1[0], o1[1]), pk_bf16(o1[2], o1[3]));
                    *(uint2*)(dst + 32) = make_uint2(pk_bf16(o2[0], o2[1]), pk_bf16(o2[2], o2[3]));
                }
            }
        } else if (sec == 1) {
            const int cb = (n0 & 1023) + wn * 64;
            const int ib = ((cb & 255) >> 6) * 32 + (lane & 31);
            const int c1 = cb + (lane & 31);
#pragma unroll
            for (int mi = 0; mi < 2; ++mi)
#pragma unroll
                for (int g = 0; g < 4; ++g) {
                    const int tok0 = m0 + wm * 64 + mi * 32 + 8 * g + 4 * (lane >> 5);
                    float o1[4], o2[4];
#pragma unroll
                    for (int e = 0; e < 4; ++e) {
                        float2 cs = rot[(size_t)((tok0 + e) & smask) * 128 + ib];
                        float x1 = acc[mi][0][g * 4 + e], x2 = acc[mi][1][g * 4 + e];
                        o1[e] = x1 * cs.x - x2 * cs.y; o2[e] = x1 * cs.y + x2 * cs.x;
                        Kb[(size_t)(tok0 + e) * 1024 + c1] = f2bf(o1[e]);
                        Kb[(size_t)(tok0 + e) * 1024 + c1 + 32] = f2bf(o2[e]);
                    }
                    *(uint2*)(Ktb + (size_t)c1 * T3 + tok0) = make_uint2(pk_bf16(o1[0], o1[1]), pk_bf16(o1[2], o1[3]));
                    *(uint2*)(Ktb + (size_t)(c1 + 32) * T3 + tok0) = make_uint2(pk_bf16(o2[0], o2[1]), pk_bf16(o2[2], o2[3]));
                }
        } else if (sec < 4) {
#pragma unroll
            for (int mi = 0; mi < 2; ++mi)
#pragma unroll
                for (int ni = 0; ni < 2; ++ni) {
                    const int col = n0 - 2048 + wn * 64 + ni * 32 + (lane & 31);
#pragma unroll
                    for (int g = 0; g < 4; ++g) {
                        const int tok0 = m0 + wm * 64 + mi * 32 + 8 * g + 4 * (lane >> 5);
                        *(uint2*)(Vtb + (size_t)col * T3 + tok0) =
                            make_uint2(pk_bf16(acc[mi][ni][g * 4 + 0], acc[mi][ni][g * 4 + 1]), pk_bf16(acc[mi][ni][g * 4 + 2], acc[mi][ni][g * 4 + 3]));
                    }
                }
        } else {
#pragma unroll
            for (int mi = 0; mi < 2; ++mi) {
                const int tok = m0 + epi_m<true>(wm, mi, 0, lane);
#pragma unroll
                for (int ni = 0; ni < 2; ++ni)
#pragma unroll
                    for (int g = 0; g < 4; ++g) {
                        const int col = n0 - 4096 + wn * 64 + ni * 32 + 8 * g + 4 * (lane >> 5);
                        *(uint2*)(Gb + (size_t)tok * 2048 + col) =
                            make_uint2(pk_bf16(acc[mi][ni][g * 4 + 0], acc[mi][ni][g * 4 + 1]), pk_bf16(acc[mi][ni][g * 4 + 2], acc[mi][ni][g * 4 + 3]));
                    }
            }
        }
    }
};

struct PolScore : NoPre {
    const bf16_t *A, *B; bf16_t* P; float lgf, lgb; char* smem;
    __device__ __forceinline__ uint4 ldA(int row, int kt, int c8) const { return *(const uint4*)(A + (size_t)row * 1024 + kt * 64 + c8 * 8); }
    __device__ __forceinline__ uint4 ldB(int row, int kt, int c8) const { return *(const uint4*)(B + (size_t)row * 1024 + kt * 64 + c8 * 8); }
    __device__ __forceinline__ void epi(f32x16 (&acc)[2][2], int wm, int wn, int lane) const {
        float* tab = (float*)smem;
        const int tid = (wm * 2 + wn) * 64 + lane;
        if (tid < 255) { const int d = tid - 127; tab[tid] = (d >= 0) ? exp2f(lgf * (float)d) : exp2f(lgb * (float)(-d)); }
        __syncthreads();
#pragma unroll
        for (int mi = 0; mi < 2; ++mi) {
            const int i = epi_m<true>(wm, mi, 0, lane);
#pragma unroll
            for (int ni = 0; ni < 2; ++ni)
#pragma unroll
                for (int g = 0; g < 4; ++g) {
                    const int j0 = wn * 64 + ni * 32 + 8 * g + 4 * (lane >> 5);
                    const float* tp = tab + (i - j0 + 127);
                    const float v0 = acc[mi][ni][g * 4 + 0] * tp[0], v1 = acc[mi][ni][g * 4 + 1] * tp[-1];
                    const float v2 = acc[mi][ni][g * 4 + 2] * tp[-2], v3 = acc[mi][ni][g * 4 + 3] * tp[-3];
                    *(uint2*)(P + (size_t)i * 128 + j0) = make_uint2(pk_bf16(v0, v1), pk_bf16(v2, v3));
                }
        }
        __syncthreads();
    }
};

struct PolUscan {
    const bf16_t *A, *B;
    bf16_t* UR;
    int nc, dir; float lg, dec, st, st2;
    __device__ __forceinline__ int col0(int kt) const { const int ci = kt >> 1; const int ch = dir ? (nc - 1 - ci) : ci; return ch * 128 + (kt & 1) * 64; }
    __device__ __forceinline__ uint4 ldA(int row, int kt, int c8) const { return *(const uint4*)(A + (size_t)row * T3 + col0(kt) + c8 * 8); }
    __device__ __forceinline__ uint4 ldB(int row, int kt, int c8) const {
        uint4 v = *(const uint4*)(B + (size_t)row * T3 + col0(kt) + c8 * 8);
        const int j0 = (kt & 1) * 64 + c8 * 8;
        float w0 = exp2f(lg * (float)(dir ? j0 : (127 - j0)));
        float w1 = w0 * st;
        uint4 r;
        r.x = pk_bf16(bf_lo(v.x) * w0, bf_hi(v.x) * w1); w0 *= st2; w1 *= st2;
        r.y = pk_bf16(bf_lo(v.y) * w0, bf_hi(v.y) * w1); w0 *= st2; w1 *= st2;
        r.z = pk_bf16(bf_lo(v.z) * w0, bf_hi(v.z) * w1); w0 *= st2; w1 *= st2;
        r.w = pk_bf16(bf_lo(v.w) * w0, bf_hi(v.w) * w1);
        return r;
    }
    __device__ __forceinline__ void pre(int kt, f32x16 (&acc)[2][2], int wm, int wn, int lane) const {
        if (kt & 1) return;
        const int ci = kt >> 1; const int ch = dir ? (nc - 1 - ci) : ci;
        bf16_t* dst = UR + (size_t)ch * (4ull * 512 * 256);
#pragma unroll
        for (int mi = 0; mi < 2; ++mi) {
            const int m = epi_m<true>(wm, mi, 0, lane);
#pragma unroll
            for (int ni = 0; ni < 2; ++ni)
#pragma unroll
                for (int g = 0; g < 4; ++g) {
                    const int n = wn * 64 + ni * 32 + 8 * g + 4 * (lane >> 5);
                    *(uint2*)(dst + (size_t)m * 256 + n) =
                        make_uint2(pk_bf16(acc[mi][ni][g * 4 + 0], acc[mi][ni][g * 4 + 1]), pk_bf16(acc[mi][ni][g * 4 + 2], acc[mi][ni][g * 4 + 3]));
                }
        }
#pragma unroll
        for (int mi = 0; mi < 2; ++mi)
#pragma unroll
            for (int ni = 0; ni < 2; ++ni)
#pragma unroll
                for (int r = 0; r < 16; ++r) acc[mi][ni][r] *= dec;
    }
    __device__ __forceinline__ void epi(f32x16 (&)[2][2], int, int, int) const {}
};

struct PolO : NoPre {
    const bf16_t *Pp, *Qp, *Vp, *Rf, *Rb; bf16_t* O; float lgf, lgb;
    __device__ __forceinline__ uint4 ldA(int row, int kt, int c8) const {
        if (kt < 2) return *(const uint4*)(Pp + (size_t)row * 128 + kt * 64 + c8 * 8);
        const int seg = (kt - 2) >> 2, kk = (kt - 2) & 3;
        uint4 v = *(const uint4*)(Qp + (size_t)row * 1024 + kk * 64 + c8 * 8);
        const float s = seg ? exp2f(lgb * (float)(128 - row)) : exp2f(lgf * (float)(row + 1));
        return scale8(v, s);
    }
    __device__ __forceinline__ uint4 ldB(int row, int kt, int c8) const {
        if (kt < 2) return *(const uint4*)(Vp + (size_t)row * T3 + kt * 64 + c8 * 8);
        const int seg = (kt - 2) >> 2, kk = (kt - 2) & 3;
        return *(const uint4*)((seg ? Rb : Rf) + (size_t)row * 256 + kk * 64 + c8 * 8);
    }
    __device__ __forceinline__ void epi(f32x16 (&acc)[2][2], int wm, int wn, int lane) const {
#pragma unroll
        for (int mi = 0; mi < 2; ++mi) {
            const int m = epi_m<true>(wm, mi, 0, lane);
#pragma unroll
            for (int ni = 0; ni < 2; ++ni)
#pragma unroll
                for (int g = 0; g < 4; ++g) {
                    const int n = wn * 64 + ni * 32 + 8 * g + 4 * (lane >> 5);
                    *(uint2*)(O + (size_t)m * 2048 + n) =
                        make_uint2(pk_bf16(acc[mi][ni][g * 4 + 0], acc[mi][ni][g * 4 + 1]), pk_bf16(acc[mi][ni][g * 4 + 2], acc[mi][ni][g * 4 + 3]));
                }
        }
    }
};

struct PolResid : NoPre {
    const bf16_t *A, *B; int lda, ldb; const float* res; float* dst;
    __device__ __forceinline__ uint4 ldA(int row, int kt, int c8) const { return *(const uint4*)(A + (size_t)row * lda + kt * 64 + c8 * 8); }
    __device__ __forceinline__ uint4 ldB(int row, int kt, int c8) const { return *(const uint4*)(B + (size_t)row * ldb + kt * 64 + c8 * 8); }
    __device__ __forceinline__ void epi(f32x16 (&acc)[2][2], int wm, int wn, int lane) const {
#pragma unroll
        for (int mi = 0; mi < 2; ++mi) {
            const int m = epi_m<true>(wm, mi, 0, lane);
#pragma unroll
            for (int ni = 0; ni < 2; ++ni)
#pragma unroll
                for (int g = 0; g < 4; ++g) {
                    const int n = wn * 64 + ni * 32 + 8 * g + 4 * (lane >> 5);
                    const float4 x = *(const float4*)(res + (size_t)m * 1024 + n);
                    float4 z;
                    z.x = ALPHA * x.x + acc[mi][ni][g * 4 + 0]; z.y = ALPHA * x.y + acc[mi][ni][g * 4 + 1];
                    z.z = ALPHA * x.z + acc[mi][ni][g * 4 + 2]; z.w = ALPHA * x.w + acc[mi][ni][g * 4 + 3];
                    *(float4*)(dst + (size_t)m * 1024 + n) = z;
                }
        }
    }
};

struct PolMoe1 : NoPre {
    const bf16_t *xb, *B; const int* idx; bf16_t* H; int n0;
    __device__ __forceinline__ uint4 ldA(int row, int kt, int c8) const { return *(const uint4*)(xb + (size_t)idx[row] * 1024 + kt * 64 + c8 * 8); }
    __device__ __forceinline__ uint4 ldB(int row, int kt, int c8) const { return *(const uint4*)(B + (size_t)row * 1024 + kt * 64 + c8 * 8); }
    __device__ __forceinline__ void epi(f32x16 (&acc)[2][2], int wm, int wn, int lane) const {
        const int fb = (n0 + wn * 64) >> 1;
#pragma unroll
        for (int mi = 0; mi < 2; ++mi) {
            const int m = epi_m<true>(wm, mi, 0, lane);
#pragma unroll
            for (int g = 0; g < 4; ++g) {
                float v[4];
#pragma unroll
                for (int e = 0; e < 4; ++e) v[e] = silu_f(acc[mi][0][g * 4 + e]) * acc[mi][1][g * 4 + e];
                *(uint2*)(H + (size_t)m * 1024 + fb + 8 * g + 4 * (lane >> 5)) = make_uint2(pk_bf16(v[0], v[1]), pk_bf16(v[2], v[3]));
            }
        }
    }
};
struct PolMoe2 : NoPre {
    const bf16_t *A, *B; const float* gate; bf16_t* Y;
    __device__ __forceinline__ uint4 ldA(int row, int kt, int c8) const { return *(const uint4*)(A + (size_t)row * 1024 + kt * 64 + c8 * 8); }
    __device__ __forceinline__ uint4 ldB(int row, int kt, int c8) const { return *(const uint4*)(B + (size_t)row * 1024 + kt * 64 + c8 * 8); }
    __device__ __forceinline__ void epi(f32x16 (&acc)[2][2], int wm, int wn, int lane) const {
#pragma unroll
        for (int mi = 0; mi < 2; ++mi) {
            const int m = epi_m<true>(wm, mi, 0, lane);
            const float gt = gate[m];
#pragma unroll
            for (int ni = 0; ni < 2; ++ni)
#pragma unroll
                for (int g = 0; g < 4; ++g) {
                    const int n = wn * 64 + ni * 32 + 8 * g + 4 * (lane >> 5);
                    *(uint2*)(Y + (size_t)m * 1024 + n) =
                        make_uint2(pk_bf16(acc[mi][ni][g * 4 + 0] * gt, acc[mi][ni][g * 4 + 1] * gt), pk_bf16(acc[mi][ni][g * 4 + 2] * gt, acc[mi][ni][g * 4 + 3] * gt));
                }
        }
    }
};
template <bool SWAP> struct PolQkv : NoPre {
    const bf16_t *A, *B; char* ws; int m0, n0;
    __device__ __forceinline__ uint4 ldA(int row, int kt, int c8) const { return *(const uint4*)(A + (size_t)row * 1024 + kt * 64 + c8 * 8); }
    __device__ __forceinline__ uint4 ldB(int row, int kt, int c8) const { return *(const uint4*)(B + (size_t)row * 1024 + kt * 64 + c8 * 8); }
    __device__ __forceinline__ void epi(f32x16 (&acc)[2][2], int wm, int wn, int lane) const {
        if (SWAP) {
            bf16_t* dstb = (bf16_t*)(ws + ((n0 >> 10) ? N_K : N_Q));
#pragma unroll
            for (int mi = 0; mi < 2; ++mi) {
                const int tok = m0 + epi_m<true>(wm, mi, 0, lane);
#pragma unroll
                for (int ni = 0; ni < 2; ++ni)
#pragma unroll
                    for (int g = 0; g < 4; ++g) {
                        const int col = (n0 & 1023) + wn * 64 + ni * 32 + 8 * g + 4 * (lane >> 5);
                        *(uint2*)(dstb + (size_t)tok * 1024 + col) =
                            make_uint2(pk_bf16(acc[mi][ni][g * 4 + 0], acc[mi][ni][g * 4 + 1]), pk_bf16(acc[mi][ni][g * 4 + 2], acc[mi][ni][g * 4 + 3]));
                    }
            }
        } else {
            bf16_t* Vt = (bf16_t*)(ws + N_VT);
#pragma unroll
            for (int mi = 0; mi < 2; ++mi)
#pragma unroll
                for (int ni = 0; ni < 2; ++ni) {
                    const int col = n0 - 2048 + wn * 64 + ni * 32 + (lane & 31);
#pragma unroll
                    for (int g = 0; g < 4; ++g) {
                        const int tok0 = m0 + wm * 64 + mi * 32 + 8 * g + 4 * (lane >> 5);
                        *(uint2*)(Vt + (size_t)col * T_ALL + tok0) =
                            make_uint2(pk_bf16(acc[mi][ni][g * 4 + 0], acc[mi][ni][g * 4 + 1]), pk_bf16(acc[mi][ni][g * 4 + 2], acc[mi][ni][g * 4 + 3]));
                    }
                }
        }
    }
};

__device__ __forceinline__ void transpose_tile(const float* src0, const float* src1, int ld, bf16_t* dst, int K, int n0, int k0, int mode, char* smem, const int TID) {
    float* tile = (float*)smem;
    const int t = TID;
    {
        const int n4 = (t & 15) * 4, kr = t >> 4;
        const int np = n0 + n4;
        const float* s = src0; int col = np;
        if (mode == 1 && np < 2048) {
            const int base = np & ~255, r = np & 255, g = r >> 6, u = r & 63;
            const int i = g * 32 + (u & 31);
            col = base + ((u < 32) ? i : (i + 128));
        } else if (mode == 2) {
            const int g = np >> 6, u = np & 63;
            if (u >= 32) s = src1;
            col = g * 32 + (u & 31);
        }
#pragma unroll
        for (int kk = 0; kk < 4; ++kk) {
            const int k = kr + 16 * kk;
            const float4 v = *(const float4*)(s + (size_t)(k0 + k) * ld + col);
            tile[k * 65 + n4 + 0] = v.x; tile[k * 65 + n4 + 1] = v.y; tile[k * 65 + n4 + 2] = v.z; tile[k * 65 + n4 + 3] = v.w;
        }
    }
    __syncthreads();
    {
        const int n = t >> 2, kc = (t & 3) * 16;
        const int np = n0 + n;
        float sc = 1.f;
        if (mode == 1 && np >= 1024 && np < 2048) sc = 0.0625f;
        if (mode == 3 && np < 1024) sc = 0.17677669529663687f;
        unsigned o[8];
#pragma unroll
        for (int j = 0; j < 8; ++j) o[j] = pk_bf16(tile[(kc + 2 * j) * 65 + n] * sc, tile[(kc + 2 * j + 1) * 65 + n] * sc);
        uint4* d = (uint4*)(dst + (size_t)np * K + k0 + kc);
        d[0] = make_uint4(o[0], o[1], o[2], o[3]);
        d[1] = make_uint4(o[4], o[5], o[6], o[7]);
    }
    __syncthreads();
}
__device__ void convert_matrix(const float* src0, const float* src1, int ld, bf16_t* dst, int N, int K, int mode, char* smem, int& rot, const int TID) {
    const int ntn = N / 64, ntk = K / 64, nt = ntn * ntk;
    int start = (int)((blockIdx.x + gridDim.x - (rot % gridDim.x)) % gridDim.x);
    for (int t = start; t < nt; t += gridDim.x) transpose_tile(src0, src1, ld, dst, K, (t % ntn) * 64, (t / ntn) * 64, mode, smem, TID);
    rot += nt;
}

template <int MODE_SRC, bool WRITE_XB, bool ROUTER>
__device__ void ln_phase(const Params& p, const float* gam, const float* bet, const float* wr, size_t xb_off, char* smem, const int TID) {
    float* wrT = (float*)smem;
    if (ROUTER) {
        for (int i = TID; i < 16 * 1024; i += 256) { const int d = i >> 4, e = i & 15; wrT[e * 1024 + d] = wr[i]; }
        __syncthreads();
    }
    const int lane = TID & 63, w = TID >> 6;
    bf16_t* xb = (bf16_t*)(p.ws + xb_off);
    const bf16_t* ye = (const bf16_t*)(p.ws + M_YE);
    const int* pos = (const int*)(p.ws + M_POS);
    float* aff = (float*)(p.ws + M_AFF);
    for (int tok = blockIdx.x * 4 + w; tok < T_ALL; tok += gridDim.x * 4) {
        float* xr = p.out + (size_t)tok * 1024;
        float4 v[4];
#pragma unroll
        for (int k = 0; k < 4; ++k) v[k] = *(const float4*)(xr + k * 256 + lane * 4);
        if (MODE_SRC == 1) {
#pragma unroll
            for (int k = 0; k < 4; ++k) { v[k].x *= ALPHA; v[k].y *= ALPHA; v[k].z *= ALPHA; v[k].w *= ALPHA; }
            const int trunk = tok >= T_PROMPT;
            const int cap = trunk ? CAP_S : CAP_P;
            const size_t rb = trunk ? (size_t)16 * CAP_P : 0;
            for (int e = 0; e < 16; ++e) {
                const int ps = pos[(size_t)tok * 16 + e];
                if (ps >= 0) {
                    const bf16_t* yr = ye + (rb + (size_t)e * cap + ps) * 1024;
#pragma unroll
                    for (int k = 0; k < 4; ++k) {
                        const uint2 u = *(const uint2*)(yr + k * 256 + lane * 4);
                        v[k].x += bf_lo(u.x); v[k].y += bf_hi(u.x); v[k].z += bf_lo(u.y); v[k].w += bf_hi(u.y);
                    }
                }
            }
        }
        float s = 0.f;
#pragma unroll
        for (int k = 0; k < 4; ++k) s += v[k].x + v[k].y + v[k].z + v[k].w;
        const float mu = wave_sum(s) * (1.f / 1024.f);
        float q = 0.f;
#pragma unroll
        for (int k = 0; k < 4; ++k) {
            v[k].x -= mu; v[k].y -= mu; v[k].z -= mu; v[k].w -= mu;
            q += v[k].x * v[k].x + v[k].y * v[k].y + v[k].z * v[k].z + v[k].w * v[k].w;
        }
        const float rstd = rsqrtf(wave_sum(q) * (1.f / 1024.f) + LN_EPS);
#pragma unroll
        for (int k = 0; k < 4; ++k) {
            const float4 g = *(const float4*)(gam + k * 256 + lane * 4);
            const float4 b = *(const float4*)(bet + k * 256 + lane * 4);
            v[k].x = v[k].x * rstd * g.x + b.x; v[k].y = v[k].y * rstd * g.y + b.y;
            v[k].z = v[k].z * rstd * g.z + b.z; v[k].w = v[k].w * rstd * g.w + b.w;
            *(float4*)(xr + k * 256 + lane * 4) = v[k];
            if (WRITE_XB) *(uint2*)(xb + (size_t)tok * 1024 + k * 256 + lane * 4) = make_uint2(pk_bf16(v[k].x, v[k].y), pk_bf16(v[k].z, v[k].w));
        }
        if (ROUTER) {
            float lg[16];
#pragma unroll
            for (int e = 0; e < 16; ++e) {
                float a = 0.f;
#pragma unroll
                for (int k = 0; k < 4; ++k) {
                    const float4 wv = *(const float4*)(wrT + e * 1024 + k * 256 + lane * 4);
                    a += v[k].x * wv.x + v[k].y * wv.y + v[k].z * wv.z + v[k].w * wv.w;
                }
                lg[e] = wave_sum(a);
            }
            float mx = lg[0];
#pragma unroll
            for (int e = 1; e < 16; ++e) mx = fmaxf(mx, lg[e]);
            float se = 0.f;
#pragma unroll
            for (int e = 0; e < 16; ++e) { lg[e] = expf(lg[e] - mx); se += lg[e]; }
            const float inv = 1.f / se;
            float mine = 0.f;
#pragma unroll
            for (int e = 0; e < 16; ++e) if (lane == e) mine = lg[e] * inv;
            if (lane < 16) {
                const int trunk = tok >= T_PROMPT;
                const int tt = trunk ? T3 : T_PROMPT;
                const int tl = trunk ? tok - T_PROMPT : tok;
                aff[(trunk ? (size_t)T_PROMPT * 16 : 0) + (size_t)lane * tt + tl] = mine;
            }
        }
    }
    __syncthreads();
}

__device__ void topk_phase(const Params& p, char* smem, const int TID) {
    int* hist = (int*)smem;
    u64* sh_pref = (u64*)(smem + 1024);
    int* sh_rem = (int*)(smem + 1040);
    int* sh_cnt = (int*)(smem + 1044);
    const float* aff = (const float*)(p.ws + M_AFF);
    int* idx = (int*)(p.ws + M_IDX);
    float* gate = (float*)(p.ws + M_GATE);
    int* pos = (int*)(p.ws + M_POS);
    for (int item = blockIdx.x; item < 32; item += gridDim.x) {
        const int trunk = item >> 4, e = item & 15;
        const int tt = trunk ? T3 : T_PROMPT, cap = trunk ? CAP_S : CAP_P;
        const float* a = aff + (trunk ? (size_t)T_PROMPT * 16 : 0) + (size_t)e * tt;
        const size_t ob = (trunk ? (size_t)16 * CAP_P : 0) + (size_t)e * cap;
        const int tok0 = trunk ? T_PROMPT : 0;
        if (TID == 0) { *sh_pref = 0ull; *sh_rem = cap; *sh_cnt = 0; }
        __syncthreads();
        for (int pass = 0; pass < 6; ++pass) {
            const int shift = 40 - 8 * pass;
            hist[TID] = 0;
            __syncthreads();
            const u64 pref = *sh_pref;
            for (int i = TID; i < tt; i += 256) {
                const u64 key = ((u64)__float_as_uint(a[i]) << 15) | (u64)(32767 - i);
                if (pass == 0 || (key >> (shift + 8)) == pref) atomicAdd(&hist[(int)((key >> shift) & 255)], 1);
            }
            __syncthreads();
            if (TID == 0) {
                int rem = *sh_rem, b = 255;
                for (; b > 0; --b) { const int c = hist[b]; if (c >= rem) break; rem -= c; }
                *sh_rem = rem; *sh_pref = (pref << 8) | (u64)b;
            }
            __syncthreads();
        }
        const u64 thr = *sh_pref;
        for (int i = TID; i < tt; i += 256) {
            const float av = a[i];
            const u64 key = ((u64)__float_as_uint(av) << 15) | (u64)(32767 - i);
            int ps = -1;
            if (key >= thr) { ps = atomicAdd(sh_cnt, 1); idx[ob + ps] = i; gate[ob + ps] = av; }
            pos[(size_t)(tok0 + i) * 16 + e] = ps;
        }
        __syncthreads();
    }
}

__device__ void na_phase(const Params& p, const int TID) {
    bf16_t* NQ = (bf16_t*)(p.ws + N_Q);
    const bf16_t* NK = (const bf16_t*)(p.ws + N_K);
    const bf16_t* NVt = (const bf16_t*)(p.ws + N_VT);
    const int lane = TID & 63, qb = TID >> 6, qi = lane & 15, hi = lane >> 4;
    for (int item = blockIdx.x; item < 768 * 32; item += gridDim.x) {
        const int h = item & 31, rg = item >> 5;
        int seq_base, rows, r;
        if (rg < 512) { seq_base = (rg >> 5) * 2048; rows = 32; r = rg & 31; }
        else { seq_base = T_PROMPT; rows = 256; r = rg - 512; }
        const int rs = min(max(r - 4, 0), rows - 8);
        const int c = qb * 16 + qi;
        const int cs = min(max(c - 8, 0), 48);
        const int kb0 = min(max(qb - 1, 0), 1);
        const int tq = seq_base + r * 64 + c;
        const bf16x8 qf = *(const bf16x8*)(NQ + (size_t)tq * 1024 + h * 32 + hi * 8);
        const float* rp = p.na_rpb + h * 465;
        float s[24][4];
        float mx = -1e30f;
#pragma unroll
        for (int a = 0; a < 8; ++a)
#pragma unroll
            for (int jb = 0; jb < 3; ++jb) {
                const int kcb = (kb0 + jb) * 16;
                const int tk = seq_base + (rs + a) * 64 + kcb + qi;
                const bf16x8 kf = *(const bf16x8*)(NK + (size_t)tk * 1024 + h * 32 + hi * 8);
                f32x4 z = {0.f, 0.f, 0.f, 0.f};
                const f32x4 sc = __builtin_amdgcn_mfma_f32_16x16x32_bf16(kf, qf, z, 0, 0, 0);
                const float* rpr = rp + (rs + a - r + 7) * 31;
#pragma unroll
                for (int e = 0; e < 4; ++e) {
                    const int kcol = kcb + 4 * hi + e;
                    const bool valid = (kcol >= cs) && (kcol < cs + 16);
                    const int bi = valid ? (kcol - c + 15) : 15;
                    const float v = valid ? (sc[e] + rpr[bi]) : -1e30f;
                    s[a * 3 + jb][e] = v;
                    mx = fmaxf(mx, v);
                }
            }
        mx = fmaxf(mx, __shfl_xor(mx, 16, 64));
        mx = fmaxf(mx, __shfl_xor(mx, 32, 64));
        float sum = 0.f;
#pragma unroll
        for (int t = 0; t < 24; ++t)
#pragma unroll
            for (int e = 0; e < 4; ++e) { const float pv = __expf(s[t][e] - mx); s[t][e] = pv; sum += pv; }
        sum += __shfl_xor(sum, 16, 64);
        sum += __shfl_xor(sum, 32, 64);
        const float inv = 1.f / sum;
        f32x4 o0 = {0.f, 0.f, 0.f, 0.f}, o1 = {0.f, 0.f, 0.f, 0.f};
#pragma unroll
        for (int pi = 0; pi < 12; ++pi) {
            const int t0 = 2 * pi, t1 = 2 * pi + 1;
            const int tokA = seq_base + (rs + t0 / 3) * 64 + (kb0 + t0 % 3) * 16 + 4 * hi;
            const int tokB = seq_base + (rs + t1 / 3) * 64 + (kb0 + t1 % 3) * 16 + 4 * hi;
            union { bf16x8 v; unsigned u[4]; } pf, v0, v1;
            pf.u[0] = pk_bf16(s[t0][0], s[t0][1]); pf.u[1] = pk_bf16(s[t0][2], s[t0][3]);
            pf.u[2] = pk_bf16(s[t1][0], s[t1][1]); pf.u[3] = pk_bf16(s[t1][2], s[t1][3]);
            const bf16_t* vr0 = NVt + (size_t)(h * 32 + qi) * T_ALL;
            const bf16_t* vr1 = NVt + (size_t)(h * 32 + 16 + qi) * T_ALL;
            const uint2 a0 = *(const uint2*)(vr0 + tokA), b0 = *(const uint2*)(vr0 + tokB);
            const uint2 a1 = *(const uint2*)(vr1 + tokA), b1 = *(const uint2*)(vr1 + tokB);
            v0.u[0] = a0.x; v0.u[1] = a0.y; v0.u[2] = b0.x; v0.u[3] = b0.y;
            v1.u[0] = a1.x; v1.u[1] = a1.y; v1.u[2] = b1.x; v1.u[3] = b1.y;
            o0 = __builtin_amdgcn_mfma_f32_16x16x32_bf16(pf.v, v0.v, o0, 0, 0, 0);
            o1 = __builtin_amdgcn_mfma_f32_16x16x32_bf16(pf.v, v1.v, o1, 0, 0, 0);
        }
#pragma unroll
        for (int e = 0; e < 4; ++e) {
            const int q = 4 * hi + e;
            const float iv = __shfl(inv, q, 64);
            bf16_t* dst = NQ + (size_t)(seq_base + r * 64 + qb * 16 + q) * 1024 + h * 32 + qi;
            dst[0] = f2bf(o0[e] * iv);
            dst[16] = f2bf(o1[e] * iv);
        }
    }
}

enum { PH_PRE = 0, PH_R0 = 1  , PH_LN0A = 16, PH_TOPK0, PH_MOE1_0, PH_MOE2_0, PH_LN0B, PH_QKV, PH_NA, PH_NAOUT, PH_LN1A, PH_TOPK1, PH_MOE1_1, PH_MOE2_1, PH_LN1B, PH_COUNT };

#ifndef ONLY
#define EN(k) 1
#else
#define EN(k) (ONLY == (k))
#endif
__device__ void run_phase(const Params& p, int ph, char* smem, const int TID) {
    const int bid = blockIdx.x, G = gridDim.x;
    char* ws = p.ws;
    if (EN(0) && ph == PH_PRE) {
        int rot = 0;
        convert_matrix(p.ret_w_in, nullptr, 6144, (bf16_t*)(ws + R_WIN), 6144, 1024, 1, smem, rot, TID);
        convert_matrix(p.ret_w_out, nullptr, 1024, (bf16_t*)(ws + R_WOUT), 1024, 2048, 0, smem, rot, TID);
        float2* rt = (float2*)(ws + R_ROT);
        for (int i = bid * 256 + TID; i < 16384 * 128; i += G * 256) {
            const int s = i >> 7, fi = i & 127;
            const float inv = exp2f(-(float)fi * (13.287712379549449f / 128.0f));
            const float ang = (float)s * inv;
            const double rev = (double)ang * 0.15915494309189535;
            const float fr = (float)(rev - (double)(long long)(rev + 0.5));
            rt[i] = make_float2(__builtin_amdgcn_cosf(fr), __builtin_amdgcn_sinf(fr));
        }
        return;
    }
    if (ph >= PH_R0 && ph < PH_R0 + 15) {
        const int th = (ph - PH_R0) / 5, sub = (ph - PH_R0) % 5;
        const int nseq = (th < 2) ? 8 : 1, nc = (th < 2) ? 16 : 128, smask = (th < 2) ? 2047 : 16383;
        const float* xin = (th < 2) ? (p.x_prompt + (size_t)th * T3 * 1024) : p.x_sample;
        if (EN(1) && sub == 0) {
            const int ntn = 48;
            for (int t = bid; t < 128 * ntn; t += G) {
                const int m0 = (t / ntn) * 128, n0 = (t % ntn) * 128;
                const int sec = n0 >> 10;
                if (sec == 0 || sec >= 4) { PolProj<true> pol; pol.xA = xin; pol.Bt = (const bf16_t*)(ws + R_WIN); pol.ws = ws; pol.m0 = m0; pol.n0 = n0; pol.smask = smask; gemm_core<PolProj<true>, true>(pol, smem, 16, TID); }
                else { PolProj<false> pol; pol.xA = xin; pol.Bt = (const bf16_t*)(ws + R_WIN); pol.ws = ws; pol.m0 = m0; pol.n0 = n0; pol.smask = smask; gemm_core<PolProj<false>, false>(pol, smem, 16, TID); }
            }
        } else if (EN(2) && sub == 1) {
            const int nscan = nseq * 4 * 2 * 8;
            const int nscore = 128 * 4;
            for (int t = bid; t < nscan + nscore; t += G) {
                if (t < nscan) {
                    int u = t;
                    const int dkt = u & 1; u >>= 1; const int dvt = u & 3; u >>= 2; const int dir = u & 1; u >>= 1; const int h = u & 3; u >>= 2; const int seq = u;
                    PolUscan pol;
                    const int tok0 = seq * nc * 128;
                    pol.A = (const bf16_t*)(ws + R_VT) + (size_t)(h * 512 + dvt * 128) * T3 + tok0;
                    pol.B = (const bf16_t*)(ws + R_KT) + (size_t)(h * 256 + dkt * 128) * T3 + tok0;
                    pol.UR = (bf16_t*)(ws + R_UR) + (size_t)dir * (128ull * 4 * 512 * 256) + (size_t)(seq * nc) * (4ull * 512 * 256) + (size_t)h * (512 * 256) + (size_t)(dvt * 128) * 256 + dkt * 128;
                    pol.nc = nc; pol.dir = dir;
                    pol.lg = log2_sigmoid(p.ret_decay[dir * 4 + h]);
                    pol.dec = exp2f(pol.lg * 128.f);
                    pol.st = exp2f(dir ? pol.lg : -pol.lg); pol.st2 = pol.st * pol.st;
                    gemm_core<PolUscan, true>(pol, smem, nc * 2, TID);
                } else {
                    const int u = t - nscan; const int h = u & 3, cgi = u >> 2;
                    PolScore pol;
                    pol.A = (const bf16_t*)(ws + R_Q) + (size_t)(cgi * 128) * 1024 + h * 256;
                    pol.B = (const bf16_t*)(ws + R_K) + (size_t)(cgi * 128) * 1024 + h * 256;
                    pol.P = (bf16_t*)(ws + R_P) + (size_t)((cgi * 4 + h) * 128) * 128;
                    pol.lgf = log2_sigmoid(p.ret_decay[h]); pol.lgb = log2_sigmoid(p.ret_decay[4 + h]); pol.smem = smem;
                    gemm_core<PolScore, true>(pol, smem, 4, TID);
                }
            }
        } else if (EN(3) && sub == 2) {
            for (int t = bid; t < 128 * 4 * 4; t += G) {
                const int dvt = t & 3, h = (t >> 2) & 3, cgi = t >> 4;
                PolO pol;
                pol.Pp = (const bf16_t*)(ws + R_P) + (size_t)((cgi * 4 + h) * 128) * 128;
                pol.Qp = (const bf16_t*)(ws + R_Q) + (size_t)(cgi * 128) * 1024 + h * 256;
                pol.Vp = (const bf16_t*)(ws + R_VT) + (size_t)(h * 512 + dvt * 128) * T3 + cgi * 128;
                const size_t ro = (size_t)cgi * (4ull * 512 * 256) + (size_t)h * (512 * 256) + (size_t)(dvt * 128) * 256;
                pol.Rf = (const bf16_t*)(ws + R_UR) + ro;
                pol.Rb = (const bf16_t*)(ws + R_UR) + 128ull * 4 * 512 * 256 + ro;
                pol.O = (bf16_t*)(ws + R_O) + (size_t)(cgi * 128) * 2048 + h * 512 + dvt * 128;
                pol.lgf = log2_sigmoid(p.ret_decay[h]); pol.lgb = log2_sigmoid(p.ret_decay[4 + h]);
                gemm_core<PolO, true>(pol, smem, 10, TID);
            }
        } else if (EN(4) && sub == 3) {
            const int lane = TID & 63, w = TID >> 6;
            bf16_t* O = (bf16_t*)(ws + R_O); const bf16_t* Gb = (const bf16_t*)(ws + R_G);
            for (int it = bid * 4 + w; it < T3 * 4; it += G * 4) {
                const size_t off = (size_t)it * 512 + lane * 8;
                const uint4 ov = *(const uint4*)(O + off), gv = *(const uint4*)(Gb + off);
                float y[8] = {bf_lo(ov.x), bf_hi(ov.x), bf_lo(ov.y), bf_hi(ov.y), bf_lo(ov.z), bf_hi(ov.z), bf_lo(ov.w), bf_hi(ov.w)};
                const float g[8] = {bf_lo(gv.x), bf_hi(gv.x), bf_lo(gv.y), bf_hi(gv.y), bf_lo(gv.z), bf_hi(gv.z), bf_lo(gv.w), bf_hi(gv.w)};
                float s = 0.f;
#pragma unroll
                for (int e = 0; e < 8; ++e) s += y[e];
                const float mu = wave_sum(s) * (1.f / 512.f);
                float q = 0.f;
#pragma unroll
                for (int e = 0; e < 8; ++e) { y[e] -= mu; q += y[e] * y[e]; }
                const float rstd = rsqrtf(wave_sum(q) * (1.f / 512.f) + GN_EPS);
#pragma unroll
                for (int e = 0; e < 8; ++e) y[e] = y[e] * rstd * silu_f(g[e]);
                *(uint4*)(O + off) = make_uint4(pk_bf16(y[0], y[1]), pk_bf16(y[2], y[3]), pk_bf16(y[4], y[5]), pk_bf16(y[6], y[7]));
            }
        } else if (EN(5) && sub == 4) {
            for (int t = bid; t < 128 * 8; t += G) {
                const int m0 = (t >> 3) * 128, n0 = (t & 7) * 128;
                PolResid pol;
                pol.A = (const bf16_t*)(ws + R_O) + (size_t)m0 * 2048; pol.lda = 2048;
                pol.B = (const bf16_t*)(ws + R_WOUT) + (size_t)n0 * 2048; pol.ldb = 2048;
                pol.res = xin + (size_t)m0 * 1024 + n0;
                pol.dst = p.out + ((size_t)th * T3 + m0) * 1024 + n0;
                gemm_core<PolResid, true>(pol, smem, 32, TID);
            }
        }
        return;
    }
    if (EN(6) && (ph == PH_LN0A || ph == PH_LN1A)) {
        const int L = (ph == PH_LN1A);
        ln_phase<0, true, true>(p, p.ln_mix_g + L * 1024, p.ln_mix_b + L * 1024, p.w_router + (size_t)L * 1024 * 16, M_XB, smem, TID);
        int rot = 0;
        for (int e = 0; e < 16; ++e) {
            const size_t wo = ((size_t)L * 16 + e) * 1024 * 1024;
            convert_matrix(p.w_gate + wo, p.w_up + wo, 1024, (bf16_t*)(ws + M_WGU) + (size_t)e * 2048 * 1024, 2048, 1024, 2, smem, rot, TID);
            convert_matrix(p.w_down + wo, nullptr, 1024, (bf16_t*)(ws + M_WD) + (size_t)e * 1024 * 1024, 1024, 1024, 0, smem, rot, TID);
        }
        if (!L) {
            convert_matrix(p.na_w_in, nullptr, 3072, (bf16_t*)(ws + M_NWIN), 3072, 1024, 3, smem, rot, TID);
            convert_matrix(p.na_w_out, nullptr, 1024, (bf16_t*)(ws + M_NWOUT), 1024, 1024, 0, smem, rot, TID);
        }
        return;
    }
    if (EN(7) && (ph == PH_TOPK0 || ph == PH_TOPK1)) { topk_phase(p, smem, TID); return; }
    if (EN(8) && (ph == PH_MOE1_0 || ph == PH_MOE1_1)) {
        const int np = 16 * 32 * 16, nsm = 16 * 16 * 16;
        for (int t = bid; t < np + nsm; t += G) {
            int trunk, e, mt, nt;
            if (t < np) { trunk = 0; nt = t & 15; mt = (t >> 4) & 31; e = t >> 9; }
            else { const int u = t - np; trunk = 1; nt = u & 15; mt = (u >> 4) & 15; e = u >> 8; }
            const int cap = trunk ? CAP_S : CAP_P;
            const size_t rb = (trunk ? (size_t)16 * CAP_P : 0) + (size_t)e * cap + mt * 128;
            PolMoe1 pol;
            pol.xb = (const bf16_t*)(ws + M_XB) + (trunk ? (size_t)T_PROMPT * 1024 : 0);
            pol.idx = (const int*)(ws + M_IDX) + rb;
            pol.B = (const bf16_t*)(ws + M_WGU) + ((size_t)e * 2048 + nt * 128) * 1024;
            pol.H = (bf16_t*)(ws + M_H) + rb * 1024;
            pol.n0 = nt * 128;
            gemm_core<PolMoe1, true>(pol, smem, 16, TID);
        }
        return;
    }
    if (EN(9) && (ph == PH_MOE2_0 || ph == PH_MOE2_1)) {
        const int np = 16 * 32 * 8, nsm = 16 * 16 * 8;
        for (int t = bid; t < np + nsm; t += G) {
            int trunk, e, mt, nt;
            if (t < np) { trunk = 0; nt = t & 7; mt = (t >> 3) & 31; e = t >> 8; }
            else { const int u = t - np; trunk = 1; nt = u & 7; mt = (u >> 3) & 15; e = u >> 7; }
            const int cap = trunk ? CAP_S : CAP_P;
            const size_t rb = (trunk ? (size_t)16 * CAP_P : 0) + (size_t)e * cap + mt * 128;
            PolMoe2 pol;
            pol.A = (const bf16_t*)(ws + M_H) + rb * 1024;
            pol.B = (const bf16_t*)(ws + M_WD) + ((size_t)e * 1024 + nt * 128) * 1024;
            pol.gate = (const float*)(ws + M_GATE) + rb;
            pol.Y = (bf16_t*)(ws + M_YE) + rb * 1024 + nt * 128;
            gemm_core<PolMoe2, true>(pol, smem, 16, TID);
        }
        return;
    }
    if (EN(10) && ph == PH_LN0B) { ln_phase<1, true, false>(p, p.ln_ffn_g, p.ln_ffn_b, nullptr, M_XB2, smem, TID); return; }
    if (EN(10) && ph == PH_LN1B) { ln_phase<1, false, false>(p, p.ln_ffn_g + 1024, p.ln_ffn_b + 1024, nullptr, M_XB2, smem, TID); return; }
    if (EN(11) && ph == PH_QKV) {
        for (int t = bid; t < 384 * 24; t += G) {
            const int m0 = (t / 24) * 128, n0 = (t % 24) * 128;
            if (n0 < 2048) { PolQkv<true> pol; pol.A = (const bf16_t*)(ws + M_XB2) + (size_t)m0 * 1024; pol.B = (const bf16_t*)(ws + M_NWIN) + (size_t)n0 * 1024; pol.ws = ws; pol.m0 = m0; pol.n0 = n0; gemm_core<PolQkv<true>, true>(pol, smem, 16, TID); }
            else { PolQkv<false> pol; pol.A = (const bf16_t*)(ws + M_XB2) + (size_t)m0 * 1024; pol.B = (const bf16_t*)(ws + M_NWIN) + (size_t)n0 * 1024; pol.ws = ws; pol.m0 = m0; pol.n0 = n0; gemm_core<PolQkv<false>, false>(pol, smem, 16, TID); }
        }
        return;
    }
    if (EN(12) && ph == PH_NA) { na_phase(p, TID); return; }
    if (EN(13) && ph == PH_NAOUT) {
        for (int t = bid; t < 384 * 8; t += G) {
            const int m0 = (t >> 3) * 128, n0 = (t & 7) * 128;
            PolResid pol;
            pol.A = (const bf16_t*)(ws + N_Q) + (size_t)m0 * 1024; pol.lda = 1024;
            pol.B = (const bf16_t*)(ws + M_NWOUT) + (size_t)n0 * 1024; pol.ldb = 1024;
            pol.res = p.out + (size_t)m0 * 1024 + n0;
            pol.dst = p.out + (size_t)m0 * 1024 + n0;
            gemm_core<PolResid, true>(pol, smem, 16, TID);
        }
        return;
    }
}

__global__ void __launch_bounds__(256, 2) fwd_megakernel(Params p) {
    __shared__ __attribute__((aligned(16))) char smem[65536];
    cg::grid_group grid = cg::this_grid();
    for (int ph = p.ph_lo; ph < p.ph_hi; ++ph) {
        Params q = p;
        asm volatile("" : "+s"(q.ws), "+s"(q.out), "+s"(q.x_prompt), "+s"(q.x_sample), "+s"(q.ret_decay), "+s"(q.w_gate), "+s"(q.w_up), "+s"(q.w_down));
        int phv = ph;
        asm volatile("" : "+s"(phv));
        int tidv = threadIdx.x;
        asm volatile("" : "+v"(tidv));
        run_phase(q, phv, smem, tidv);
        if (ph + 1 < p.ph_hi) grid.sync();
    }
}

extern "C" void kernel_launch(void* const* d_in, const int* in_sizes, int n_in, void* d_out, int out_size, void* d_ws, size_t ws_size, hipStream_t stream) {
    static int grid_blocks = 0;
    if (!grid_blocks) {
        int dev = 0, cus = 0, per_cu = 0;
        hipGetDevice(&dev);
        hipDeviceGetAttribute(&cus, hipDeviceAttributeMultiprocessorCount, dev);
        hipOccupancyMaxActiveBlocksPerMultiprocessor(&per_cu, fwd_megakernel, 256, 0);
        if (per_cu < 1) per_cu = 1;
        if (per_cu > 2) per_cu = 2;
        grid_blocks = cus * per_cu;
        if (ws_size < R_END || ws_size < M_END) fprintf(stderr, "kernel_launch: workspace too small: %zu < %zu\n", ws_size, (size_t)(R_END > M_END ? R_END : M_END));
    }
    if (ws_size < R_END || ws_size < M_END) return;
    Params p{};
    p.x_prompt = (const float*)d_in[0]; p.x_sample = (const float*)d_in[1]; p.ret_w_in = (const float*)d_in[2]; p.ret_decay = (const float*)d_in[3];
    p.ret_w_out = (const float*)d_in[4]; p.na_w_in = (const float*)d_in[5]; p.na_rpb = (const float*)d_in[6]; p.na_w_out = (const float*)d_in[7];
    p.ln_mix_g = (const float*)d_in[8]; p.ln_mix_b = (const float*)d_in[9]; p.ln_ffn_g = (const float*)d_in[10]; p.ln_ffn_b = (const float*)d_in[11];
    p.w_router = (const float*)d_in[12]; p.w_gate = (const float*)d_in[13]; p.w_up = (const float*)d_in[14]; p.w_down = (const float*)d_in[15];
    p.out = (float*)d_out; p.ws = (char*)d_ws; p.ph_lo = 0; p.ph_hi = PH_COUNT;
    void* args[] = {&p};
    hipError_t e = hipLaunchCooperativeKernel((void*)fwd_megakernel, dim3(grid_blocks), dim3(256), args, 0, stream);
    if (e != hipSuccess) fprintf(stderr, "cooperative launch failed: %s (grid %d)\n", hipGetErrorString(e), grid_blocks);
}
```

```cpp
#include <hip/hip_runtime.h>
#include <hip/hip_cooperative_groups.h>
#include <cstdio>
namespace cg = cooperative_groups;

typedef unsigned short bf16_t;
typedef short bf16x8 __attribute__((ext_vector_type(8)));
typedef float f32x16 __attribute__((ext_vector_type(16)));
typedef float f32x4 __attribute__((ext_vector_type(4)));
typedef unsigned long long u64;

constexpr int D = 1024;
constexpr int T_ALL = 49152;
constexpr int T_PROMPT = 32768;
constexpr int T3 = 16384;
constexpr float ALPHA = 1.41421356237309515f;
constexpr float LN_EPS = 1e-5f, GN_EPS = 1e-6f;
constexpr int CAP_P = 4096, CAP_S = 2048;
constexpr int RC = 256, NCH3 = T3 / RC;

constexpr size_t R_WIN = 0;
constexpr size_t R_WOUT = R_WIN + 6144ull * 1024 * 2;
constexpr size_t R_ROT = R_WOUT + 1024ull * 2048 * 2;
constexpr size_t R_Q = R_ROT + 16384ull * 128 * 8;
constexpr size_t R_K = R_Q + (size_t)T3 * 1024 * 2;
constexpr size_t R_KT = R_K + (size_t)T3 * 1024 * 2;
constexpr size_t R_VT = R_KT + (size_t)T3 * 1024 * 2;
constexpr size_t R_G = R_VT + (size_t)T3 * 2048 * 2;
constexpr size_t R_P = R_G + (size_t)T3 * 2048 * 2;
constexpr size_t R_UR = R_P + (size_t)NCH3 * 4 * RC * RC * 2;
constexpr size_t R_O = R_UR + 2ull * NCH3 * 4 * 512 * 256 * 2;
constexpr size_t R_END = R_O + (size_t)T3 * 2048 * 2;
constexpr size_t UNIT = (size_t)T_ALL * 1024 * 2;
constexpr size_t M_XB = 0;
constexpr size_t M_XB2 = 2 * UNIT;
constexpr size_t M_YE = 0;
constexpr size_t M_H = 2 * UNIT;
constexpr size_t M_WGU = M_H + 2ull * T_ALL * 1024 * 2;
constexpr size_t M_WD = M_WGU + 16ull * 2048 * 1024 * 2;
constexpr size_t M_AFF = M_WD + 16ull * 1024 * 1024 * 2;
constexpr size_t M_IDX = M_AFF + (size_t)T_ALL * 16 * 4;
constexpr size_t M_GATE = M_IDX + 2ull * T_ALL * 4;
constexpr size_t M_POS = M_GATE + 2ull * T_ALL * 4;
constexpr size_t M_NWIN = M_POS + (size_t)T_ALL * 16 * 4;
constexpr size_t M_NWOUT = M_NWIN + 3072ull * 1024 * 2;
constexpr size_t M_END = M_NWOUT + 1024ull * 1024 * 2;
constexpr size_t BAR_OFF = (R_END > M_END ? R_END : M_END);
constexpr size_t BAR_END = BAR_OFF + 16384;
constexpr size_t N_Q = 3 * UNIT;
constexpr size_t N_K = 0;
constexpr size_t N_VT = UNIT;

constexpr int LDS_BYTES = 131072 + 16;
struct Params {
    const float *x_prompt, *x_sample, *ret_w_in, *ret_decay, *ret_w_out, *na_w_in, *na_rpb, *na_w_out;
    const float *ln_mix_g, *ln_mix_b, *ln_ffn_g, *ln_ffn_b, *w_router, *w_gate, *w_up, *w_down;
    float* out;
    char* ws;
    int ph_lo, ph_hi;
};

typedef __bf16 bf16x2_t __attribute__((ext_vector_type(2)));
typedef float f32x2_t __attribute__((ext_vector_type(2)));
__device__ __forceinline__ unsigned pk_bf16(float lo, float hi) {
    f32x2_t v = {lo, hi};
    bf16x2_t b = __builtin_convertvector(v, bf16x2_t);
    return __builtin_bit_cast(unsigned, b);
}
__device__ __forceinline__ bf16_t f2bf(float f) { return (bf16_t)(pk_bf16(f, 0.f) & 0xffffu); }
__device__ __forceinline__ float bf_lo(unsigned u) { return __uint_as_float(u << 16); }
__device__ __forceinline__ float bf_hi(unsigned u) { return __uint_as_float(u & 0xffff0000u); }
__device__ __forceinline__ float silu_f(float g) { return g * __builtin_amdgcn_rcpf(1.f + __expf(-g)); }
template <int CTRL, int RMASK> __device__ __forceinline__ float dpp_mov0(float v) {
    return __builtin_bit_cast(float, __builtin_amdgcn_update_dpp(0, __builtin_bit_cast(int, v), CTRL, RMASK, 0xf, false));
}
__device__ __forceinline__ float wave_sum(float v) {
    v += dpp_mov0<0xB1, 0xf>(v);
    v += dpp_mov0<0x4E, 0xf>(v);
    v += dpp_mov0<0x141, 0xf>(v);
    v += dpp_mov0<0x140, 0xf>(v);
    v += dpp_mov0<0x142, 0xa>(v);
    v += dpp_mov0<0x143, 0xc>(v);
    return __builtin_bit_cast(float, __builtin_amdgcn_readlane(__builtin_bit_cast(int, v), 63));
}
template <int CTRL> __device__ __forceinline__ float dpp_perm(float v) { return __builtin_bit_cast(float, __builtin_amdgcn_update_dpp(0, __builtin_bit_cast(int, v), CTRL, 0xf, 0xf, true)); }
__device__ __forceinline__ float row16_max(float v) {
    v = fmaxf(v, dpp_perm<0xB1>(v)); v = fmaxf(v, dpp_perm<0x4E>(v)); v = fmaxf(v, dpp_perm<0x141>(v)); return fmaxf(v, dpp_perm<0x140>(v));
}
__device__ __forceinline__ float row16_sum(float v) {
    v += dpp_perm<0xB1>(v); v += dpp_perm<0x4E>(v); v += dpp_perm<0x141>(v); return v + dpp_perm<0x140>(v);
}
__device__ __forceinline__ uint4 scale8(uint4 v, float s) {
    uint4 r;
    r.x = pk_bf16(bf_lo(v.x) * s, bf_hi(v.x) * s);
    r.y = pk_bf16(bf_lo(v.y) * s, bf_hi(v.y) * s);
    r.z = pk_bf16(bf_lo(v.z) * s, bf_hi(v.z) * s);
    r.w = pk_bf16(bf_lo(v.w) * s, bf_hi(v.w) * s);
    return r;
}
__device__ __forceinline__ float log2_sigmoid(float x) { return -log1pf(expf(-x)) * 1.44269504088896341f; }

__device__ __forceinline__ int lds_off(int row, int c8) { return row * 128 + ((c8 ^ ((row >> 1) & 7)) << 4); }
constexpr int NT = 512;
template <int MI_, int NI_, int WM_, int WN_, int DEPTH_> struct Cfg {
    static constexpr int DEPTH = DEPTH_;
    static constexpr int MI = MI_, NI = NI_, WM = WM_, WN = WN_, BM = WM_ * MI_ * 32, BN = WN_ * NI_ * 32, LA = BM / 64, LB = BN / 64, STAGE = (BM + BN) * 128;
    static_assert(WM_ * WN_ == 8, "8 waves");
};
typedef Cfg<4, 2, 2, 4, 2> C256;
typedef Cfg<2, 1, 2, 4, 4> C128;
typedef Cfg<2, 2, 2, 4, 3> CO;

template <class P, class C, bool SWAP, int D, int S0, bool NOMATH = false>
__device__ __forceinline__ void gemm_iter(P& p, char* smem, int kt, int nk, uint4 (&va)[D][C::LA], uint4 (&vb)[D][C::LB], f32x16 (&acc)[C::MI][C::NI],
                                          int wm, int wn, int lane, int r0, int c8) {
    constexpr int S = S0 % D, SN = (S0 + 1) % D;
    char* cur = smem + (kt & 1) * C::STAGE;
    char* nxt = smem + ((kt + 1) & 1) * C::STAGE;
    if (kt + D < nk) {
#pragma unroll
        for (int i = 0; i < C::LA; ++i) va[S][i] = p.ldA(r0 + 64 * i, kt + D, c8);
#pragma unroll
        for (int i = 0; i < C::LB; ++i) vb[S][i] = p.ldB(r0 + 64 * i, kt + D, c8);
    }
    __builtin_amdgcn_sched_barrier(0);
    p.template pre<C>(kt, acc, wm, wn, lane);
#pragma unroll
    for (int ks = 0; ks < (NOMATH ? 0 : 4); ++ks) {
        bf16x8 a[C::MI], b[C::NI];
#pragma unroll
        for (int mi = 0; mi < C::MI; ++mi) a[mi] = *(const bf16x8*)(cur + lds_off(wm * (C::MI * 32) + mi * 32 + (lane & 31), ks * 2 + (lane >> 5)));
#pragma unroll
        for (int ni = 0; ni < C::NI; ++ni) b[ni] = *(const bf16x8*)(cur + C::BM * 128 + lds_off(wn * (C::NI * 32) + ni * 32 + (lane & 31), ks * 2 + (lane >> 5)));
#pragma unroll
        for (int mi = 0; mi < C::MI; ++mi)
#pragma unroll
            for (int ni = 0; ni < C::NI; ++ni) {
                if (SWAP) acc[mi][ni] = __builtin_amdgcn_mfma_f32_32x32x16_bf16(b[ni], a[mi], acc[mi][ni], 0, 0, 0);
                else      acc[mi][ni] = __builtin_amdgcn_mfma_f32_32x32x16_bf16(a[mi], b[ni], acc[mi][ni], 0, 0, 0);
            }
    }
    if (kt + 1 < nk) {
#pragma unroll
        for (int i = 0; i < C::LA; ++i) *(uint4*)(nxt + lds_off(r0 + 64 * i, c8)) = p.fixA(va[SN][i], r0 + 64 * i, kt + 1, c8);
#pragma unroll
        for (int i = 0; i < C::LB; ++i) *(uint4*)(nxt + C::BM * 128 + lds_off(r0 + 64 * i, c8)) = p.fixB(vb[SN][i], r0 + 64 * i, kt + 1, c8);
    }
    __syncthreads();
}

template <class P, class C, bool SWAP, int D = C::DEPTH, bool NOMATH = false>
__device__ __forceinline__ void gemm_core(P& p, char* smem, int nk, const int TID) {
    int tid = TID;
    asm volatile("" : "+v"(tid));
    const int lane = tid & 63, w = tid >> 6, wm = w / C::WN, wn = w % C::WN;
    const int c8 = tid & 7, r0 = tid >> 3;
    f32x16 acc[C::MI][C::NI];
#pragma unroll
    for (int i = 0; i < C::MI; ++i)
#pragma unroll
        for (int j = 0; j < C::NI; ++j)
#pragma unroll
            for (int r = 0; r < 16; ++r) acc[i][j][r] = 0.f;
    uint4 va[D][C::LA], vb[D][C::LB];
#pragma unroll
    for (int d = 0; d < D; ++d) {
        if (d < nk) {
#pragma unroll
            for (int i = 0; i < C::LA; ++i) va[d][i] = p.ldA(r0 + 64 * i, d, c8);
#pragma unroll
            for (int i = 0; i < C::LB; ++i) vb[d][i] = p.ldB(r0 + 64 * i, d, c8);
        }
    }
#pragma unroll
    for (int i = 0; i < C::LA; ++i) *(uint4*)(smem + lds_off(r0 + 64 * i, c8)) = p.fixA(va[0][i], r0 + 64 * i, 0, c8);
#pragma unroll
    for (int i = 0; i < C::LB; ++i) *(uint4*)(smem + C::BM * 128 + lds_off(r0 + 64 * i, c8)) = p.fixB(vb[0][i], r0 + 64 * i, 0, c8);
    __syncthreads();
    for (int kt = 0; kt < nk; kt += D) {
        gemm_iter<P, C, SWAP, D, 0, NOMATH>(p, smem, kt, nk, va, vb, acc, wm, wn, lane, r0, c8);
        if (D > 1 && kt + 1 < nk) gemm_iter<P, C, SWAP, D, 1, NOMATH>(p, smem, kt + 1, nk, va, vb, acc, wm, wn, lane, r0, c8);
        if (D > 2 && kt + 2 < nk) gemm_iter<P, C, SWAP, D, 2, NOMATH>(p, smem, kt + 2, nk, va, vb, acc, wm, wn, lane, r0, c8);
        if (D > 3 && kt + 3 < nk) gemm_iter<P, C, SWAP, D, 3, NOMATH>(p, smem, kt + 3, nk, va, vb, acc, wm, wn, lane, r0, c8);
    }
    int tid2 = tid;
    asm volatile("" : "+v"(tid2));
    p.template epi<C>(acc, (tid2 >> 6) / C::WN, (tid2 >> 6) % C::WN, tid2 & 63);
}

#define LAS3 __attribute__((address_space(3)))
template <class P, class C>
__device__ __forceinline__ void dma_stage(P& p, char* stage, int kt, int w, int lane) {
    const int rl = lane >> 3, cs = lane & 7;
#pragma unroll
    for (int i = 0; i < C::LA; ++i) {
        const int row = 64 * i + 8 * w + rl;
        __builtin_amdgcn_global_load_lds((const unsigned*)p.adA(row, kt, cs ^ ((row >> 1) & 7)), (LAS3 unsigned*)(stage + (64 * i + 8 * w) * 128), 16, 0, 0);
    }
#pragma unroll
    for (int i = 0; i < C::LB; ++i) {
        const int row = 64 * i + 8 * w + rl;
        __builtin_amdgcn_global_load_lds((const unsigned*)p.adB(row, kt, cs ^ ((row >> 1) & 7)), (LAS3 unsigned*)(stage + C::BM * 128 + (64 * i + 8 * w) * 128), 16, 0, 0);
    }
}
template <class P, class C, bool SWAP>
__device__ __forceinline__ void gemm_core_dma(P& p, char* smem, int nk, const int TID) {
    int tid = TID;
    asm volatile("" : "+v"(tid));
    const int lane = tid & 63, w = __builtin_amdgcn_readfirstlane(tid >> 6), wm = w / C::WN, wn = w % C::WN;
    f32x16 acc[C::MI][C::NI];
#pragma unroll
    for (int i = 0; i < C::MI; ++i)
#pragma unroll
        for (int j = 0; j < C::NI; ++j)
#pragma unroll
            for (int r = 0; r < 16; ++r) acc[i][j][r] = 0.f;
    dma_stage<P, C>(p, smem, 0, w, lane);
    __syncthreads();
    for (int kt = 0; kt < nk; ++kt) {
        char* cur = smem + (kt & 1) * C::STAGE;
        if (kt + 1 < nk) dma_stage<P, C>(p, smem + ((kt + 1) & 1) * C::STAGE, kt + 1, w, lane);
        __builtin_amdgcn_sched_barrier(0);
        bf16x8 a[2][C::MI], b[2][C::NI];
#pragma unroll
        for (int mi = 0; mi < C::MI; ++mi) a[0][mi] = *(const bf16x8*)(cur + lds_off(wm * (C::MI * 32) + mi * 32 + (lane & 31), (lane >> 5)));
#pragma unroll
        for (int ni = 0; ni < C::NI; ++ni) b[0][ni] = *(const bf16x8*)(cur + C::BM * 128 + lds_off(wn * (C::NI * 32) + ni * 32 + (lane & 31), (lane >> 5)));
#pragma unroll
        for (int ks = 0; ks < 4; ++ks) {
            if (ks < 3) {
#pragma unroll
                for (int mi = 0; mi < C::MI; ++mi) a[(ks + 1) & 1][mi] = *(const bf16x8*)(cur + lds_off(wm * (C::MI * 32) + mi * 32 + (lane & 31), (ks + 1) * 2 + (lane >> 5)));
#pragma unroll
                for (int ni = 0; ni < C::NI; ++ni) b[(ks + 1) & 1][ni] = *(const bf16x8*)(cur + C::BM * 128 + lds_off(wn * (C::NI * 32) + ni * 32 + (lane & 31), (ks + 1) * 2 + (lane >> 5)));
            }
            __builtin_amdgcn_sched_barrier(0);
#pragma unroll
            for (int mi = 0; mi < C::MI; ++mi)
#pragma unroll
                for (int ni = 0; ni < C::NI; ++ni) {
                    if (SWAP) acc[mi][ni] = __builtin_amdgcn_mfma_f32_32x32x16_bf16(b[ks & 1][ni], a[ks & 1][mi], acc[mi][ni], 0, 0, 0);
                    else      acc[mi][ni] = __builtin_amdgcn_mfma_f32_32x32x16_bf16(a[ks & 1][mi], b[ks & 1][ni], acc[mi][ni], 0, 0, 0);
                }
            __builtin_amdgcn_sched_barrier(0);
        }
        __syncthreads();
    }
    int tid2 = tid;
    asm volatile("" : "+v"(tid2));
    p.template epi<C>(acc, (tid2 >> 6) / C::WN, (tid2 >> 6) % C::WN, tid2 & 63);
}

__device__ __forceinline__ int lds_off64(int row, int c4) { return row * 64 + ((c4 ^ ((row >> 2) & 3)) << 4); }
template <class P, class C, bool SWAP>
__device__ __forceinline__ void gemm_core_dma4(P& p, char* smem, int nk, const int TID) {
    static_assert(C::BM == 256 && C::BN == 256, "sized for 256 x 256 tiles: 4 stages x 32 KiB");
    constexpr int STG = (C::BM + C::BN) * 64;
    int tid = TID;
    asm volatile("" : "+v"(tid));
    const int lane = tid & 63, w = __builtin_amdgcn_readfirstlane(tid >> 6), wm = w / C::WN, wn = w % C::WN;
    const int nsteps = nk * 2;
    f32x16 acc[C::MI][C::NI];
#pragma unroll
    for (int i = 0; i < C::MI; ++i)
#pragma unroll
        for (int j = 0; j < C::NI; ++j)
#pragma unroll
            for (int r = 0; r < 16; ++r) acc[i][j][r] = 0.f;
    const char* pa[2]; const char* pb[2];
#pragma unroll
    for (int i = 0; i < 2; ++i) {
        const int row = 32 * w + 16 * i + (lane >> 2);
        const int ch = (lane & 3) ^ ((row >> 2) & 3);
        pa[i] = (const char*)p.adA(row, 0, 0) + ch * 16;
        pb[i] = (const char*)p.adB(row, 0, 0) + ch * 16;
    }
#define DMA4_ISSUE(j) do { char* st_ = smem + ((j) & 3) * STG + (32 * w) * 64; _Pragma("unroll") for (int i_ = 0; i_ < 2; ++i_) { \
        __builtin_amdgcn_global_load_lds((const unsigned*)(pa[i_] + (size_t)(j) * 64), (LAS3 unsigned*)(st_ + i_ * 1024), 16, 0, 0); \
        __builtin_amdgcn_global_load_lds((const unsigned*)(pb[i_] + (size_t)(j) * 64), (LAS3 unsigned*)(st_ + C::BM * 64 + i_ * 1024), 16, 0, 0); } } while (0)
    DMA4_ISSUE(0);
    DMA4_ISSUE(1);
    for (int j = 0; j < nsteps; ++j) {
        if (j + 2 < nsteps) { DMA4_ISSUE(j + 2); asm volatile("s_waitcnt vmcnt(8)" ::: "memory"); }
        else if (j + 1 < nsteps) asm volatile("s_waitcnt vmcnt(4)" ::: "memory");
        else asm volatile("s_waitcnt vmcnt(0)" ::: "memory");
        __builtin_amdgcn_s_barrier();
        __builtin_amdgcn_sched_barrier(0);
        const char* cur = smem + (j & 3) * STG;
#pragma unroll
        for (int ks = 0; ks < 2; ++ks) {
            bf16x8 a[C::MI], b[C::NI];
#pragma unroll
            for (int mi = 0; mi < C::MI; ++mi) a[mi] = *(const bf16x8*)(cur + lds_off64(wm * (C::MI * 32) + mi * 32 + (lane & 31), ks * 2 + (lane >> 5)));
#pragma unroll
            for (int ni = 0; ni < C::NI; ++ni) b[ni] = *(const bf16x8*)(cur + C::BM * 64 + lds_off64(wn * (C::NI * 32) + ni * 32 + (lane & 31), ks * 2 + (lane >> 5)));
#pragma unroll
            for (int mi = 0; mi < C::MI; ++mi)
#pragma unroll
                for (int ni = 0; ni < C::NI; ++ni) {
                    if (SWAP) acc[mi][ni] = __builtin_amdgcn_mfma_f32_32x32x16_bf16(b[ni], a[mi], acc[mi][ni], 0, 0, 0);
                    else      acc[mi][ni] = __builtin_amdgcn_mfma_f32_32x32x16_bf16(a[mi], b[ni], acc[mi][ni], 0, 0, 0);
                }
        }
        __builtin_amdgcn_sched_barrier(0);
    }
#undef DMA4_ISSUE
    __syncthreads();
    int tid2 = tid;
    asm volatile("" : "+v"(tid2));
    p.template epi<C>(acc, (tid2 >> 6) / C::WN, (tid2 >> 6) % C::WN, tid2 & 63);
}

struct NoFix {
    __device__ __forceinline__ uint4 fixA(uint4 v, int, int, int) const { return v; }
    __device__ __forceinline__ uint4 fixB(uint4 v, int, int, int) const { return v; }
};
struct NoPre : NoFix { template <class C> __device__ __forceinline__ void pre(int, f32x16 (&)[C::MI][C::NI], int, int, int) {} };

#define PK4(A, g) make_uint2(pk_bf16((A)[(g) * 4 + 0], (A)[(g) * 4 + 1]), pk_bf16((A)[(g) * 4 + 2], (A)[(g) * 4 + 3]))

template <bool SWAP> struct PolProj : NoPre {
    const bf16_t* xA; const bf16_t* Bt; char* ws; int m0, n0, smask;
    __device__ __forceinline__ const bf16_t* adA(int row, int kt, int c8) const { return xA + (size_t)(m0 + row) * 1024 + kt * 64 + c8 * 8; }
    __device__ __forceinline__ const bf16_t* adB(int row, int kt, int c8) const { return Bt + (size_t)(n0 + row) * 1024 + kt * 64 + c8 * 8; }
    __device__ __forceinline__ uint4 ldA(int row, int kt, int c8) const { return *(const uint4*)adA(row, kt, c8); }
    __device__ __forceinline__ uint4 ldB(int row, int kt, int c8) const { return *(const uint4*)adB(row, kt, c8); }
    template <class C> __device__ __forceinline__ void epi(f32x16 (&acc)[C::MI][C::NI], int wm, int wn, int lane) const {
        static_assert(C::NI == 2, "rotary pairs need a 64-column wave tile");
        const int sec = n0 >> 10;
        bf16_t* Qb = (bf16_t*)(ws + R_Q); bf16_t* Kb = (bf16_t*)(ws + R_K); bf16_t* Ktb = (bf16_t*)(ws + R_KT);
        bf16_t* Vtb = (bf16_t*)(ws + R_VT); bf16_t* Gb = (bf16_t*)(ws + R_G);
        const float2* rot = (const float2*)(ws + R_ROT);
        const int mb = m0 + wm * (C::MI * 32);
        if (sec == 0) {
            const int cb = (n0 & 1023) + wn * 64;
            const int ib = ((cb & 255) >> 6) * 32 + (lane & 31);
            const int c1 = cb + (lane & 31);
#pragma unroll
            for (int mi = 0; mi < C::MI; ++mi)
#pragma unroll
                for (int r = 0; r < 16; ++r) {
                    const int tok = mb + mi * 32 + 8 * (r >> 2) + 4 * (lane >> 5) + (r & 3);
                    const float2 cs = rot[(size_t)(tok & smask) * 128 + ib];
                    const float x1 = acc[mi][0][r], x2 = acc[mi][1][r];
                    Qb[(size_t)tok * 1024 + c1] = f2bf(x1 * cs.x - x2 * cs.y);
                    Qb[(size_t)tok * 1024 + c1 + 32] = f2bf(x1 * cs.y + x2 * cs.x);
                }
        } else if (sec == 1) {
            const int cb = (n0 & 1023) + wn * 64;
            const int ib = ((cb & 255) >> 6) * 32 + (lane & 31);
            const int c1 = cb + (lane & 31);
#pragma unroll
            for (int mi = 0; mi < C::MI; ++mi)
#pragma unroll
                for (int g = 0; g < 4; ++g) {
                    const int tok0 = mb + mi * 32 + 8 * g + 4 * (lane >> 5);
                    float o1[4], o2[4];
#pragma unroll
                    for (int e = 0; e < 4; ++e) {
                        float2 cs = rot[(size_t)((tok0 + e) & smask) * 128 + ib];
                        float x1 = acc[mi][0][g * 4 + e], x2 = acc[mi][1][g * 4 + e];
                        o1[e] = x1 * cs.x - x2 * cs.y; o2[e] = x1 * cs.y + x2 * cs.x;
                        Kb[(size_t)(tok0 + e) * 1024 + c1] = f2bf(o1[e]);
                        Kb[(size_t)(tok0 + e) * 1024 + c1 + 32] = f2bf(o2[e]);
                    }
                    *(uint2*)(Ktb + ((size_t)(tok0 >> 7) * 1024 + c1) * 128 + (tok0 & 127)) = make_uint2(pk_bf16(o1[0], o1[1]), pk_bf16(o1[2], o1[3]));
                    *(uint2*)(Ktb + ((size_t)(tok0 >> 7) * 1024 + c1 + 32) * 128 + (tok0 & 127)) = make_uint2(pk_bf16(o2[0], o2[1]), pk_bf16(o2[2], o2[3]));
                    __builtin_amdgcn_sched_barrier(0);
                }
        } else if (sec < 4) {
#pragma unroll
            for (int mi = 0; mi < C::MI; ++mi) {
                const int tok = mb + mi * 32 + (lane & 31);
#pragma unroll
                for (int ni = 0; ni < 2; ++ni)
#pragma unroll
                    for (int r = 0; r < 16; ++r) {
                        const int col = n0 - 2048 + wn * 64 + ni * 32 + 8 * (r >> 2) + 4 * (lane >> 5) + (r & 3);
                        Vtb[((size_t)(tok >> 7) * 2048 + col) * 128 + (tok & 127)] = f2bf(acc[mi][ni][r]);
                    }
            }
        } else {
#pragma unroll
            for (int mi = 0; mi < C::MI; ++mi)
#pragma unroll
                for (int ni = 0; ni < 2; ++ni) {
                    const int col = n0 - 4096 + wn * 64 + ni * 32 + (lane & 31);
#pragma unroll
                    for (int r = 0; r < 16; ++r) {
                        const int tok = mb + mi * 32 + 8 * (r >> 2) + 4 * (lane >> 5) + (r & 3);
                        Gb[(size_t)tok * 2048 + col] = f2bf(acc[mi][ni][r]);
                    }
                }
        }
    }
};

#ifdef PROBE_MASK
struct PolNull : NoPre {
    float* sink;
    __device__ __forceinline__ uint4 ldA(int row, int kt, int c8) const { return make_uint4(row, kt, c8, 0x3f803f80u); }
    __device__ __forceinline__ uint4 ldB(int row, int kt, int c8) const { return make_uint4(0x3f803f80u, row ^ kt, c8, 0x3f803f80u); }
    template <class C> __device__ __forceinline__ void epi(f32x16 (&acc)[C::MI][C::NI], int wm, int wn, int lane) const {
        float t = 0.f;
#pragma unroll
        for (int mi = 0; mi < C::MI; ++mi)
#pragma unroll
            for (int ni = 0; ni < C::NI; ++ni)
#pragma unroll
                for (int r = 0; r < 16; ++r) t += acc[mi][ni][r];
        if (t == 123456.789f) *sink = t;
    }
};
#endif

#ifdef PROBE_MASK
struct PolLoadTest : NoPre {
    const bf16_t *A, *B; int lda; float* sink;
    __device__ __forceinline__ uint4 ldA(int row, int kt, int c8) const { return *(const uint4*)(A + (size_t)row * lda + kt * 64 + c8 * 8); }
    __device__ __forceinline__ uint4 ldB(int row, int kt, int c8) const { return *(const uint4*)(B + (size_t)row * lda + kt * 64 + c8 * 8); }
    template <class C> __device__ __forceinline__ void epi(f32x16 (&acc)[C::MI][C::NI], int, int, int) const { if (acc[0][0][0] == 123456.789f) *sink = 1.f; }
};
#endif

struct PolScore : NoPre {
    const bf16_t *A, *B; bf16_t* P; float lgf, lgb; char* smem;
    __device__ __forceinline__ const bf16_t* adA(int row, int kt, int c8) const { return A + (size_t)row * 1024 + kt * 64 + c8 * 8; }
    __device__ __forceinline__ const bf16_t* adB(int row, int kt, int c8) const { return B + (size_t)row * 1024 + kt * 64 + c8 * 8; }
    __device__ __forceinline__ uint4 ldA(int row, int kt, int c8) const { return *(const uint4*)adA(row, kt, c8); }
    __device__ __forceinline__ uint4 ldB(int row, int kt, int c8) const { return *(const uint4*)adB(row, kt, c8); }
    template <class C> __device__ __forceinline__ void epi(f32x16 (&acc)[C::MI][C::NI], int wm, int wn, int lane) const {
        float* tab = (float*)smem;
        const int tid = (wm * C::WN + wn) * 64 + lane;
        if (tid < 2 * RC - 1) { const int d = tid - (RC - 1); tab[tid] = (d >= 0) ? exp2f(lgf * (float)d) : exp2f(lgb * (float)(-d)); }
        __syncthreads();
#pragma unroll
        for (int mi = 0; mi < C::MI; ++mi)
#pragma unroll
            for (int ni = 0; ni < C::NI; ++ni) {
                const int j = wn * (C::NI * 32) + ni * 32 + (lane & 31);
#pragma unroll
                for (int r = 0; r < 16; ++r) {
                    const int i = wm * (C::MI * 32) + mi * 32 + 8 * (r >> 2) + 4 * (lane >> 5) + (r & 3);
                    P[(size_t)i * RC + j] = f2bf(acc[mi][ni][r] * tab[i - j + (RC - 1)]);
                }
            }
        __syncthreads();
    }
};

template <bool EMIT = true, bool SCALE = true> struct PolUscanT {
    const bf16_t *A, *B;
    bf16_t* UR;
    int nc, dir; float lg, dec, st, st2;
    __device__ __forceinline__ int rchunk(int kt) const { const int ci = kt >> 2; return dir ? (nc - 1 - ci) : ci; }
    __device__ __forceinline__ int chunk(int kt) const { return rchunk(kt) * 2 + ((kt & 3) >> 1); }
    __device__ __forceinline__ uint4 ldA(int row, int kt, int c8) const { return *(const uint4*)(A + (size_t)chunk(kt) * (2048 * 128) + (kt & 1) * 64 + (unsigned)(row * 128 + c8 * 8)); }
    __device__ __forceinline__ uint4 ldB(int row, int kt, int c8) const { return *(const uint4*)(B + (size_t)chunk(kt) * (1024 * 128) + (kt & 1) * 64 + (unsigned)(row * 128 + c8 * 8)); }
    __device__ __forceinline__ uint4 fixA(uint4 v, int, int, int) const { return v; }
    __device__ __forceinline__ uint4 fixB(uint4 v, int row, int kt, int c8) const {
        if (!SCALE) return v;
        const int j0 = (kt & 3) * 64 + c8 * 8;
        float w0 = exp2f(lg * (float)(dir ? j0 : (RC - 1 - j0)));
        float w1 = w0 * st;
        uint4 r;
        r.x = pk_bf16(bf_lo(v.x) * w0, bf_hi(v.x) * w1); w0 *= st2; w1 *= st2;
        r.y = pk_bf16(bf_lo(v.y) * w0, bf_hi(v.y) * w1); w0 *= st2; w1 *= st2;
        r.z = pk_bf16(bf_lo(v.z) * w0, bf_hi(v.z) * w1); w0 *= st2; w1 *= st2;
        r.w = pk_bf16(bf_lo(v.w) * w0, bf_hi(v.w) * w1);
        return r;
    }
    template <class C> __device__ __forceinline__ void pre(int kt, f32x16 (&acc)[C::MI][C::NI], int wm, int wn, int lane) const {
        if (kt & 3) return;
        const int ch = rchunk(kt);
        bf16_t* dst = UR + (size_t)ch * (4ull * 512 * 256);
#pragma unroll
        for (int mi = 0; mi < (EMIT ? C::MI : 0); ++mi)
#pragma unroll
            for (int ni = 0; ni < C::NI; ++ni) {
                const int n = wn * (C::NI * 32) + ni * 32 + (lane & 31);
#pragma unroll
                for (int r = 0; r < 16; ++r) {
                    const int m = wm * (C::MI * 32) + mi * 32 + 8 * (r >> 2) + 4 * (lane >> 5) + (r & 3);
                    dst[(size_t)m * 256 + n] = f2bf(acc[mi][ni][r]);
                }
            }
#pragma unroll
        for (int mi = 0; mi < C::MI; ++mi)
#pragma unroll
            for (int ni = 0; ni < C::NI; ++ni)
#pragma unroll
                for (int r = 0; r < 16; ++r) acc[mi][ni][r] *= dec;
    }
    template <class C> __device__ __forceinline__ void epi(f32x16 (&)[C::MI][C::NI], int, int, int) const {}
};

typedef PolUscanT<true, true> PolUscan;

struct PolO : NoPre {
    const bf16_t *Pp, *Qp, *Vp, *Rf, *Rb; bf16_t* O; float lgf, lgb; int half;
    __device__ __forceinline__ uint4 ldA(int row, int kt, int c8) const {
        if (kt < 4) return *(const uint4*)(Pp + kt * 64 + (unsigned)(row * RC + c8 * 8));
        const int kk = (kt - 4) & 3;
        return *(const uint4*)(Qp + kk * 64 + (unsigned)(row * 1024 + c8 * 8));
    }
    __device__ __forceinline__ uint4 fixA(uint4 v, int row, int kt, int) const {
        if (kt < 4) return v;
        const int seg = (kt - 4) >> 2, i = half * 128 + row;
        const float s = seg ? exp2f(lgb * (float)(RC - i)) : exp2f(lgf * (float)(i + 1));
        return scale8(v, s);
    }
    __device__ __forceinline__ uint4 ldB(int row, int kt, int c8) const {
        if (kt < 4) return *(const uint4*)(Vp + (size_t)(kt >> 1) * (2048 * 128) + (kt & 1) * 64 + (unsigned)(row * 128 + c8 * 8));
        const int seg = (kt - 4) >> 2, kk = (kt - 4) & 3;
        return *(const uint4*)((seg ? Rb : Rf) + kk * 64 + (unsigned)(row * 256 + c8 * 8));
    }
    template <class C> __device__ __forceinline__ void epi(f32x16 (&acc)[C::MI][C::NI], int wm, int wn, int lane) const {
#pragma unroll
        for (int mi = 0; mi < C::MI; ++mi)
#pragma unroll
            for (int ni = 0; ni < C::NI; ++ni) {
                const int n = wn * (C::NI * 32) + ni * 32 + (lane & 31);
#pragma unroll
                for (int r = 0; r < 16; ++r) {
                    const int m = wm * (C::MI * 32) + mi * 32 + 8 * (r >> 2) + 4 * (lane >> 5) + (r & 3);
                    O[(size_t)m * 2048 + n] = f2bf(acc[mi][ni][r]);
                }
            }
    }
};

struct PolResid : NoPre {
    const bf16_t *A, *B; int lda, ldb; const float* res; float* dst;
    __device__ __forceinline__ const bf16_t* adA(int row, int kt, int c8) const { return A + (size_t)row * lda + kt * 64 + c8 * 8; }
    __device__ __forceinline__ const bf16_t* adB(int row, int kt, int c8) const { return B + (size_t)row * ldb + kt * 64 + c8 * 8; }
    __device__ __forceinline__ uint4 ldA(int row, int kt, int c8) const { return *(const uint4*)adA(row, kt, c8); }
    __device__ __forceinline__ uint4 ldB(int row, int kt, int c8) const { return *(const uint4*)adB(row, kt, c8); }
    template <class C> __device__ __forceinline__ void epi(f32x16 (&acc)[C::MI][C::NI], int wm, int wn, int lane) const {
#pragma unroll
        for (int mi = 0; mi < C::MI; ++mi)
#pragma unroll
            for (int ni = 0; ni < C::NI; ++ni) {
                const int n = wn * (C::NI * 32) + ni * 32 + (lane & 31);
#pragma unroll
                for (int r = 0; r < 16; ++r) {
                    const int m = wm * (C::MI * 32) + mi * 32 + 8 * (r >> 2) + 4 * (lane >> 5) + (r & 3);
                    dst[(size_t)m * 1024 + n] = ALPHA * res[(size_t)m * 1024 + n] + acc[mi][ni][r];
                }
            }
    }
};

struct PolMoe1 : NoPre {
    const bf16_t *xb, *B; const int* idx; bf16_t* H; int n0;
    __device__ __forceinline__ const bf16_t* adA(int row, int kt, int c8) const { return xb + (size_t)idx[row] * 1024 + kt * 64 + c8 * 8; }
    __device__ __forceinline__ const bf16_t* adB(int row, int kt, int c8) const { return B + (size_t)row * 1024 + kt * 64 + c8 * 8; }
    __device__ __forceinline__ uint4 ldA(int row, int kt, int c8) const { return *(const uint4*)adA(row, kt, c8); }
    __device__ __forceinline__ uint4 ldB(int row, int kt, int c8) const { return *(const uint4*)adB(row, kt, c8); }
    template <class C> __device__ __forceinline__ void epi(f32x16 (&acc)[C::MI][C::NI], int wm, int wn, int lane) const {
        static_assert(C::NI == 2, "gate/up pairs need a 64-column wave tile");
        const int f = ((n0 + wn * 64) >> 1) + (lane & 31);
#pragma unroll
        for (int mi = 0; mi < C::MI; ++mi)
#pragma unroll
            for (int r = 0; r < 16; ++r) {
                const int m = wm * (C::MI * 32) + mi * 32 + 8 * (r >> 2) + 4 * (lane >> 5) + (r & 3);
                H[(size_t)m * 1024 + f] = f2bf(silu_f(acc[mi][0][r]) * acc[mi][1][r]);
            }
    }
};
struct PolMoe2 : NoPre {
    const bf16_t *A, *B; const float* gate; bf16_t* Y;
    __device__ __forceinline__ const bf16_t* adA(int row, int kt, int c8) const { return A + (size_t)row * 1024 + kt * 64 + c8 * 8; }
    __device__ __forceinline__ const bf16_t* adB(int row, int kt, int c8) const { return B + (size_t)row * 1024 + kt * 64 + c8 * 8; }
    __device__ __forceinline__ uint4 ldA(int row, int kt, int c8) const { return *(const uint4*)adA(row, kt, c8); }
    __device__ __forceinline__ uint4 ldB(int row, int kt, int c8) const { return *(const uint4*)adB(row, kt, c8); }
    template <class C> __device__ __forceinline__ void epi(f32x16 (&acc)[C::MI][C::NI], int wm, int wn, int lane) const {
#pragma unroll
        for (int mi = 0; mi < C::MI; ++mi)
#pragma unroll
            for (int r = 0; r < 16; ++r) {
                const int m = wm * (C::MI * 32) + mi * 32 + 8 * (r >> 2) + 4 * (lane >> 5) + (r & 3);
                const float gt = gate[m];
#pragma unroll
                for (int ni = 0; ni < C::NI; ++ni) Y[(size_t)m * 1024 + wn * (C::NI * 32) + ni * 32 + (lane & 31)] = f2bf(acc[mi][ni][r] * gt);
            }
    }
};
template <bool SWAP> struct PolQkv : NoPre {
    const bf16_t *A, *B; char* ws; int m0, n0;
    __device__ __forceinline__ const bf16_t* adA(int row, int kt, int c8) const { return A + (size_t)row * 1024 + kt * 64 + c8 * 8; }
    __device__ __forceinline__ const bf16_t* adB(int row, int kt, int c8) const { return B + (size_t)row * 1024 + kt * 64 + c8 * 8; }
    __device__ __forceinline__ uint4 ldA(int row, int kt, int c8) const { return *(const uint4*)adA(row, kt, c8); }
    __device__ __forceinline__ uint4 ldB(int row, int kt, int c8) const { return *(const uint4*)adB(row, kt, c8); }
    template <class C> __device__ __forceinline__ void epi(f32x16 (&acc)[C::MI][C::NI], int wm, int wn, int lane) const {
        const int mb = m0 + wm * (C::MI * 32);
        if (!SWAP) {
            bf16_t* dstb = (bf16_t*)(ws + ((n0 >> 10) ? N_K : N_Q));
#pragma unroll
            for (int mi = 0; mi < C::MI; ++mi)
#pragma unroll
                for (int ni = 0; ni < C::NI; ++ni) {
                    const int hh = ((n0 & 1023) + wn * (C::NI * 32) + ni * 32) >> 5;
#pragma unroll
                    for (int r = 0; r < 16; ++r) {
                        const int tok = mb + mi * 32 + 8 * (r >> 2) + 4 * (lane >> 5) + (r & 3);
                        dstb[((size_t)hh * T_ALL + tok) * 32 + (lane & 31)] = f2bf(acc[mi][ni][r]);
                    }
                }
        } else {
            bf16_t* Vt = (bf16_t*)(ws + N_VT);
#pragma unroll
            for (int mi = 0; mi < C::MI; ++mi) {
                const int tok = mb + mi * 32 + (lane & 31);
#pragma unroll
                for (int ni = 0; ni < C::NI; ++ni)
#pragma unroll
                    for (int r = 0; r < 16; ++r) {
                        const int col = n0 - 2048 + wn * (C::NI * 32) + ni * 32 + 8 * (r >> 2) + 4 * (lane >> 5) + (r & 3);
                        Vt[(size_t)col * T_ALL + tok] = f2bf(acc[mi][ni][r]);
                    }
            }
        }
    }
};

__device__ __forceinline__ void transpose_tile(const float* src0, const float* src1, int ld, bf16_t* dst, int K, int n0, int k0, int mode, char* smem, const int TID) {
    float* tile = (float*)smem;
    const int t = TID;
    {
        const int n4 = (t & 15) * 4, kr = t >> 4;
        const int np = n0 + n4;
        const float* s = src0; int col = np;
        if (mode == 1 && np < 2048) {
            const int base = np & ~255, r = np & 255, g = r >> 5, u = r & 31;
            const int i = g * 16 + (u & 15);
            col = base + ((u < 16) ? i : (i + 128));
        } else if (mode == 2) {
            const int g = np >> 5, u = np & 31;
            if (u >= 16) s = src1;
            col = g * 16 + (u & 15);
        }
        float4 v[8];
#pragma unroll
        for (int kk = 0; kk < 8; ++kk) v[kk] = *(const float4*)(s + (size_t)(k0 + kr + 32 * kk) * ld + col);
#pragma unroll
        for (int kk = 0; kk < 8; ++kk) {
            const int k = kr + 32 * kk;
            tile[k * 65 + n4 + 0] = v[kk].x; tile[k * 65 + n4 + 1] = v[kk].y; tile[k * 65 + n4 + 2] = v[kk].z; tile[k * 65 + n4 + 3] = v[kk].w;
        }
    }
    __syncthreads();
    {
        const int n = t >> 3, kc = (t & 7) * 32;
        const int np = n0 + n;
        float sc = 1.f;
        if (mode == 1 && np >= 1024 && np < 2048) sc = 0.0625f;
        if (mode == 3 && np < 1024) sc = 0.17677669529663687f * 1.4426950408889634f;
        unsigned o[16];
#pragma unroll
        for (int j = 0; j < 16; ++j) o[j] = pk_bf16(tile[(kc + 2 * j) * 65 + n] * sc, tile[(kc + 2 * j + 1) * 65 + n] * sc);
        uint4* d = (uint4*)(dst + (size_t)np * K + k0 + kc);
        d[0] = make_uint4(o[0], o[1], o[2], o[3]);
        d[1] = make_uint4(o[4], o[5], o[6], o[7]);
        d[2] = make_uint4(o[8], o[9], o[10], o[11]);
        d[3] = make_uint4(o[12], o[13], o[14], o[15]);
    }
    __syncthreads();
}
__device__ void convert_matrix(const float* src0, const float* src1, int ld, bf16_t* dst, int N, int K, int mode, char* smem, int& rot, const int TID, int wid, int nw) {
    const int ntn = N / 64, ntk = K / 256, nt = ntn * ntk;
    if (wid >= 0) {
        int start = (wid + nw - (rot % nw)) % nw;
        for (int t = start; t < nt; t += nw) transpose_tile(src0, src1, ld, dst, K, (t % ntn) * 64, (t / ntn) * 256, mode, smem, TID);
    }
    rot += nt;
}

template <int MODE_SRC, bool WRITE_XB, bool ROUTER>
__device__ void ln_phase(const Params& p, const float* gam, const float* bet, const float* wr, size_t xb_off, char* smem, const int TID) {
    float* wrT = (float*)smem;
    if (ROUTER) {
        for (int i0 = TID; i0 < 16 * 1024; i0 += 8 * NT) {
            float wv[8];
#pragma unroll
            for (int j = 0; j < 8; ++j) wv[j] = wr[i0 + j * NT];
#pragma unroll
            for (int j = 0; j < 8; ++j) { const int i = i0 + j * NT; wrT[(i & 15) * 1024 + (i >> 4)] = wv[j]; }
        }
        __syncthreads();
    }
    const int lane = TID & 63, w = TID >> 6;
    bf16_t* xb = (bf16_t*)(p.ws + xb_off);
    const bf16_t* ye = (const bf16_t*)(p.ws + M_YE);
    const int* pos = (const int*)(p.ws + M_POS);
    float* aff = (float*)(p.ws + M_AFF);
    const int tstride = gridDim.x * 8;
    int tok = blockIdx.x * 8 + w;
    float4 nv[4]; int npos = -1;
    if (tok < T_ALL) {
#pragma unroll
        for (int k = 0; k < 4; ++k) nv[k] = *(const float4*)(p.out + (size_t)tok * 1024 + k * 256 + lane * 4);
        if (MODE_SRC == 1) npos = pos[(size_t)tok * 16 + (lane & 15)];
    }
    for (; tok < T_ALL; tok += tstride) {
        float* xr = p.out + (size_t)tok * 1024;
        float4 v[4];
#pragma unroll
        for (int k = 0; k < 4; ++k) v[k] = nv[k];
        const int cpos = npos;
        if (tok + tstride < T_ALL) {
#pragma unroll
            for (int k = 0; k < 4; ++k) nv[k] = *(const float4*)(p.out + (size_t)(tok + tstride) * 1024 + k * 256 + lane * 4);
            if (MODE_SRC == 1) npos = pos[(size_t)(tok + tstride) * 16 + (lane & 15)];
        }
        if (MODE_SRC == 1) {
#pragma unroll
            for (int k = 0; k < 4; ++k) { v[k].x *= ALPHA; v[k].y *= ALPHA; v[k].z *= ALPHA; v[k].w *= ALPHA; }
            const int trunk = tok >= T_PROMPT;
            const int cap = trunk ? CAP_S : CAP_P;
            const size_t rb = trunk ? (size_t)16 * CAP_P : 0;
            unsigned long long m = __ballot(cpos >= 0) & 0xffffull;
            while (m) {
                const int e0 = __builtin_ctzll(m); m &= m - 1;
                const int e1 = m ? __builtin_ctzll(m) : -1; if (m) m &= m - 1;
                const int p0 = __builtin_amdgcn_readlane(cpos, e0);
                const int p1 = __builtin_amdgcn_readlane(cpos, e1 >= 0 ? e1 : e0);
                const bf16_t* y0 = ye + (rb + (size_t)e0 * cap + p0) * 1024;
                const bf16_t* y1 = ye + (rb + (size_t)(e1 >= 0 ? e1 : e0) * cap + (e1 >= 0 ? p1 : p0)) * 1024;
                uint2 u0[4], u1[4];
#pragma unroll
                for (int k = 0; k < 4; ++k) { u0[k] = *(const uint2*)(y0 + k * 256 + lane * 4); u1[k] = *(const uint2*)(y1 + k * 256 + lane * 4); }
                const float s1 = (e1 >= 0) ? 1.f : 0.f;
#pragma unroll
                for (int k = 0; k < 4; ++k) {
                    v[k].x += bf_lo(u0[k].x); v[k].y += bf_hi(u0[k].x); v[k].z += bf_lo(u0[k].y); v[k].w += bf_hi(u0[k].y);
                    v[k].x += s1 * bf_lo(u1[k].x); v[k].y += s1 * bf_hi(u1[k].x); v[k].z += s1 * bf_lo(u1[k].y); v[k].w += s1 * bf_hi(u1[k].y);
                }
            }
        }
        float s = 0.f;
#pragma unroll
        for (int k = 0; k < 4; ++k) s += v[k].x + v[k].y + v[k].z + v[k].w;
        const float mu = wave_sum(s) * (1.f / 1024.f);
        float q = 0.f;
#pragma unroll
        for (int k = 0; k < 4; ++k) {
            v[k].x -= mu; v[k].y -= mu; v[k].z -= mu; v[k].w -= mu;
            q += v[k].x * v[k].x + v[k].y * v[k].y + v[k].z * v[k].z + v[k].w * v[k].w;
        }
        const float rstd = rsqrtf(wave_sum(q) * (1.f / 1024.f) + LN_EPS);
#pragma unroll
        for (int k = 0; k < 4; ++k) {
            const float4 g = *(const float4*)(gam + k * 256 + lane * 4);
            const float4 b = *(const float4*)(bet + k * 256 + lane * 4);
            v[k].x = v[k].x * rstd * g.x + b.x; v[k].y = v[k].y * rstd * g.y + b.y;
            v[k].z = v[k].z * rstd * g.z + b.z; v[k].w = v[k].w * rstd * g.w + b.w;
            *(float4*)(xr + k * 256 + lane * 4) = v[k];
            if (WRITE_XB) *(uint2*)(xb + (size_t)tok * 1024 + k * 256 + lane * 4) = make_uint2(pk_bf16(v[k].x, v[k].y), pk_bf16(v[k].z, v[k].w));
        }
        if (ROUTER) {
            float mylog = -1e30f;
#pragma unroll 2
            for (int e = 0; e < 16; ++e) {
                float a = 0.f;
#pragma unroll
                for (int k = 0; k < 4; ++k) {
                    const float4 wv = *(const float4*)(wrT + e * 1024 + k * 256 + lane * 4);
                    a += v[k].x * wv.x + v[k].y * wv.y + v[k].z * wv.z + v[k].w * wv.w;
                }
                a = wave_sum(a);
                if (lane == e) mylog = a;
            }
            const float mx = row16_max(mylog);
            const float ex = (lane < 16) ? expf(mylog - mx) : 0.f;
            const float mine = ex / row16_sum(ex);
            if (lane < 16) {
                const int trunk = tok >= T_PROMPT;
                const int tt = trunk ? T3 : T_PROMPT;
                const int tl = trunk ? tok - T_PROMPT : tok;
                aff[(trunk ? (size_t)T_PROMPT * 16 : 0) + (size_t)lane * tt + tl] = mine;
            }
        }
    }
    __syncthreads();
}

template <int NPT>
__device__ __forceinline__ void topk_item(const float* a, int cap, int* idx, float* gate, int* pos, int e, char* smem, const int TID) {
    int* part = (int*)smem;
    int* sh_cnt = (int*)(smem + 64);
    unsigned key[NPT];
#pragma unroll
    for (int k = 0; k < NPT; ++k) key[k] = __float_as_uint(a[k * NT + TID]);
    if (TID == 0) *sh_cnt = 0;
    const int lane = TID & 63, w = TID >> 6;
    u64 pref = 0ull;
    for (int bit = 45; bit >= 0; --bit) {
        const u64 cand = pref | (1ull << bit);
        const unsigned cb = (unsigned)(cand >> 15), ci = (unsigned)(cand & 32767ull);
        int c = 0;
        const int lim = 32767 - TID - (int)ci;
#pragma unroll
        for (int k = 0; k < NPT; ++k) c += (key[k] > cb || (key[k] == cb && k * NT <= lim)) ? 1 : 0;
#pragma unroll
        for (int o = 32; o > 0; o >>= 1) c += __shfl_xor(c, o, 64);
        int* pp = part + (bit & 1) * 8;
        if (lane == 0) pp[w] = c;
        __syncthreads();
        const int tot = pp[0] + pp[1] + pp[2] + pp[3] + pp[4] + pp[5] + pp[6] + pp[7];
        if (tot >= cap) pref = cand;
    }
    const unsigned cb = (unsigned)(pref >> 15), ci = (unsigned)(pref & 32767ull);
    int mine = 0;
    const int lim = 32767 - TID - (int)ci;
#pragma unroll
    for (int k = 0; k < NPT; ++k) mine += (key[k] > cb || (key[k] == cb && k * NT <= lim)) ? 1 : 0;
    int slot = atomicAdd(sh_cnt, mine);
    const float* ap = a + TID;
    int* pp = pos + (size_t)TID * 16 + e;
#pragma unroll 4
    for (int k = 0; k < NPT; ++k) {
        const float av = ap[(size_t)k * NT];
        const unsigned kb = __float_as_uint(av);
        const bool sel = (kb > cb || (kb == cb && k * NT <= lim));
        int ps = -1;
        if (sel) { ps = slot++; idx[ps] = k * NT + TID; gate[ps] = av; }
        pp[(size_t)k * (NT * 16)] = ps;
    }
    __syncthreads();
}
__device__ void topk_phase(const Params& p, char* smem, const int TID) {
    const float* aff = (const float*)(p.ws + M_AFF);
    int* idx = (int*)(p.ws + M_IDX);
    float* gate = (float*)(p.ws + M_GATE);
    int* pos = (int*)(p.ws + M_POS);
    for (int item = blockIdx.x; item < 32; item += gridDim.x) {
        const int trunk = item >> 4, e = item & 15;
        if (trunk == 0) topk_item<64>(aff + (size_t)e * T_PROMPT, CAP_P, idx + (size_t)e * CAP_P, gate + (size_t)e * CAP_P, pos, e, smem, TID);
        else topk_item<32>(aff + (size_t)T_PROMPT * 16 + (size_t)e * T3, CAP_S, idx + (size_t)16 * CAP_P + (size_t)e * CAP_S, gate + (size_t)16 * CAP_P + (size_t)e * CAP_S,
                           pos + (size_t)T_PROMPT * 16, e, smem, TID);
    }
}

typedef unsigned u32x2v __attribute__((ext_vector_type(2)));
__device__ __forceinline__ float xrow_max(float v) {
    u32x2v r = __builtin_amdgcn_permlane16_swap(__float_as_uint(v), __float_as_uint(v), false, false);
    v = fmaxf(__uint_as_float(r[0]), __uint_as_float(r[1]));
    r = __builtin_amdgcn_permlane32_swap(__float_as_uint(v), __float_as_uint(v), false, false);
    return fmaxf(__uint_as_float(r[0]), __uint_as_float(r[1]));
}
__device__ __forceinline__ float xrow_sum(float v) {
    u32x2v r = __builtin_amdgcn_permlane16_swap(__float_as_uint(v), __float_as_uint(v), false, false);
    v = __uint_as_float(r[0]) + __uint_as_float(r[1]);
    r = __builtin_amdgcn_permlane32_swap(__float_as_uint(v), __float_as_uint(v), false, false);
    return __uint_as_float(r[0]) + __uint_as_float(r[1]);
}

constexpr int NA_VSTR = 1936;
constexpr int NA_SK = 0, NA_SV = 61440, NA_SB = 61440 + 32 * NA_VSTR;
__device__ void na_phase(const Params& p, char* smem, const int TID) {
    const bf16_t* Qh = (const bf16_t*)(p.ws + N_Q);
    const bf16_t* Kh = (const bf16_t*)(p.ws + N_K);
    const bf16_t* NVt = (const bf16_t*)(p.ws + N_VT);
    bf16_t* O = (bf16_t*)(p.ws + M_XB2);
    char* sK = smem + NA_SK; char* sV = smem + NA_SV; float* sB = (float*)(smem + NA_SB);
    const int lane = TID & 63, w = TID >> 6, qi = lane & 15, hi = lane >> 4;
    for (int item = blockIdx.x; item < 96 * 32; item += gridDim.x) {
        const int h = item & 31, rgp = item >> 5;
        int seq_base, rows, g;
        if (rgp < 64) { seq_base = (rgp >> 2) * 2048; rows = 32; g = rgp & 3; }
        else { seq_base = T_PROMPT; rows = 256; g = rgp - 64; }
        const int r0 = g * 8;
        const int rs0 = min(max(r0 - 4, 0), rows - 8), rs1 = min(max(r0 + 3, 0), rows - 8);
        const int nrows = rs1 + 8 - rs0;
        __syncthreads();
        {
            const uint4* src = (const uint4*)(Kh + ((size_t)h * T_ALL + seq_base + rs0 * 64) * 32);
            const int nk16 = nrows * 256, nv16 = nrows * 8;
            uint4 kv[8], vv[8];
#pragma unroll
            for (int i = 0; i < 8; ++i) kv[i] = src[min(TID + i * NT, nk16 - 1)];
#pragma unroll
            for (int j = 0; j < 4; ++j) {
                const uint4* vs = (const uint4*)(NVt + (size_t)(h * 32 + w + 8 * j) * T_ALL + seq_base + rs0 * 64);
#pragma unroll
                for (int i = 0; i < 2; ++i) vv[j * 2 + i] = vs[min(lane + 64 * i, nv16 - 1)];
            }
#define NA_PIN4(v) asm volatile("" : "+v"((v).x), "+v"((v).y), "+v"((v).z), "+v"((v).w))
#pragma unroll
            for (int i = 0; i < 8; ++i) { NA_PIN4(kv[i]); NA_PIN4(vv[i]); }
#undef NA_PIN4
#pragma unroll
            for (int i = 0; i < 8; ++i) { const int c = TID + i * NT; if (c < nk16) ((uint4*)sK)[c] = kv[i]; }
#pragma unroll
            for (int j = 0; j < 4; ++j)
#pragma unroll
                for (int i = 0; i < 2; ++i) { const int c = lane + 64 * i; if (c < nv16) *(uint4*)(sV + (w + 8 * j) * NA_VSTR + c * 16) = vv[j * 2 + i]; }
            for (int c = TID; c < 465; c += NT) sB[c] = p.na_rpb[h * 465 + c] * 1.4426950408889634f;
        }
        __syncthreads();
        const int r = r0 + w;
        const int rs = min(max(r - 4, 0), rows - 8);
        const int lr0 = rs - rs0;
#pragma unroll 1
        for (int qb = 0; qb < 4; ++qb) {
            const int c = qb * 16 + qi;
            const int cs = min(max(c - 8, 0), 48);
            const int kb0 = min(max(qb - 1, 0), 1);
            const int tq = seq_base + r * 64 + c;
            const bf16x8 qf = *(const bf16x8*)(Qh + ((size_t)h * T_ALL + tq) * 32 + hi * 8);
            typedef float f32x2v __attribute__((ext_vector_type(2)));
            f32x2v s[24][2];
            f32x2v mk[3][2];
#pragma unroll
            for (int jb = 0; jb < 3; ++jb)
#pragma unroll
                for (int e = 0; e < 4; ++e) {
                    const int kcol = (kb0 + jb) * 16 + 4 * hi + e;
                    mk[jb][e >> 1][e & 1] = ((kcol >= cs) && (kcol < cs + 16)) ? 0.f : -1e30f;
                }
            float mx = -1e30f;
#pragma unroll
            for (int a = 0; a < 8; ++a)
#pragma unroll
                for (int jb = 0; jb < 3; ++jb) {
                    const int kcb = (kb0 + jb) * 16;
                    const bf16x8 kf = *(const bf16x8*)(sK + ((lr0 + a) * 64 + kcb + qi) * 64 + hi * 16);
                    f32x4 z = {0.f, 0.f, 0.f, 0.f};
                    const f32x4 sc = __builtin_amdgcn_mfma_f32_16x16x32_bf16(kf, qf, z, 0, 0, 0);
                    const float* rpr = sB + (rs + a - r + 7) * 31;
                    f32x2v bv[2];
#pragma unroll
                    for (int e = 0; e < 4; ++e) bv[e >> 1][e & 1] = rpr[min(max(kcb + 4 * hi + e - c + 15, 0), 30)];
                    const f32x2v v0 = (f32x2v){sc[0], sc[1]} + (bv[0] + mk[jb][0]);
                    const f32x2v v1 = (f32x2v){sc[2], sc[3]} + (bv[1] + mk[jb][1]);
                    s[a * 3 + jb][0] = v0; s[a * 3 + jb][1] = v1;
                    mx = fmaxf(fmaxf(mx, fmaxf(v0[0], v0[1])), fmaxf(v1[0], v1[1]));
                }
            mx = xrow_max(mx);
            const f32x2v mxv = {mx, mx};
            f32x2v sumv = {0.f, 0.f};
#pragma unroll
            for (int t = 0; t < 24; ++t)
#pragma unroll
                for (int hh = 0; hh < 2; ++hh) {
                    const f32x2v d = s[t][hh] - mxv;
                    f32x2v pv; pv[0] = __builtin_amdgcn_exp2f(d[0]); pv[1] = __builtin_amdgcn_exp2f(d[1]);
                    s[t][hh] = pv; sumv += pv;
                }
            const float inv = __builtin_amdgcn_rcpf(xrow_sum(sumv[0] + sumv[1]));
            const f32x2v invv = {inv, inv};
            f32x4 o0 = {0.f, 0.f, 0.f, 0.f}, o1 = {0.f, 0.f, 0.f, 0.f};
            const char* vr0 = sV + qi * NA_VSTR;
            const char* vr1 = sV + (16 + qi) * NA_VSTR;
#pragma unroll
            for (int pi = 0; pi < 12; ++pi) {
                const int t0 = 2 * pi, t1 = 2 * pi + 1;
                const int ka = ((lr0 + t0 / 3) * 64 + (kb0 + t0 % 3) * 16 + 4 * hi) * 2;
                const int kb = ((lr0 + t1 / 3) * 64 + (kb0 + t1 % 3) * 16 + 4 * hi) * 2;
                union { bf16x8 v; unsigned u[4]; } pf, v0, v1;
                const f32x2v q00 = s[t0][0] * invv, q01 = s[t0][1] * invv, q10 = s[t1][0] * invv, q11 = s[t1][1] * invv;
                pf.u[0] = pk_bf16(q00[0], q00[1]); pf.u[1] = pk_bf16(q01[0], q01[1]);
                pf.u[2] = pk_bf16(q10[0], q10[1]); pf.u[3] = pk_bf16(q11[0], q11[1]);
                const uint2 a0 = *(const uint2*)(vr0 + ka), b0 = *(const uint2*)(vr0 + kb);
                const uint2 a1 = *(const uint2*)(vr1 + ka), b1 = *(const uint2*)(vr1 + kb);
                v0.u[0] = a0.x; v0.u[1] = a0.y; v0.u[2] = b0.x; v0.u[3] = b0.y;
                v1.u[0] = a1.x; v1.u[1] = a1.y; v1.u[2] = b1.x; v1.u[3] = b1.y;
                o0 = __builtin_amdgcn_mfma_f32_16x16x32_bf16(pf.v, v0.v, o0, 0, 0, 0);
                o1 = __builtin_amdgcn_mfma_f32_16x16x32_bf16(pf.v, v1.v, o1, 0, 0, 0);
            }
#pragma unroll
            for (int e = 0; e < 4; ++e) {
                const int q = 4 * hi + e;
                bf16_t* dst = O + (size_t)(seq_base + r * 64 + qb * 16 + q) * 1024 + h * 32 + qi;
                dst[0] = f2bf(o0[e]);
                dst[16] = f2bf(o1[e]);
            }
        }
    }
}

#define XB_TMO      128
#define XB_XCNT(j)  (256  + 64 * (j))
#define XB_XSUB(j)  (1280 + 64 * (j))
#define XB_XGEN(j)  (2304 + 64 * (j))
#define XB_TOP      3328
#define XB_TOPGEN   3392
#define XCD_BAR_WORDS 3456
#define XB_SPIN_CAP (1u << 18)
__device__ __forceinline__ unsigned xb_ld(unsigned* p)              { return __hip_atomic_load(p, __ATOMIC_RELAXED, __HIP_MEMORY_SCOPE_AGENT); }
__device__ __forceinline__ unsigned xb_add(unsigned* p, unsigned v) { return __hip_atomic_fetch_add(p, v, __ATOMIC_RELAXED, __HIP_MEMORY_SCOPE_AGENT); }
__device__ __forceinline__ unsigned xb_xcc_id() { return (unsigned)__builtin_amdgcn_s_getreg((3 << 11) | 20) & 0xFu; }
#define XB_SPIN(cond, bar) do { unsigned _sp = 0; while (cond) { __builtin_amdgcn_s_sleep(1); \
    if ((++_sp & 255u) == 0u) { if (xb_ld(&(bar)[XB_TMO])) break; if (_sp > XB_SPIN_CAP) { atomicAdd(&(bar)[XB_TMO], 1u); break; } } } } while (0)
struct XcdBarrier { unsigned* bar; unsigned x; volatile LAS3 unsigned* st; };
__device__ __forceinline__ XcdBarrier xcd_barrier_post(unsigned* bar, volatile LAS3 unsigned* st, int tid) {
    XcdBarrier b; b.bar = bar; b.x = xb_xcc_id(); b.st = st;
    if (tid == 0) (void)xb_add(&bar[XB_XCNT(b.x)], 1u);
    return b;
}
__device__ __forceinline__ void xcd_barrier_complete(unsigned* bar, unsigned x, unsigned& nloc, unsigned& nx) {
    const unsigned G = gridDim.x * gridDim.y * gridDim.z;
    unsigned sum, cnt, mine, sp = 0u;
    for (;;) {
        sum = 0u; cnt = 0u; mine = 0u;
#pragma unroll
        for (unsigned j = 0; j < 16; ++j) { const unsigned c = xb_ld(&bar[XB_XCNT(j)]); sum += c; cnt += (c > 0u) ? 1u : 0u; mine = (j == x) ? c : mine; }
        if (sum == G) break;
        __builtin_amdgcn_s_sleep(1);
        if ((++sp & 255u) == 0u) { if (xb_ld(&bar[XB_TMO])) break; if (sp > XB_SPIN_CAP) { atomicAdd(&bar[XB_TMO], 1u); break; } }
    }
    nloc = mine > 0u ? mine : 1u; nx = cnt > 0u ? cnt : 1u;
}
__device__ __forceinline__ void xcd_barrier(const XcdBarrier& b, int tid) {
    asm volatile("s_waitcnt vmcnt(0)" ::: "memory");
    __syncthreads();
    if (tid == 0) {
        unsigned* bar = b.bar;
        __builtin_amdgcn_s_waitcnt(0);
        unsigned nloc = b.st[0], nx = b.st[1];
        if (nloc == 0u) { xcd_barrier_complete(bar, b.x, nloc, nx); b.st[0] = nloc; b.st[1] = nx; }
        const unsigned old = xb_add(&bar[XB_XSUB(b.x)], 1u);
        const unsigned gen = old / nloc;
        if (old + 1u == (gen + 1u) * nloc) {
            __builtin_amdgcn_fence(__ATOMIC_RELEASE, "agent");
            asm volatile("s_waitcnt vmcnt(0)" ::: "memory");
            const unsigned og = xb_add(&bar[XB_TOP], 1u);
            const unsigned tg = og / nx;
            if (og + 1u == (tg + 1u) * nx) xb_add(&bar[XB_TOPGEN], 1u);
            else XB_SPIN(xb_ld(&bar[XB_TOPGEN]) == tg, bar);
            __builtin_amdgcn_fence(__ATOMIC_ACQUIRE, "agent");
            xb_add(&bar[XB_XGEN(b.x)], 1u);
            asm volatile("s_waitcnt vmcnt(0)" ::: "memory");
        } else {
            XB_SPIN(xb_ld(&bar[XB_XGEN(b.x)]) == gen, bar);
            __builtin_amdgcn_fence(__ATOMIC_ACQUIRE, "agent");
            asm volatile("s_waitcnt vmcnt(0)" ::: "memory");
        }
    }
    __syncthreads();
}

__device__ __forceinline__ bool tile_map(int k, int MT, int NTN, int MS, int NS, int& m, int& n) {
    const int bid = blockIdx.x;
    if (gridDim.x != 256) { const int t = k * gridDim.x + bid; if (t >= MT * NTN) return false; m = t / NTN; n = t % NTN; return true; }
    const int NG = NTN / NS, total = (MT / MS) * NG;
    const int s = k * 8 + (bid & 7);
    if (s >= total) return false;
    const int j = bid >> 3;
    m = (s / NG) * MS + j / NS; n = (s % NG) * NS + j % NS;
    return true;
}

enum { PH_PRE = 0, PH_R0 = 1  , PH_LN0A = 16, PH_TOPK0, PH_MOE1_0, PH_MOE2_0, PH_LN0B, PH_QKV, PH_NA, PH_NAOUT, PH_LN1A, PH_TOPK1, PH_MOE1_1, PH_MOE2_1, PH_LN1B, PH_COUNT };

namespace pg8 {
#define PG8_LAS __attribute__((address_space(3)))
typedef unsigned short bf16_t;
typedef short bf16x8 __attribute__((ext_vector_type(8)));
typedef float f32x4 __attribute__((ext_vector_type(4)));
typedef unsigned u32x4 __attribute__((ext_vector_type(4)));
constexpr int BM = 256, BK = 64, HALF = 128, HTB = HALF * BK * 2  , STAGE_BYTES = 8 * HTB, NXCD = 8, WGM = 8;

__host__ __device__ __forceinline__ int lds_byte(int r, int c) { const int st = (r >> 4) * 2 + (c >> 5), rr = r & 15, cc = c & 31, ob = rr * 64 + cc * 2; return st * 1024 + (ob ^ (((ob >> 9) & 1) << 5)); }
__host__ __device__ __forceinline__ void stage_rc(int b, int& R, int& C) { const int st = b / 1024, sb = b % 1024, swz = sb ^ (((sb >> 9) & 1) << 5); R = (st >> 1) * 16 + swz / 64; C = (st & 1) * 32 + (swz % 64) / 2; }
__host__ __device__ __forceinline__ int perm32(int rho) { const int n = rho >> 4, i = rho & 15; return 8 * (i >> 2) + 4 * n + (i & 3); }

struct Unit { int pm, pn; };
struct Gemm { const bf16_t* A; const bf16_t* Bt; int M, N, K; };

template <class Epi, class Sched, bool STAMP = false>
__device__ __forceinline__ void gemm_phase(PG8_LAS unsigned char* lds, const Gemm g, const Sched& S, const Epi& E, unsigned long long* stamps, const int tid_in) {
    const int tid = tid_in, wid = __builtin_amdgcn_readfirstlane(tid >> 6), lane = tid & 63, wr = wid >> 2, wc = wid & 3, fr = lane & 15, fq = lane >> 4;
    const int K = g.K, nt = K / BK;
    int ts_lo = 0, ts_hi = 0, nts = 0; const unsigned long long rt_entry = STAMP ? (unsigned long long)wall_clock64() : 0ull;
#define PG8_STAMP() do { if (STAMP && wid == 0 && nts < 64) { const unsigned long long _c = (unsigned long long)clock64(); \
        ts_lo = (lane == nts) ? (int)(unsigned)_c : ts_lo; ts_hi = (lane == nts) ? (int)(unsigned)(_c >> 32) : ts_hi; ++nts; } } while (0)
    PG8_STAMP();
    unsigned voffA[2], voffB[2];
#pragma unroll
    for (int i = 0; i < 2; ++i) { int R, C; stage_rc(tid * 16 + i * 8192, R, C); const int Rb = Epi::PERM ? ((R & ~31) + perm32(R & 31)) : R;
        voffA[i] = (unsigned)(R * K + C) * 2u; voffB[i] = (unsigned)(Rb * K + C) * 2u; }
    const size_t kstep = (size_t)(BK * 2);
    const size_t hstep = (size_t)HALF * K * 2;
    const size_t tstep = 2 * hstep;
    const unsigned ldsw = (unsigned)wid * 1024u;
    const int aoff = lds_byte(wr * 64 + fr, fq * 8), boff = lds_byte(wc * 32 + fr, fq * 8);
#define PG8_SA(b, h) (((b) * 2 + (h)) * HTB)
#define PG8_SB(b, h) ((4 + (b) * 2 + (h)) * HTB)
#define PG8_STAGE(bufoff, gbase, voff) do { _Pragma("unroll") for (int _i = 0; _i < 2; ++_i) \
        __builtin_amdgcn_global_load_lds((const unsigned*)((const char*)(gbase) + (voff)[_i]), (PG8_LAS unsigned*)(lds + (bufoff) + ldsw + _i * 8192), 16, 0, 0); } while (0)
#define PG8_LDA(dst, b, h) do { _Pragma("unroll") for (int m = 0; m < 4; ++m) _Pragma("unroll") for (int k = 0; k < 2; ++k) dst[m][k] = *(const PG8_LAS bf16x8*)(lds + PG8_SA(b, h) + aoff + m * 2048 + k * 1024); } while (0)
#define PG8_LDB(dst, b, h) do { _Pragma("unroll") for (int n = 0; n < 2; ++n) _Pragma("unroll") for (int k = 0; k < 2; ++k) dst[n][k] = *(const PG8_LAS bf16x8*)(lds + PG8_SB(b, h) + boff + n * 2048 + k * 1024); } while (0)
#define PG8_MMA(ai, bj, At, Bt) do { __builtin_amdgcn_s_setprio(1); _Pragma("unroll") for (int m = 0; m < 4; ++m) _Pragma("unroll") for (int n = 0; n < 2; ++n) _Pragma("unroll") for (int k = 0; k < 2; ++k) \
        acc[ai][bj][m][n] = __builtin_amdgcn_mfma_f32_16x16x32_bf16(Bt[n][k], At[m][k], acc[ai][bj][m][n], 0, 0, 0); __builtin_amdgcn_s_setprio(0); } while (0)
#define PG8_WAIT_V(n) asm volatile("s_waitcnt vmcnt(" #n ")" ::: "memory")
#define PG8_WAIT_L(n) asm volatile("s_waitcnt lgkmcnt(" #n ")" ::: "memory")
#define PG8_BAR __builtin_amdgcn_s_barrier()
#define PG8_SCHED __builtin_amdgcn_sched_barrier(0)
    Unit cur, nxt; int ui = 0;
    if (!S.next(0, cur)) return;
    f32x4 acc[2][2][4][2];
#pragma unroll
    for (int a = 0; a < 2; ++a)
#pragma unroll
        for (int b = 0; b < 2; ++b)
#pragma unroll
            for (int m = 0; m < 4; ++m)
#pragma unroll
                for (int n = 0; n < 2; ++n) acc[a][b][m][n] = (f32x4){0.f, 0.f, 0.f, 0.f};
    bf16x8 At[4][2], B0[2][2], B1[2][2];
    const char* cA = (const char*)g.A + (size_t)cur.pm * tstep; const char* cB = (const char*)g.Bt + (size_t)cur.pn * tstep;
    S.a_ready(cur);
    PG8_STAGE(PG8_SB(0, 0), cB, voffB); PG8_STAGE(PG8_SA(0, 0), cA, voffA); PG8_STAGE(PG8_SB(0, 1), cB + hstep, voffB); PG8_STAGE(PG8_SA(0, 1), cA + hstep, voffA);
    if (wr == 1) PG8_BAR;
    PG8_WAIT_V(4); PG8_BAR;
    PG8_STAGE(PG8_SB(1, 0), cB + kstep, voffB); PG8_STAGE(PG8_SA(1, 0), cA + kstep, voffA); PG8_STAGE(PG8_SB(1, 1), cB + hstep + kstep, voffB);
    PG8_WAIT_V(6); PG8_BAR;
    PG8_STAMP();
    for (;;) {
        const bool has_next = S.next(ui + 1, nxt);
        const char* nA = has_next ? (const char*)g.A + (size_t)nxt.pm * tstep : cA; const char* nB = has_next ? (const char*)g.Bt + (size_t)nxt.pn * tstep : cB;
        for (int t = 0; t < nt; t += 2) {
            const bool last = (t == nt - 2);
            const char* a1 = cA + (size_t)(t + 1) * kstep;
            const char* a2 = last ? nA : cA + (size_t)(t + 2) * kstep; const char* b2 = last ? nB : cB + (size_t)(t + 2) * kstep;
            const char* a3 = a2 + kstep; const char* b3 = b2 + kstep;
            if (last && has_next) S.a_ready(nxt);
            PG8_LDB(B0, 0, 0); PG8_SCHED; PG8_LDA(At, 0, 0); PG8_STAGE(PG8_SA(1, 1), a1 + hstep, voffA);
            PG8_WAIT_L(8); PG8_BAR; PG8_WAIT_L(0); PG8_MMA(0, 0, At, B0); PG8_BAR; PG8_SCHED;
            PG8_LDB(B1, 0, 1); PG8_STAGE(PG8_SB(0, 0), b2, voffB);
            PG8_BAR; PG8_WAIT_L(0); PG8_MMA(0, 1, At, B1); PG8_BAR;
            PG8_LDA(At, 0, 1); PG8_STAGE(PG8_SA(0, 0), a2, voffA);
            PG8_BAR; PG8_WAIT_L(0); PG8_MMA(1, 0, At, B0); PG8_BAR; PG8_SCHED;
            PG8_STAGE(PG8_SB(0, 1), b2 + hstep, voffB);
            PG8_WAIT_V(6); PG8_BAR; PG8_MMA(1, 1, At, B1); PG8_BAR;
            PG8_LDB(B0, 1, 0); PG8_SCHED; PG8_LDA(At, 1, 0); PG8_STAGE(PG8_SA(0, 1), a2 + hstep, voffA);
            PG8_WAIT_L(8); PG8_BAR; PG8_WAIT_L(0); PG8_MMA(0, 0, At, B0); PG8_BAR; PG8_SCHED;
            PG8_LDB(B1, 1, 1); PG8_STAGE(PG8_SB(1, 0), b3, voffB);
            PG8_BAR; PG8_WAIT_L(0); PG8_MMA(0, 1, At, B1); PG8_BAR;
            PG8_LDA(At, 1, 1); PG8_STAGE(PG8_SA(1, 0), a3, voffA);
            PG8_BAR; PG8_WAIT_L(0); PG8_MMA(1, 0, At, B0); PG8_BAR; PG8_SCHED;
            PG8_STAGE(PG8_SB(1, 1), b3 + hstep, voffB);
            PG8_WAIT_V(6); PG8_BAR; PG8_MMA(1, 1, At, B1); PG8_BAR;
        }
        PG8_STAMP();
        if constexpr (!Epi::AFTER_DRAIN) { E(acc, cur, wr, wc, fr, fq); S.done(cur); }
        PG8_STAMP();
        if (!has_next) break;
#pragma unroll
        for (int a = 0; a < 2; ++a)
#pragma unroll
            for (int b = 0; b < 2; ++b)
#pragma unroll
                for (int m = 0; m < 4; ++m)
#pragma unroll
                    for (int n = 0; n < 2; ++n) acc[a][b][m][n] = (f32x4){0.f, 0.f, 0.f, 0.f};
        cur = nxt; cA = nA; cB = nB; ++ui;
    }
    PG8_WAIT_V(0);
    if (wr == 0) PG8_BAR;
    PG8_BAR;
    if constexpr (Epi::AFTER_DRAIN) { E.fused(acc, cur, wr, wc, fr, fq, lds, wid, lane); S.done(cur); }
    PG8_STAMP();
    if (STAMP && wid == 0) { stamps[lane] = lane < nts ? (((unsigned long long)(unsigned)ts_hi << 32) | (unsigned)ts_lo) : 0ull;
        if (lane == 62) stamps[62] = rt_entry; if (lane == 63) stamps[63] = (unsigned long long)wall_clock64(); }
#undef PG8_STAMP
#undef PG8_SA
#undef PG8_SB
#undef PG8_STAGE
#undef PG8_LDA
#undef PG8_LDB
#undef PG8_MMA
#undef PG8_WAIT_V
#undef PG8_WAIT_L
#undef PG8_BAR
#undef PG8_SCHED
}
template <class Epi, class Sched, bool STAMP = false>
__device__ __forceinline__ void gemm_phase_gather(PG8_LAS unsigned char* lds, const Gemm g, const Sched& S, const Epi& E, unsigned long long* stamps, const int tid_in, const int* gidx, int split_row, int split_add) {
    const int tid = tid_in, wid = __builtin_amdgcn_readfirstlane(tid >> 6), lane = tid & 63, wr = wid >> 2, wc = wid & 3, fr = lane & 15, fq = lane >> 4;
    const int K = g.K, nt = K / BK;
    int ts_lo = 0, ts_hi = 0, nts = 0; const unsigned long long rt_entry = STAMP ? (unsigned long long)wall_clock64() : 0ull;
#define PG8_STAMP() do { if (STAMP && wid == 0 && nts < 64) { const unsigned long long _c = (unsigned long long)clock64(); \
        ts_lo = (lane == nts) ? (int)(unsigned)_c : ts_lo; ts_hi = (lane == nts) ? (int)(unsigned)(_c >> 32) : ts_hi; ++nts; } } while (0)
    PG8_STAMP();
    unsigned voffA[2], voffB[2];
    int Rg[2], Cg[2];
#pragma unroll
    for (int i = 0; i < 2; ++i) { int R, C; stage_rc(tid * 16 + i * 8192, R, C); const int Rb = Epi::PERM ? ((R & ~31) + perm32(R & 31)) : R;
        voffA[i] = (unsigned)(R * K + C) * 2u; voffB[i] = (unsigned)(Rb * K + C) * 2u; Rg[i] = R; Cg[i] = C; }
    unsigned voffC[2][2], voffN[2][2];
#define PG8_GOFF(dst, unit) do { _Pragma("unroll") for (int _h = 0; _h < 2; ++_h) _Pragma("unroll") for (int _i = 0; _i < 2; ++_i) { \
        const int _r = (unit).pm * BM + _h * HALF + Rg[_i]; const int _src = gidx[_r] + (_r >= split_row ? split_add : 0); dst[_h][_i] = (unsigned)(_src * K + Cg[_i]) * 2u; } } while (0)
#define PG8_STAGE_A(bufoff, kbytes, VO, h) do { _Pragma("unroll") for (int _i = 0; _i < 2; ++_i) \
        __builtin_amdgcn_global_load_lds((const unsigned*)(cA + (kbytes) + (VO)[h][_i]), (PG8_LAS unsigned*)(lds + (bufoff) + ldsw + _i * 8192), 16, 0, 0); } while (0)
    const size_t kstep = (size_t)(BK * 2);
    const size_t hstep = (size_t)HALF * K * 2;
    const size_t tstep = 2 * hstep;
    const unsigned ldsw = (unsigned)wid * 1024u;
    const int aoff = lds_byte(wr * 64 + fr, fq * 8), boff = lds_byte(wc * 32 + fr, fq * 8);
#define PG8_SA(b, h) (((b) * 2 + (h)) * HTB)
#define PG8_SB(b, h) ((4 + (b) * 2 + (h)) * HTB)
#define PG8_STAGE(bufoff, gbase, voff) do { _Pragma("unroll") for (int _i = 0; _i < 2; ++_i) \
        __builtin_amdgcn_global_load_lds((const unsigned*)((const char*)(gbase) + (voff)[_i]), (PG8_LAS unsigned*)(lds + (bufoff) + ldsw + _i * 8192), 16, 0, 0); } while (0)
#define PG8_LDA(dst, b, h) do { _Pragma("unroll") for (int m = 0; m < 4; ++m) _Pragma("unroll") for (int k = 0; k < 2; ++k) dst[m][k] = *(const PG8_LAS bf16x8*)(lds + PG8_SA(b, h) + aoff + m * 2048 + k * 1024); } while (0)
#define PG8_LDB(dst, b, h) do { _Pragma("unroll") for (int n = 0; n < 2; ++n) _Pragma("unroll") for (int k = 0; k < 2; ++k) dst[n][k] = *(const PG8_LAS bf16x8*)(lds + PG8_SB(b, h) + boff + n * 2048 + k * 1024); } while (0)
#define PG8_MMA(ai, bj, At, Bt) do { __builtin_amdgcn_s_setprio(1); _Pragma("unroll") for (int m = 0; m < 4; ++m) _Pragma("unroll") for (int n = 0; n < 2; ++n) _Pragma("unroll") for (int k = 0; k < 2; ++k) \
        acc[ai][bj][m][n] = __builtin_amdgcn_mfma_f32_16x16x32_bf16(Bt[n][k], At[m][k], acc[ai][bj][m][n], 0, 0, 0); __builtin_amdgcn_s_setprio(0); } while (0)
#define PG8_WAIT_V(n) asm volatile("s_waitcnt vmcnt(" #n ")" ::: "memory")
#define PG8_WAIT_L(n) asm volatile("s_waitcnt lgkmcnt(" #n ")" ::: "memory")
#define PG8_BAR __builtin_amdgcn_s_barrier()
#define PG8_SCHED __builtin_amdgcn_sched_barrier(0)
    Unit cur, nxt; int ui = 0;
    if (!S.next(0, cur)) return;
    f32x4 acc[2][2][4][2];
#pragma unroll
    for (int a = 0; a < 2; ++a)
#pragma unroll
        for (int b = 0; b < 2; ++b)
#pragma unroll
            for (int m = 0; m < 4; ++m)
#pragma unroll
                for (int n = 0; n < 2; ++n) acc[a][b][m][n] = (f32x4){0.f, 0.f, 0.f, 0.f};
    bf16x8 At[4][2], B0[2][2], B1[2][2];
    const char* cA = (const char*)g.A; const char* cB = (const char*)g.Bt + (size_t)cur.pn * tstep;
    S.a_ready(cur);
    PG8_GOFF(voffC, cur);
    PG8_STAGE(PG8_SB(0, 0), cB, voffB); PG8_STAGE_A(PG8_SA(0, 0), 0, voffC, 0); PG8_STAGE(PG8_SB(0, 1), cB + hstep, voffB); PG8_STAGE_A(PG8_SA(0, 1), 0, voffC, 1);
    if (wr == 1) PG8_BAR;
    PG8_WAIT_V(4); PG8_BAR;
    PG8_STAGE(PG8_SB(1, 0), cB + kstep, voffB); PG8_STAGE_A(PG8_SA(1, 0), kstep, voffC, 0); PG8_STAGE(PG8_SB(1, 1), cB + hstep + kstep, voffB);
    PG8_WAIT_V(6); PG8_BAR;
    PG8_STAMP();
    for (;;) {
        const bool has_next = S.next(ui + 1, nxt);
        const char* nB = has_next ? (const char*)g.Bt + (size_t)nxt.pn * tstep : cB;
#pragma unroll
        for (int _h = 0; _h < 2; ++_h)
#pragma unroll
            for (int _i = 0; _i < 2; ++_i) voffN[_h][_i] = voffC[_h][_i];
        for (int t = 0; t < nt; t += 2) {
            const bool last = (t == nt - 2);
            const size_t kb1 = (size_t)(t + 1) * kstep;
            const size_t kb2 = last ? 0 : (size_t)(t + 2) * kstep; const char* b2 = last ? nB : cB + (size_t)(t + 2) * kstep;
            const size_t kb3 = kb2 + kstep; const char* b3 = b2 + kstep;
            if (last && has_next) { S.a_ready(nxt); PG8_GOFF(voffN, nxt); }
            unsigned v2[2][2];
#pragma unroll
            for (int _h = 0; _h < 2; ++_h)
#pragma unroll
                for (int _i = 0; _i < 2; ++_i) v2[_h][_i] = last ? voffN[_h][_i] : voffC[_h][_i];
            PG8_LDB(B0, 0, 0); PG8_SCHED; PG8_LDA(At, 0, 0); PG8_STAGE_A(PG8_SA(1, 1), kb1, voffC, 1);
            PG8_WAIT_L(8); PG8_BAR; PG8_WAIT_L(0); PG8_MMA(0, 0, At, B0); PG8_BAR; PG8_SCHED;
            PG8_LDB(B1, 0, 1); PG8_STAGE(PG8_SB(0, 0), b2, voffB);
            PG8_BAR; PG8_WAIT_L(0); PG8_MMA(0, 1, At, B1); PG8_BAR;
            PG8_LDA(At, 0, 1); PG8_STAGE_A(PG8_SA(0, 0), kb2, v2, 0);
            PG8_BAR; PG8_WAIT_L(0); PG8_MMA(1, 0, At, B0); PG8_BAR; PG8_SCHED;
            PG8_STAGE(PG8_SB(0, 1), b2 + hstep, voffB);
            PG8_WAIT_V(6); PG8_BAR; PG8_MMA(1, 1, At, B1); PG8_BAR;
            PG8_LDB(B0, 1, 0); PG8_SCHED; PG8_LDA(At, 1, 0); PG8_STAGE_A(PG8_SA(0, 1), kb2, v2, 1);
            PG8_WAIT_L(8); PG8_BAR; PG8_WAIT_L(0); PG8_MMA(0, 0, At, B0); PG8_BAR; PG8_SCHED;
            PG8_LDB(B1, 1, 1); PG8_STAGE(PG8_SB(1, 0), b3, voffB);
            PG8_BAR; PG8_WAIT_L(0); PG8_MMA(0, 1, At, B1); PG8_BAR;
            PG8_LDA(At, 1, 1); PG8_STAGE_A(PG8_SA(1, 0), kb3, v2, 0);
            PG8_BAR; PG8_WAIT_L(0); PG8_MMA(1, 0, At, B0); PG8_BAR; PG8_SCHED;
            PG8_STAGE(PG8_SB(1, 1), b3 + hstep, voffB);
            PG8_WAIT_V(6); PG8_BAR; PG8_MMA(1, 1, At, B1); PG8_BAR;
        }
        PG8_STAMP();
        if constexpr (!Epi::AFTER_DRAIN) { E(acc, cur, wr, wc, fr, fq); S.done(cur); }
        PG8_STAMP();
        if (!has_next) break;
#pragma unroll
        for (int a = 0; a < 2; ++a)
#pragma unroll
            for (int b = 0; b < 2; ++b)
#pragma unroll
                for (int m = 0; m < 4; ++m)
#pragma unroll
                    for (int n = 0; n < 2; ++n) acc[a][b][m][n] = (f32x4){0.f, 0.f, 0.f, 0.f};
        cur = nxt; cB = nB; ++ui;
#pragma unroll
        for (int _h = 0; _h < 2; ++_h)
#pragma unroll
            for (int _i = 0; _i < 2; ++_i) voffC[_h][_i] = voffN[_h][_i];
    }
    PG8_WAIT_V(0);
    if (wr == 0) PG8_BAR;
    PG8_BAR;
    if constexpr (Epi::AFTER_DRAIN) { E.fused(acc, cur, wr, wc, fr, fq, lds, wid, lane); S.done(cur); }
    PG8_STAMP();
    if (STAMP && wid == 0) { stamps[lane] = lane < nts ? (((unsigned long long)(unsigned)ts_hi << 32) | (unsigned)ts_lo) : 0ull;
        if (lane == 62) stamps[62] = rt_entry; if (lane == 63) stamps[63] = (unsigned long long)wall_clock64(); }
#undef PG8_STAMP
#undef PG8_SA
#undef PG8_SB
#undef PG8_STAGE
#undef PG8_STAGE_A
#undef PG8_GOFF
#undef PG8_LDA
#undef PG8_LDB
#undef PG8_MMA
#undef PG8_WAIT_V
#undef PG8_WAIT_L
#undef PG8_BAR
#undef PG8_SCHED
}
}

struct Pg8SchedMoe2 {
    __device__ bool next(int i, pg8::Unit& u) const {
        int tm, nt; if (!tile_map(i, 384, 4, 8, 4, tm, nt)) return false;
        const int e = (tm < 256) ? (tm >> 4) : ((tm - 256) >> 3);
        u.pm = tm; u.pn = e * 4 + nt; return true;
    }
    __device__ __forceinline__ void a_ready(const pg8::Unit&) const {}
    __device__ __forceinline__ void done(const pg8::Unit&) const {}
};
struct Pg8EpiMoe2 {
    static constexpr bool PERM = false, AFTER_DRAIN = false;
    const float* gate; bf16_t* Y;
    __device__ __forceinline__ void operator()(const pg8::f32x4 (&acc)[2][2][4][2], const pg8::Unit& u, int wr, int wc, int fr, int fq) const {
        const int row0 = u.pm * 256 + wr * 64 + fr, col0 = (u.pn & 3) * 256 + wc * 32 + 4 * fq;
#pragma unroll
        for (int ai = 0; ai < 2; ++ai)
#pragma unroll
            for (int m = 0; m < 4; ++m) {
                const int row = row0 + ai * 128 + m * 16;
                const float gt = gate[row];
                bf16_t* rowp = Y + (size_t)row * 1024 + col0;
#pragma unroll
                for (int bj = 0; bj < 2; ++bj)
#pragma unroll
                    for (int n = 0; n < 2; ++n) {
                        const pg8::f32x4 v = acc[ai][bj][m][n];
                        *(uint2*)(rowp + bj * 128 + n * 16) = make_uint2(pk_bf16(v[0] * gt, v[1] * gt), pk_bf16(v[2] * gt, v[3] * gt));
                    }
            }
    }
};

struct Pg8Sched {
    int MT, NTN, MS, NS, wid, nw;
    __device__ bool next(int i, pg8::Unit& u) const {
        if (nw == 256 && gridDim.x == 256) return tile_map(i, MT, NTN, MS, NS, u.pm, u.pn);
        if (wid < 0) return false;
        const int t = wid + i * nw; if (t >= MT * NTN) return false;
        u.pm = t / NTN; u.pn = t % NTN; return true;
    }
    __device__ __forceinline__ void a_ready(const pg8::Unit&) const {}
    __device__ __forceinline__ void done(const pg8::Unit&) const {}
};
struct Pg8EpiResid {
    static constexpr bool PERM = false, AFTER_DRAIN = false;
    const float* res; float* dst;
    __device__ __forceinline__ void operator()(const pg8::f32x4 (&acc)[2][2][4][2], const pg8::Unit& u, int wr, int wc, int fr, int fq) const {
        const int row0 = u.pm * 256 + wr * 64 + fr, col0 = u.pn * 256 + wc * 32 + 4 * fq;
#pragma unroll
        for (int ai = 0; ai < 2; ++ai)
#pragma unroll
            for (int m = 0; m < 4; ++m) {
                const size_t ro = (size_t)(row0 + ai * 128 + m * 16) * 1024 + col0;
#pragma unroll
                for (int bj = 0; bj < 2; ++bj)
#pragma unroll
                    for (int n = 0; n < 2; ++n) {
                        const float4 x = *(const float4*)(res + ro + bj * 128 + n * 16);
                        const pg8::f32x4 v = acc[ai][bj][m][n];
                        *(float4*)(dst + ro + bj * 128 + n * 16) = make_float4(ALPHA * x.x + v[0], ALPHA * x.y + v[1], ALPHA * x.z + v[2], ALPHA * x.w + v[3]);
                    }
            }
    }
};
struct Pg8EpiQK {
    static constexpr bool PERM = false, AFTER_DRAIN = false;
    char* ws;
    __device__ __forceinline__ void operator()(const pg8::f32x4 (&acc)[2][2][4][2], const pg8::Unit& u, int wr, int wc, int fr, int fq) const {
        const int n0 = u.pn * 256;
        bf16_t* dstb = (bf16_t*)(ws + ((n0 >> 10) ? N_K : N_Q));
        const int row0 = u.pm * 256 + wr * 64 + fr;
#pragma unroll
        for (int ai = 0; ai < 2; ++ai)
#pragma unroll
            for (int m = 0; m < 4; ++m) {
                const int tok = row0 + ai * 128 + m * 16;
#pragma unroll
                for (int bj = 0; bj < 2; ++bj) {
                    const int hh = ((n0 & 1023) + bj * 128 + wc * 32) >> 5;
#pragma unroll
                    for (int n = 0; n < 2; ++n) {
                        const pg8::f32x4 v = acc[ai][bj][m][n];
                        *(uint2*)(dstb + ((size_t)hh * T_ALL + tok) * 32 + n * 16 + 4 * fq) = make_uint2(pk_bf16(v[0], v[1]), pk_bf16(v[2], v[3]));
                    }
                }
            }
    }
};
struct Pg8EpiRows {
    static constexpr bool PERM = false, AFTER_DRAIN = false;
    bf16_t* O; size_t ldc;
    __device__ __forceinline__ void operator()(const pg8::f32x4 (&acc)[2][2][4][2], const pg8::Unit& u, int wr, int wc, int fr, int fq) const {
        const int row0 = u.pm * 256 + wr * 64 + fr, col0 = u.pn * 256 + wc * 32 + 4 * fq;
#pragma unroll
        for (int ai = 0; ai < 2; ++ai)
#pragma unroll
            for (int m = 0; m < 4; ++m) {
                bf16_t* rowp = O + (size_t)(row0 + ai * 128 + m * 16) * ldc + col0;
#pragma unroll
                for (int bj = 0; bj < 2; ++bj)
#pragma unroll
                    for (int n = 0; n < 2; ++n) {
                        const pg8::f32x4 v = acc[ai][bj][m][n];
                        *(uint2*)(rowp + bj * 128 + n * 16) = make_uint2(pk_bf16(v[0], v[1]), pk_bf16(v[2], v[3]));
                    }
            }
    }
};

struct Pg8EpiQKrot {
    static constexpr bool PERM = false, AFTER_DRAIN = false;
    char* ws; int smask;
    __device__ __forceinline__ void operator()(const pg8::f32x4 (&acc)[2][2][4][2], const pg8::Unit& u, int wr, int wc, int fr, int fq) const {
        const int n0 = u.pn * 256;
        const bool isk = (n0 >> 10) != 0;
        bf16_t* nat = (bf16_t*)(ws + (isk ? R_K : R_Q));
        bf16_t* Ktb = (bf16_t*)(ws + R_KT);
        const float2* rot = (const float2*)(ws + R_ROT);
        const int row0 = u.pm * 256 + wr * 64 + fr;
#pragma unroll
        for (int ai = 0; ai < 2; ++ai)
#pragma unroll
            for (int m = 0; m < 4; ++m) {
                const int tok = row0 + ai * 128 + m * 16;
                const float2* rr = rot + (size_t)(tok & smask) * 128;
#pragma unroll
                for (int bj = 0; bj < 2; ++bj) {
                    const int cb = (n0 & 1023) + bj * 128 + wc * 32;
                    const int ib = ((cb & 255) >> 5) * 16 + 4 * fq;
                    const float4 cs01 = *(const float4*)(rr + ib), cs23 = *(const float4*)(rr + ib + 2);
                    const pg8::f32x4 x1 = acc[ai][bj][m][0], x2 = acc[ai][bj][m][1];
                    const float o10 = x1[0] * cs01.x - x2[0] * cs01.y, o20 = x1[0] * cs01.y + x2[0] * cs01.x;
                    const float o11 = x1[1] * cs01.z - x2[1] * cs01.w, o21 = x1[1] * cs01.w + x2[1] * cs01.z;
                    const float o12 = x1[2] * cs23.x - x2[2] * cs23.y, o22 = x1[2] * cs23.y + x2[2] * cs23.x;
                    const float o13 = x1[3] * cs23.z - x2[3] * cs23.w, o23 = x1[3] * cs23.w + x2[3] * cs23.z;
                    const unsigned p10 = pk_bf16(o10, o11), p11 = pk_bf16(o12, o13), p20 = pk_bf16(o20, o21), p21 = pk_bf16(o22, o23);
                    bf16_t* dst = nat + (size_t)tok * 1024 + cb + 4 * fq;
                    *(uint2*)dst = make_uint2(p10, p11);
                    *(uint2*)(dst + 16) = make_uint2(p20, p21);
                    if (isk) {
                        bf16_t* kt = Ktb + ((size_t)(tok >> 7) * 1024 + cb + 4 * fq) * 128 + (tok & 127);
                        kt[0 * 128] = (bf16_t)(p10 & 0xffffu); kt[1 * 128] = (bf16_t)(p10 >> 16); kt[2 * 128] = (bf16_t)(p11 & 0xffffu); kt[3 * 128] = (bf16_t)(p11 >> 16);
                        kt[16 * 128] = (bf16_t)(p20 & 0xffffu); kt[17 * 128] = (bf16_t)(p20 >> 16); kt[18 * 128] = (bf16_t)(p21 & 0xffffu); kt[19 * 128] = (bf16_t)(p21 >> 16);
                    }
                }
            }
    }
};
struct Pg8EpiVtBlk {
    static constexpr bool PERM = false, AFTER_DRAIN = false;
    bf16_t* Vt;
    __device__ __forceinline__ void operator()(const pg8::f32x4 (&acc)[2][2][4][2], const pg8::Unit& u, int wr, int wc, int fr, int fq) const {
        const int row0 = u.pm * 256 + wr * 64 + fr, col0 = u.pn * 256 + wc * 32 + 4 * fq;
#pragma unroll
        for (int ai = 0; ai < 2; ++ai)
#pragma unroll
            for (int m = 0; m < 4; ++m) {
                const int row = row0 + ai * 128 + m * 16;
#pragma unroll
                for (int bj = 0; bj < 2; ++bj)
#pragma unroll
                    for (int n = 0; n < 2; ++n) {
                        const int tok0 = col0 + bj * 128 + n * 16;
                        const pg8::f32x4 v = acc[ai][bj][m][n];
                        *(uint2*)(Vt + ((size_t)(tok0 >> 7) * 2048 + row) * 128 + (tok0 & 127)) = make_uint2(pk_bf16(v[0], v[1]), pk_bf16(v[2], v[3]));
                    }
            }
    }
};

struct Pg8SchedMoe1 {
    __device__ bool next(int i, pg8::Unit& u) const {
        int tm, nt;
        if (gridDim.x == 256) { if (!tile_map(i, 384, 8, 4, 8, tm, nt)) return false; }
        else { const int t = blockIdx.x + i * gridDim.x; if (t >= 384 * 8) return false; tm = t >> 3; nt = t & 7; }
        const int e = (tm < 256) ? (tm >> 4) : ((tm - 256) >> 3);
        u.pm = tm; u.pn = e * 8 + nt; return true;
    }
    __device__ __forceinline__ void a_ready(const pg8::Unit&) const {}
    __device__ __forceinline__ void done(const pg8::Unit&) const {}
};
struct Pg8EpiMoe1 {
    static constexpr bool PERM = false, AFTER_DRAIN = false;
    bf16_t* H;
    __device__ __forceinline__ void operator()(const pg8::f32x4 (&acc)[2][2][4][2], const pg8::Unit& u, int wr, int wc, int fr, int fq) const {
        const int row0 = u.pm * 256 + wr * 64 + fr, f0 = (u.pn & 7) * 128 + wc * 16 + 4 * fq;
#pragma unroll
        for (int ai = 0; ai < 2; ++ai)
#pragma unroll
            for (int m = 0; m < 4; ++m) {
                bf16_t* rowp = H + (size_t)(row0 + ai * 128 + m * 16) * 1024 + f0;
#pragma unroll
                for (int bj = 0; bj < 2; ++bj) {
                    const pg8::f32x4 gt = acc[ai][bj][m][0], up = acc[ai][bj][m][1];
                    *(uint2*)(rowp + bj * 64) = make_uint2(pk_bf16(silu_f(gt[0]) * up[0], silu_f(gt[1]) * up[1]), pk_bf16(silu_f(gt[2]) * up[2], silu_f(gt[3]) * up[3]));
                }
            }
    }
};

__device__ __forceinline__ void g5_tiles(const Params& p, int th, char* smem, const int TID, int wid, int nw) {
    char* ws = p.ws;
    const float* xin = (th < 2) ? (p.x_prompt + (size_t)th * T3 * 1024) : p.x_sample;
    pg8::Gemm g; g.A = (const bf16_t*)(ws + R_O); g.Bt = (const bf16_t*)(ws + R_WOUT); g.M = T3; g.N = 1024; g.K = 2048;
    Pg8Sched S; S.MT = 64; S.NTN = 4; S.MS = 8; S.NS = 4; S.wid = wid; S.nw = nw;
    Pg8EpiResid E; E.res = xin; E.dst = p.out + (size_t)th * T3 * 1024;
    pg8::gemm_phase<Pg8EpiResid, Pg8Sched, false>((LAS3 unsigned char*)smem, g, S, E, nullptr, TID);
}

#ifndef ONLY
#define EN(k) 1
#else
#define EN(k) (ONLY == (k))
#endif
__device__ void run_phase(const Params& p, int ph, char* smem, const int TID) {
    const int bid = blockIdx.x, G = gridDim.x;
    char* ws = p.ws;
    if (EN(0) && ph == PH_PRE) {
        int rot = 0;
        convert_matrix(p.ret_w_in, nullptr, 6144, (bf16_t*)(ws + R_WIN), 6144, 1024, 1, smem, rot, TID, bid, G);
        convert_matrix(p.ret_w_out, nullptr, 1024, (bf16_t*)(ws + R_WOUT), 1024, 2048, 0, smem, rot, TID, bid, G);
        for (int th = 0; th < 3; ++th) {
            const float* xs = (th < 2) ? (p.x_prompt + (size_t)th * T3 * 1024) : p.x_sample;
            bf16_t* xd = (bf16_t*)(p.out + (size_t)th * T3 * 1024);
            const size_t nx8 = (size_t)T3 * 1024 / 8, xstr = (size_t)G * NT;
            size_t i = (size_t)bid * NT + TID;
            for (; i + 3 * xstr < nx8; i += 4 * xstr) {
                float4 a[4], b[4];
#pragma unroll
                for (int j = 0; j < 4; ++j) { a[j] = ((const float4*)xs)[2 * (i + j * xstr)]; b[j] = ((const float4*)xs)[2 * (i + j * xstr) + 1]; }
#pragma unroll
                for (int j = 0; j < 4; ++j) ((uint4*)xd)[i + j * xstr] = make_uint4(pk_bf16(a[j].x, a[j].y), pk_bf16(a[j].z, a[j].w), pk_bf16(b[j].x, b[j].y), pk_bf16(b[j].z, b[j].w));
            }
            for (; i < nx8; i += xstr) {
                const float4 a = ((const float4*)xs)[2 * i], b = ((const float4*)xs)[2 * i + 1];
                ((uint4*)xd)[i] = make_uint4(pk_bf16(a.x, a.y), pk_bf16(a.z, a.w), pk_bf16(b.x, b.y), pk_bf16(b.z, b.w));
            }
        }
#ifdef PROBE_NULLGEMM
        {
            __syncthreads();
            const unsigned long long t0 = wall_clock64();
            PolNull pn; pn.sink = (float*)(ws + R_O);
            gemm_core<PolNull, C256, true>(pn, smem, 1024, TID);
            __syncthreads();
            const unsigned long long t1 = wall_clock64();
            if (bid == 0 && TID == 0) *(unsigned long long*)(ws + R_O + 64) = t1 - t0;
        }
#endif
#ifdef PROBE_SCANTEST
        for (int var = 0; var < 2; ++var) {
            __syncthreads();
            const unsigned long long t0 = wall_clock64();
            if (bid < 64) {
                const int dkt = bid & 1, dvt = (bid >> 1) & 3, dir = (bid >> 3) & 1, h = (bid >> 4) & 3;
                if (var == 0) {
                    PolUscanT<false, true> pol;
                    pol.A = (const bf16_t*)(ws + R_VT) + ((size_t)h * 512 + dvt * 128) * 128; pol.B = (const bf16_t*)(ws + R_KT) + ((size_t)h * 256 + dkt * 128) * 128;
                    pol.UR = (bf16_t*)(ws + R_UR) + (size_t)dir * (128ull * 4 * 512 * 256) + (size_t)h * (512 * 256) + (size_t)(dvt * 128) * 256 + dkt * 128;
                    pol.nc = 128; pol.dir = dir; pol.lg = -0.01f; pol.dec = 0.5f; pol.st = 1.001f; pol.st2 = 1.002f;
                    gemm_core<PolUscanT<false, true>, C128, false>(pol, smem, 256, TID);
                } else {
                    PolUscanT<true, false> pol;
                    pol.A = (const bf16_t*)(ws + R_VT) + ((size_t)h * 512 + dvt * 128) * 128; pol.B = (const bf16_t*)(ws + R_KT) + ((size_t)h * 256 + dkt * 128) * 128;
                    pol.UR = (bf16_t*)(ws + R_UR) + (size_t)dir * (128ull * 4 * 512 * 256) + (size_t)h * (512 * 256) + (size_t)(dvt * 128) * 256 + dkt * 128;
                    pol.nc = 128; pol.dir = dir; pol.lg = -0.01f; pol.dec = 0.5f; pol.st = 1.001f; pol.st2 = 1.002f;
                    gemm_core<PolUscanT<true, false>, C128, false>(pol, smem, 256, TID);
                }
            }
            __syncthreads();
            const unsigned long long t1 = wall_clock64();
            if (bid == 0 && TID == 0) ((unsigned long long*)(ws + R_END - 64))[var] = (var ? 4 : 1) * (t1 - t0);
        }
#endif
#ifdef PROBE_LOADTEST
        for (int var = 0; var < 2; ++var) {
            __syncthreads();
            const unsigned long long t0 = wall_clock64();
            const int lda = var ? 1024 : 1088;
            for (int k = 0, tm, nt; tile_map(k, 384, 4, 8, 4, tm, nt); ++k) {
                PolLoadTest pol; pol.lda = lda; pol.sink = (float*)(ws + M_AFF);
                pol.A = (const bf16_t*)(ws + M_H) + (size_t)(tm * 256) * lda;
                pol.B = (const bf16_t*)(ws + M_WGU) + (size_t)((tm >> 4) * 1024 + nt * 256) * lda;
                gemm_core<PolLoadTest, C256, true, 1, true>(pol, smem, 16, TID);
            }
            __syncthreads();
            const unsigned long long t1 = wall_clock64();
            if (bid == 0 && TID == 0) ((unsigned long long*)(ws + M_AFF + 1024))[var] = t1 - t0;
        }
#endif
        float2* rt = (float2*)(ws + R_ROT);
        for (int i = bid * NT + TID; i < 16384 * 128; i += G * NT) {
            const int s = i >> 7, fi = i & 127;
            const float inv = exp2f(-(float)fi * (13.287712379549449f / 128.0f));
            const float ang = (float)s * inv;
            const double rev = (double)ang * 0.15915494309189535;
            const float fr = (float)(rev - (double)(long long)(rev + 0.5));
            rt[i] = make_float2(__builtin_amdgcn_cosf(fr), __builtin_amdgcn_sinf(fr));
        }
        return;
    }
    if (ph >= PH_R0 && ph < PH_R0 + 15) {
        const int th = (ph - PH_R0) / 5, sub = (ph - PH_R0) % 5;
        const int nseq = (th < 2) ? 8 : 1, nc = (th < 2) ? 16 : 128, smask = (th < 2) ? 2047 : 16383;
        const float* xin = (th < 2) ? (p.x_prompt + (size_t)th * T3 * 1024) : p.x_sample;
        if (EN(1) && sub == 0) {
            const bf16_t* xbt = (const bf16_t*)(p.out + (size_t)th * T3 * 1024);
            const bf16_t* Wt = (const bf16_t*)(ws + R_WIN);
            {
                pg8::Gemm g; g.A = xbt; g.Bt = Wt; g.M = T3; g.N = 2048; g.K = 1024;
                Pg8Sched S; S.MT = 64; S.NTN = 8; S.MS = 4; S.NS = 8; S.wid = bid; S.nw = G;
                Pg8EpiQKrot E; E.ws = ws; E.smask = smask;
                pg8::gemm_phase<Pg8EpiQKrot, Pg8Sched, false>((LAS3 unsigned char*)smem, g, S, E, nullptr, TID);
            }
            {
                pg8::Gemm g; g.A = Wt + (size_t)2048 * 1024; g.Bt = xbt; g.M = 2048; g.N = T3; g.K = 1024;
                Pg8Sched S; S.MT = 8; S.NTN = 64; S.MS = 4; S.NS = 8; S.wid = bid; S.nw = G;
                Pg8EpiVtBlk E; E.Vt = (bf16_t*)(ws + R_VT);
                pg8::gemm_phase<Pg8EpiVtBlk, Pg8Sched, false>((LAS3 unsigned char*)smem, g, S, E, nullptr, TID);
            }
            {
                pg8::Gemm g; g.A = xbt; g.Bt = Wt + (size_t)4096 * 1024; g.M = T3; g.N = 2048; g.K = 1024;
                Pg8Sched S; S.MT = 64; S.NTN = 8; S.MS = 4; S.NS = 8; S.wid = bid; S.nw = G;
                Pg8EpiRows E; E.O = (bf16_t*)(ws + R_G); E.ldc = 2048;
                pg8::gemm_phase<Pg8EpiRows, Pg8Sched, false>((LAS3 unsigned char*)smem, g, S, E, nullptr, TID);
            }
            if (th == 1 && G == 256 && EN(5)) g5_tiles(p, 0, smem, TID, bid, G);
        } else if (EN(2) && sub == 1) {
            const int nscan = nseq * 4 * 2 * 8;
            const int nscore = NCH3 * 4;
            const int ncr = nc / 2;
            if (th == 2 && G == 256 && EN(5)) g5_tiles(p, 1, smem, TID, bid - 64, 192);
            for (int t = bid; t < nscan + nscore; ) {
                if (t < nscan) {
                    int u = t;
                    if (G == 256) {
                        const int k = t >> 8, b = t & 255, x = b & 7, sl = b >> 3;
                        if (nscan >= 256) u = ((k * 32 + x * 4 + (sl >> 3)) << 3) | (sl & 7);
                        else u = (x << 3) | sl;
                    }
                    const int dkt = u & 1; u >>= 1; const int dvt = u & 3; u >>= 2; const int dir = u & 1; u >>= 1; const int h = u & 3; u >>= 2; const int seq = u;
                    PolUscan pol;
                    pol.A = (const bf16_t*)(ws + R_VT) + ((size_t)(seq * nc) * 2048 + h * 512 + dvt * 128) * 128;
                    pol.B = (const bf16_t*)(ws + R_KT) + ((size_t)(seq * nc) * 1024 + h * 256 + dkt * 128) * 128;
                    pol.UR = (bf16_t*)(ws + R_UR) + (size_t)dir * ((size_t)NCH3 * 4 * 512 * 256) + (size_t)(seq * ncr) * (4ull * 512 * 256) + (size_t)h * (512 * 256) + (size_t)(dvt * 128) * 256 + dkt * 128;
                    pol.nc = ncr; pol.dir = dir;
                    pol.lg = log2_sigmoid(p.ret_decay[dir * 4 + h]);
                    pol.dec = exp2f(pol.lg * (float)RC);
                    pol.st = exp2f(dir ? pol.lg : -pol.lg); pol.st2 = pol.st * pol.st;
                    gemm_core<PolUscan, C128, false>(pol, smem, ncr * 4, TID);
                } else {
                    const int u = t - nscan; const int h = u & 3, cgi = u >> 2;
                    PolScore pol;
                    pol.A = (const bf16_t*)(ws + R_Q) + (size_t)(cgi * RC) * 1024 + h * 256;
                    pol.B = (const bf16_t*)(ws + R_K) + (size_t)(cgi * RC) * 1024 + h * 256;
                    pol.P = (bf16_t*)(ws + R_P) + (size_t)((cgi * 4 + h) * RC) * RC;
                    pol.lgf = log2_sigmoid(p.ret_decay[h]); pol.lgb = log2_sigmoid(p.ret_decay[4 + h]); pol.smem = smem;
                    gemm_core<PolScore, C256, false, 1>(pol, smem, 4, TID);
                }
                if (th == 2 && G == 256) t = (t == bid && bid >= 64 && bid < 128) ? bid + 192 : nscan + nscore;
                else t += G;
            }
        } else if (EN(3) && sub == 2) {
            for (int t = bid; t < NCH3 * 2 * 4 * 2; t += G) {
                int u = t;
                if (G == 256) { const int k = t >> 8, b = t & 255, x = b & 7, sl = b >> 3; u = ((k * 64 + x * 8 + (sl >> 2)) << 2) | (sl & 3); }
                const int dvt = u & 1, half = (u >> 1) & 1, h = (u >> 2) & 3, cgi = u >> 4;
                PolO pol;
                pol.half = half;
                pol.Pp = (const bf16_t*)(ws + R_P) + (size_t)((cgi * 4 + h) * RC + half * 128) * RC;
                pol.Qp = (const bf16_t*)(ws + R_Q) + (size_t)(cgi * RC + half * 128) * 1024 + h * 256;
                pol.Vp = (const bf16_t*)(ws + R_VT) + ((size_t)(cgi * 2) * 2048 + h * 512 + dvt * 256) * 128;
                const size_t ro = (size_t)cgi * (4ull * 512 * 256) + (size_t)h * (512 * 256) + (size_t)(dvt * 256) * 256;
                pol.Rf = (const bf16_t*)(ws + R_UR) + ro;
                pol.Rb = (const bf16_t*)(ws + R_UR) + (size_t)NCH3 * 4 * 512 * 256 + ro;
                pol.O = (bf16_t*)(ws + R_O) + (size_t)(cgi * RC + half * 128) * 2048 + h * 512 + dvt * 256;
                pol.lgf = log2_sigmoid(p.ret_decay[h]); pol.lgb = log2_sigmoid(p.ret_decay[4 + h]);
                gemm_core<PolO, CO, false>(pol, smem, 12, TID);
            }
        } else if (EN(4) && sub == 3) {
            const int lane = TID & 63, w = TID >> 6;
            bf16_t* O = (bf16_t*)(ws + R_O); const bf16_t* Gb = (const bf16_t*)(ws + R_G);
            int it = bid * 8 + w;
            uint4 nov = make_uint4(0, 0, 0, 0), ngv = nov;
            if (it < T3 * 4) { nov = *(const uint4*)(O + (size_t)it * 512 + lane * 8); ngv = *(const uint4*)(Gb + (size_t)it * 512 + lane * 8); }
            for (; it < T3 * 4; it += G * 8) {
                const size_t off = (size_t)it * 512 + lane * 8;
                const uint4 ov = nov, gv = ngv;
                if (it + G * 8 < T3 * 4) { nov = *(const uint4*)(O + off + (size_t)G * 8 * 512); ngv = *(const uint4*)(Gb + off + (size_t)G * 8 * 512); }
                float y[8] = {bf_lo(ov.x), bf_hi(ov.x), bf_lo(ov.y), bf_hi(ov.y), bf_lo(ov.z), bf_hi(ov.z), bf_lo(ov.w), bf_hi(ov.w)};
                const float g[8] = {bf_lo(gv.x), bf_hi(gv.x), bf_lo(gv.y), bf_hi(gv.y), bf_lo(gv.z), bf_hi(gv.z), bf_lo(gv.w), bf_hi(gv.w)};
                float s = 0.f;
#pragma unroll
                for (int e = 0; e < 8; ++e) s += y[e];
                const float mu = wave_sum(s) * (1.f / 512.f);
                float q = 0.f;
#pragma unroll
                for (int e = 0; e < 8; ++e) { y[e] -= mu; q += y[e] * y[e]; }
                const float rstd = rsqrtf(wave_sum(q) * (1.f / 512.f) + GN_EPS);
#pragma unroll
                for (int e = 0; e < 8; ++e) y[e] = y[e] * rstd * silu_f(g[e]);
                *(uint4*)(O + off) = make_uint4(pk_bf16(y[0], y[1]), pk_bf16(y[2], y[3]), pk_bf16(y[4], y[5]), pk_bf16(y[6], y[7]));
            }
        } else if (EN(5) && sub == 4) {
            if (th == 2 || G != 256) g5_tiles(p, th, smem, TID, bid, G);
        }
        return;
    }
    if (EN(6) && (ph == PH_LN0A || ph == PH_LN1A)) {
        const int L = (ph == PH_LN1A);
        ln_phase<0, true, true>(p, p.ln_mix_g + L * 1024, p.ln_mix_b + L * 1024, p.w_router + (size_t)L * 1024 * 16, M_XB, smem, TID);
        return;
    }
    if (EN(7) && (ph == PH_TOPK0 || ph == PH_TOPK1)) {
        const int L = (ph == PH_TOPK1);
        topk_phase(p, smem, TID);
        const int wid = (G > 64) ? bid - 32 : bid, nw = (G > 64) ? G - 32 : G;
        int rot = 0;
        for (int e = 0; e < 16; ++e) {
            const size_t wo = ((size_t)L * 16 + e) * 1024 * 1024;
            convert_matrix(p.w_gate + wo, p.w_up + wo, 1024, (bf16_t*)(ws + M_WGU) + (size_t)e * 2048 * 1024, 2048, 1024, 2, smem, rot, TID, wid, nw);
            convert_matrix(p.w_down + wo, nullptr, 1024, (bf16_t*)(ws + M_WD) + (size_t)e * 1024 * 1024, 1024, 1024, 0, smem, rot, TID, wid, nw);
        }
        if (!L) {
            convert_matrix(p.na_w_in, nullptr, 3072, (bf16_t*)(ws + M_NWIN), 3072, 1024, 3, smem, rot, TID, wid, nw);
            convert_matrix(p.na_w_out, nullptr, 1024, (bf16_t*)(ws + M_NWOUT), 1024, 1024, 0, smem, rot, TID, wid, nw);
        }
        return;
    }
    if (EN(8) && (ph == PH_MOE1_0 || ph == PH_MOE1_1)) {
        pg8::Gemm g; g.A = (const bf16_t*)(ws + M_XB); g.Bt = (const bf16_t*)(ws + M_WGU); g.M = 2 * T_ALL; g.N = 16 * 2048; g.K = 1024;
        Pg8SchedMoe1 S; Pg8EpiMoe1 E; E.H = (bf16_t*)(ws + M_H);
        pg8::gemm_phase_gather<Pg8EpiMoe1, Pg8SchedMoe1, false>((LAS3 unsigned char*)smem, g, S, E, nullptr, TID, (const int*)(ws + M_IDX), 16 * CAP_P, T_PROMPT);
        return;
    }
    if (EN(9) && (ph == PH_MOE2_0 || ph == PH_MOE2_1)) {
        if (G == 256) {
            pg8::Gemm g; g.A = (const bf16_t*)(ws + M_H); g.Bt = (const bf16_t*)(ws + M_WD); g.M = 2 * T_ALL; g.N = 16 * 1024; g.K = 1024;
            Pg8SchedMoe2 S; Pg8EpiMoe2 E; E.gate = (const float*)(ws + M_GATE); E.Y = (bf16_t*)(ws + M_YE);
            pg8::gemm_phase<Pg8EpiMoe2, Pg8SchedMoe2, false>((LAS3 unsigned char*)smem, g, S, E, nullptr, TID);
            return;
        }
        for (int k = 0, tm, nt; tile_map(k, 384, 4, 8, 4, tm, nt); ++k) {
            int trunk, e, mt;
            if (tm < 256) { trunk = 0; mt = tm & 15; e = tm >> 4; }
            else { const int u = tm - 256; trunk = 1; mt = u & 7; e = u >> 3; }
            const int cap = trunk ? CAP_S : CAP_P;
            const size_t rb = (trunk ? (size_t)16 * CAP_P : 0) + (size_t)e * cap + mt * 256;
            PolMoe2 pol;
            pol.A = (const bf16_t*)(ws + M_H) + rb * 1024;
            pol.B = (const bf16_t*)(ws + M_WD) + ((size_t)e * 1024 + nt * 256) * 1024;
            pol.gate = (const float*)(ws + M_GATE) + rb;
            pol.Y = (bf16_t*)(ws + M_YE) + rb * 1024 + nt * 256;
            gemm_core_dma<PolMoe2, C256, false>(pol, smem, 16, TID);
        }
        return;
    }
    if (EN(10) && ph == PH_LN0B) { ln_phase<1, true, false>(p, p.ln_ffn_g, p.ln_ffn_b, nullptr, M_XB2, smem, TID); return; }
    if (EN(10) && ph == PH_LN1B) { ln_phase<1, false, false>(p, p.ln_ffn_g + 1024, p.ln_ffn_b + 1024, nullptr, M_XB2, smem, TID); return; }
    if (EN(11) && ph == PH_QKV) {
        {
            pg8::Gemm g; g.A = (const bf16_t*)(ws + M_XB2); g.Bt = (const bf16_t*)(ws + M_NWIN); g.M = T_ALL; g.N = 2048; g.K = 1024;
            Pg8Sched S; S.MT = 192; S.NTN = 8; S.MS = 4; S.NS = 8; S.wid = bid; S.nw = G;
            Pg8EpiQK E; E.ws = ws;
            pg8::gemm_phase<Pg8EpiQK, Pg8Sched, false>((LAS3 unsigned char*)smem, g, S, E, nullptr, TID);
        }
        {
            pg8::Gemm g; g.A = (const bf16_t*)(ws + M_NWIN) + (size_t)2048 * 1024; g.Bt = (const bf16_t*)(ws + M_XB2); g.M = 1024; g.N = T_ALL; g.K = 1024;
            Pg8Sched S; S.MT = 4; S.NTN = 192; S.MS = 4; S.NS = 8; S.wid = bid; S.nw = G;
            Pg8EpiRows E; E.O = (bf16_t*)(ws + N_VT); E.ldc = T_ALL;
            pg8::gemm_phase<Pg8EpiRows, Pg8Sched, false>((LAS3 unsigned char*)smem, g, S, E, nullptr, TID);
        }
        return;
    }
    if (EN(12) && ph == PH_NA) { na_phase(p, smem, TID); return; }
    if (EN(13) && ph == PH_NAOUT) {
        pg8::Gemm g; g.A = (const bf16_t*)(ws + M_XB2); g.Bt = (const bf16_t*)(ws + M_NWOUT); g.M = T_ALL; g.N = 1024; g.K = 1024;
        Pg8Sched S; S.MT = 192; S.NTN = 4; S.MS = 8; S.NS = 4; S.wid = bid; S.nw = G;
        Pg8EpiResid E; E.res = p.out; E.dst = p.out;
        pg8::gemm_phase<Pg8EpiResid, Pg8Sched, false>((LAS3 unsigned char*)smem, g, S, E, nullptr, TID);
        return;
    }
}

__device__ __forceinline__ int lane_id_opaque() {
    int l;
    asm volatile("v_mbcnt_lo_u32_b32 %0, -1, 0\n\tv_mbcnt_hi_u32_b32 %0, -1, %0" : "=v"(l));
    return l;
}

__global__ void __launch_bounds__(512, 2) fwd_megakernel(Params p) {
    extern __shared__ __attribute__((aligned(16))) char smem_dyn[];
    char* smem = smem_dyn;
    cg::grid_group grid = cg::this_grid();
    const int wave_id = __builtin_amdgcn_readfirstlane((int)(threadIdx.x >> 6));
#define MK_TID() ((wave_id << 6) | lane_id_opaque())
    if (MK_TID() == 0) *(uint4*)(smem_dyn + 131072) = make_uint4(0u, 0u, 0u, 0u);
    __syncthreads();
    (void)xcd_barrier_post((unsigned*)(p.ws + BAR_OFF), (volatile LAS3 unsigned*)(smem_dyn + 131072), MK_TID());
#ifdef PROBE_MASK
    unsigned long long t_prev = wall_clock64(), t_acc = 0, t_accb = 0, t_null = 0, t_sync = 0, t_syncb = 0;
#endif
    for (int ph = p.ph_lo; ph < p.ph_hi; ++ph) {
        Params q = p;
        {
            size_t z = 0;
            asm volatile("" : "+s"(z));
            q.ws = p.ws + z; q.out = p.out + z; q.x_prompt = p.x_prompt + z; q.x_sample = p.x_sample + z; q.ret_decay = p.ret_decay + z;
            q.w_gate = p.w_gate + z; q.w_up = p.w_up + z; q.w_down = p.w_down + z;
        }
        int phv = ph;
        asm volatile("" : "+s"(phv));
        int tidv = MK_TID();
        asm volatile("" : "+v"(tidv));
        const bool empty_ph = (gridDim.x == 256) && (ph == PH_R0 + 4 || ph == PH_R0 + 9);
        if (empty_ph) continue;
        run_phase(q, phv, smem, tidv);
#ifdef PROBE_MASK
        const unsigned long long t_s0 = wall_clock64();
#endif
        if (ph + 1 < p.ph_hi) { if (ph == p.ph_lo) grid.sync(); else { XcdBarrier xb; xb.bar = (unsigned*)(p.ws + BAR_OFF); xb.x = xb_xcc_id(); xb.st = (volatile LAS3 unsigned*)(smem_dyn + 131072); xcd_barrier(xb, MK_TID()); } }
#ifdef PROBE_MASK
        { const unsigned long long dt_ = wall_clock64() - t_s0; if ((PROBE_MASK >> ph) & 1ull) t_sync += dt_; else t_syncb += dt_; }
#endif
#ifdef PROBE_MASK
#if defined(PROBE_LOADTEST) || defined(PROBE_SCANTEST)
        if (ph == 0 && blockIdx.x == 0 && threadIdx.x == 0) { t_acc = ((volatile unsigned long long*)(p.ws + R_END - 64))[0]; t_accb = ((volatile unsigned long long*)(p.ws + R_END - 64))[1]; }
#endif
        { const unsigned long long t_now = wall_clock64(); if ((PROBE_MASK >> ph) & 1ull) t_acc += t_now - t_prev; if ((PROBE_MASK_B >> ph) & 1ull) t_accb += t_now - t_prev; t_prev = t_now; }
#endif
    }
#ifdef PROBE_MASK
    if (blockIdx.x == 0 && threadIdx.x == 0) {
        const float v = (float)t_sync * 0.001f, vb = (float)t_syncb * 0.001f;
        p.out[5] += sqrtf(v);
        p.out[1024 + 5] += sqrtf(vb);
    }
#endif
}

extern "C" void kernel_launch(void* const* d_in, const int* in_sizes, int n_in, void* d_out, int out_size, void* d_ws, size_t ws_size, hipStream_t stream) {
    static int grid_blocks = 0;
    if (!grid_blocks) {
        int dev = 0, cus = 0, per_cu = 0;
        (void)hipGetDevice(&dev);
        (void)hipDeviceGetAttribute(&cus, hipDeviceAttributeMultiprocessorCount, dev);
        (void)hipFuncSetAttribute((const void*)fwd_megakernel, hipFuncAttributeMaxDynamicSharedMemorySize, LDS_BYTES);
        (void)hipOccupancyMaxActiveBlocksPerMultiprocessor(&per_cu, fwd_megakernel, NT, LDS_BYTES);
        if (per_cu < 1) per_cu = 1;
        if (per_cu > 1) per_cu = 1;
        grid_blocks = cus * per_cu;
        if (ws_size < R_END || ws_size < M_END) fprintf(stderr, "kernel_launch: workspace too small: %zu < %zu\n", ws_size, (size_t)(R_END > M_END ? R_END : M_END));
    }
    if (ws_size < R_END || ws_size < M_END || ws_size < BAR_END || R_END > BAR_OFF || M_END > BAR_OFF) return;
    (void)hipMemsetAsync((char*)d_ws + BAR_OFF, 0, 16384, stream);
    Params p{};
    p.x_prompt = (const float*)d_in[0]; p.x_sample = (const float*)d_in[1]; p.ret_w_in = (const float*)d_in[2]; p.ret_decay = (const float*)d_in[3];
    p.ret_w_out = (const float*)d_in[4]; p.na_w_in = (const float*)d_in[5]; p.na_rpb = (const float*)d_in[6]; p.na_w_out = (const float*)d_in[7];
    p.ln_mix_g = (const float*)d_in[8]; p.ln_mix_b = (const float*)d_in[9]; p.ln_ffn_g = (const float*)d_in[10]; p.ln_ffn_b = (const float*)d_in[11];
    p.w_router = (const float*)d_in[12]; p.w_gate = (const float*)d_in[13]; p.w_up = (const float*)d_in[14]; p.w_down = (const float*)d_in[15];
    p.out = (float*)d_out; p.ws = (char*)d_ws; p.ph_lo = 0; p.ph_hi = PH_COUNT;
    void* args[] = {&p};
    hipError_t e = hipLaunchCooperativeKernel((void*)fwd_megakernel, dim3(grid_blocks), dim3(NT), args, LDS_BYTES, stream);
    if (e != hipSuccess) fprintf(stderr, "cooperative launch failed: %s (grid %d)\n", hipGetErrorString(e), grid_blocks);
}
```

```cpp
#include <hip/hip_runtime.h>
#include <hip/hip_cooperative_groups.h>
#include <cstdio>
namespace cg = cooperative_groups;

typedef unsigned short bf16_t;
typedef short bf16x8 __attribute__((ext_vector_type(8)));
typedef float f32x16 __attribute__((ext_vector_type(16)));
typedef float f32x4 __attribute__((ext_vector_type(4)));
typedef unsigned long long u64;

constexpr int D = 1024;
constexpr int T_ALL = 49152;
constexpr int T_PROMPT = 32768;
constexpr int T3 = 16384;
constexpr float ALPHA = 1.41421356237309515f;
constexpr float LN_EPS = 1e-5f, GN_EPS = 1e-6f;
constexpr int CAP_P = 4096, CAP_S = 2048;
constexpr int RC = 256, NCH3 = T3 / RC;

constexpr size_t R_WIN = 0;
constexpr size_t R_WOUT = R_WIN + 6144ull * 1024 * 2;
constexpr size_t R_ROT = R_WOUT + 1024ull * 2048 * 2;
constexpr size_t R_Q = R_ROT + 16384ull * 128 * 8;
constexpr size_t R_K = R_Q + (size_t)T3 * 1024 * 2;
constexpr size_t R_KT = R_K + (size_t)T3 * 1024 * 2;
constexpr size_t R_VT = R_KT + (size_t)T3 * 1024 * 2;
constexpr size_t R_G = R_VT + (size_t)T3 * 2048 * 2;
constexpr size_t R_P = R_G + (size_t)T3 * 2048 * 2;
constexpr size_t R_UR = R_P + (size_t)NCH3 * 4 * RC * RC * 2;
constexpr size_t R_O = R_UR + 2ull * NCH3 * 4 * 512 * 256 * 2;
constexpr size_t R_END = R_O + (size_t)T3 * 2048 * 2;
constexpr size_t UNIT = (size_t)T_ALL * 1024 * 2;
constexpr size_t M_XB = 0;
constexpr size_t M_XB2 = 2 * UNIT;
constexpr size_t M_YE = 0;
constexpr size_t M_H = 2 * UNIT;
constexpr size_t M_WGU = M_H + 2ull * T_ALL * 1024 * 2;
constexpr size_t M_WD = M_WGU + 16ull * 2048 * 1024 * 2;
constexpr size_t M_AFF = M_WD + 16ull * 1024 * 1024 * 2;
constexpr size_t M_IDX = M_AFF + (size_t)T_ALL * 16 * 4;
constexpr size_t M_GATE = M_IDX + 2ull * T_ALL * 4;
constexpr size_t M_POS = M_GATE + 2ull * T_ALL * 4;
constexpr size_t M_NWIN = M_POS + (size_t)T_ALL * 16 * 4;
constexpr size_t M_NWOUT = M_NWIN + 3072ull * 1024 * 2;
constexpr size_t M_END = M_NWOUT + 1024ull * 1024 * 2;
constexpr size_t BAR_OFF = (R_END > M_END ? R_END : M_END);
constexpr size_t BAR_END = BAR_OFF + 16384;
constexpr size_t N_Q = 3 * UNIT;
constexpr size_t N_K = 0;
constexpr size_t N_VT = UNIT;

constexpr int LDS_BYTES = 131072 + 16;
struct Params {
    const float *x_prompt, *x_sample, *ret_w_in, *ret_decay, *ret_w_out, *na_w_in, *na_rpb, *na_w_out;
    const float *ln_mix_g, *ln_mix_b, *ln_ffn_g, *ln_ffn_b, *w_router, *w_gate, *w_up, *w_down;
    float* out;
    char* ws;
    int ph_lo, ph_hi;
};

typedef __bf16 bf16x2_t __attribute__((ext_vector_type(2)));
typedef float f32x2_t __attribute__((ext_vector_type(2)));
__device__ __forceinline__ unsigned pk_bf16(float lo, float hi) {
    f32x2_t v = {lo, hi};
    bf16x2_t b = __builtin_convertvector(v, bf16x2_t);
    return __builtin_bit_cast(unsigned, b);
}
__device__ __forceinline__ bf16_t f2bf(float f) { return (bf16_t)(pk_bf16(f, 0.f) & 0xffffu); }
__device__ __forceinline__ float bf_lo(unsigned u) { return __uint_as_float(u << 16); }
__device__ __forceinline__ float bf_hi(unsigned u) { return __uint_as_float(u & 0xffff0000u); }
__device__ __forceinline__ float silu_f(float g) { return g * __builtin_amdgcn_rcpf(1.f + __expf(-g)); }
template <int CTRL, int RMASK> __device__ __forceinline__ float dpp_mov0(float v) {
    return __builtin_bit_cast(float, __builtin_amdgcn_update_dpp(0, __builtin_bit_cast(int, v), CTRL, RMASK, 0xf, false));
}
__device__ __forceinline__ float wave_sum(float v) {
    v += dpp_mov0<0xB1, 0xf>(v);
    v += dpp_mov0<0x4E, 0xf>(v);
    v += dpp_mov0<0x141, 0xf>(v);
    v += dpp_mov0<0x140, 0xf>(v);
    v += dpp_mov0<0x142, 0xa>(v);
    v += dpp_mov0<0x143, 0xc>(v);
    return __builtin_bit_cast(float, __builtin_amdgcn_readlane(__builtin_bit_cast(int, v), 63));
}
template <int CTRL> __device__ __forceinline__ float dpp_perm(float v) { return __builtin_bit_cast(float, __builtin_amdgcn_update_dpp(0, __builtin_bit_cast(int, v), CTRL, 0xf, 0xf, true)); }
__device__ __forceinline__ float row16_max(float v) {
    v = fmaxf(v, dpp_perm<0xB1>(v)); v = fmaxf(v, dpp_perm<0x4E>(v)); v = fmaxf(v, dpp_perm<0x141>(v)); return fmaxf(v, dpp_perm<0x140>(v));
}
__device__ __forceinline__ float row16_sum(float v) {
    v += dpp_perm<0xB1>(v); v += dpp_perm<0x4E>(v); v += dpp_perm<0x141>(v); return v + dpp_perm<0x140>(v);
}
__device__ __forceinline__ uint4 scale8(uint4 v, float s) {
    uint4 r;
    r.x = pk_bf16(bf_lo(v.x) * s, bf_hi(v.x) * s);
    r.y = pk_bf16(bf_lo(v.y) * s, bf_hi(v.y) * s);
    r.z = pk_bf16(bf_lo(v.z) * s, bf_hi(v.z) * s);
    r.w = pk_bf16(bf_lo(v.w) * s, bf_hi(v.w) * s);
    return r;
}
__device__ __forceinline__ float log2_sigmoid(float x) { return -log1pf(expf(-x)) * 1.44269504088896341f; }

__device__ __forceinline__ int lds_off(int row, int c8) { return row * 128 + ((c8 ^ ((row >> 1) & 7)) << 4); }
constexpr int NT = 512;
template <int MI_, int NI_, int WM_, int WN_, int DEPTH_> struct Cfg {
    static constexpr int DEPTH = DEPTH_;
    static constexpr int MI = MI_, NI = NI_, WM = WM_, WN = WN_, BM = WM_ * MI_ * 32, BN = WN_ * NI_ * 32, LA = BM / 64, LB = BN / 64, STAGE = (BM + BN) * 128;
    static_assert(WM_ * WN_ == 8, "8 waves");
};
typedef Cfg<4, 2, 2, 4, 2> C256;
typedef Cfg<2, 1, 2, 4, 4> C128;
typedef Cfg<2, 2, 2, 4, 3> CO;

template <class P, class C, bool SWAP, int D, int S0, bool NOMATH = false>
__device__ __forceinline__ void gemm_iter(P& p, char* smem, int kt, int nk, uint4 (&va)[D][C::LA], uint4 (&vb)[D][C::LB], f32x16 (&acc)[C::MI][C::NI],
                                          int wm, int wn, int lane, int r0, int c8) {
    constexpr int S = S0 % D, SN = (S0 + 1) % D;
    char* cur = smem + (kt & 1) * C::STAGE;
    char* nxt = smem + ((kt + 1) & 1) * C::STAGE;
    if (kt + D < nk) {
#pragma unroll
        for (int i = 0; i < C::LA; ++i) va[S][i] = p.ldA(r0 + 64 * i, kt + D, c8);
#pragma unroll
        for (int i = 0; i < C::LB; ++i) vb[S][i] = p.ldB(r0 + 64 * i, kt + D, c8);
    }
    __builtin_amdgcn_sched_barrier(0);
    p.template pre<C>(kt, acc, wm, wn, lane);
#pragma unroll
    for (int ks = 0; ks < (NOMATH ? 0 : 4); ++ks) {
        bf16x8 a[C::MI], b[C::NI];
#pragma unroll
        for (int mi = 0; mi < C::MI; ++mi) a[mi] = *(const bf16x8*)(cur + lds_off(wm * (C::MI * 32) + mi * 32 + (lane & 31), ks * 2 + (lane >> 5)));
#pragma unroll
        for (int ni = 0; ni < C::NI; ++ni) b[ni] = *(const bf16x8*)(cur + C::BM * 128 + lds_off(wn * (C::NI * 32) + ni * 32 + (lane & 31), ks * 2 + (lane >> 5)));
#pragma unroll
        for (int mi = 0; mi < C::MI; ++mi)
#pragma unroll
            for (int ni = 0; ni < C::NI; ++ni) {
                if (SWAP) acc[mi][ni] = __builtin_amdgcn_mfma_f32_32x32x16_bf16(b[ni], a[mi], acc[mi][ni], 0, 0, 0);
                else      acc[mi][ni] = __builtin_amdgcn_mfma_f32_32x32x16_bf16(a[mi], b[ni], acc[mi][ni], 0, 0, 0);
            }
    }
    if (kt + 1 < nk) {
#pragma unroll
        for (int i = 0; i < C::LA; ++i) *(uint4*)(nxt + lds_off(r0 + 64 * i, c8)) = p.fixA(va[SN][i], r0 + 64 * i, kt + 1, c8);
#pragma unroll
        for (int i = 0; i < C::LB; ++i) *(uint4*)(nxt + C::BM * 128 + lds_off(r0 + 64 * i, c8)) = p.fixB(vb[SN][i], r0 + 64 * i, kt + 1, c8);
    }
    __syncthreads();
}

template <class P, class C, bool SWAP, int D = C::DEPTH, bool NOMATH = false>
__device__ __forceinline__ void gemm_core(P& p, char* smem, int nk, const int TID) {
    int tid = TID;
    asm volatile("" : "+v"(tid));
    const int lane = tid & 63, w = tid >> 6, wm = w / C::WN, wn = w % C::WN;
    const int c8 = tid & 7, r0 = tid >> 3;
    f32x16 acc[C::MI][C::NI];
#pragma unroll
    for (int i = 0; i < C::MI; ++i)
#pragma unroll
        for (int j = 0; j < C::NI; ++j)
#pragma unroll
            for (int r = 0; r < 16; ++r) acc[i][j][r] = 0.f;
    uint4 va[D][C::LA], vb[D][C::LB];
#pragma unroll
    for (int d = 0; d < D; ++d) {
        if (d < nk) {
#pragma unroll
            for (int i = 0; i < C::LA; ++i) va[d][i] = p.ldA(r0 + 64 * i, d, c8);
#pragma unroll
            for (int i = 0; i < C::LB; ++i) vb[d][i] = p.ldB(r0 + 64 * i, d, c8);
        }
    }
#pragma unroll
    for (int i = 0; i < C::LA; ++i) *(uint4*)(smem + lds_off(r0 + 64 * i, c8)) = p.fixA(va[0][i], r0 + 64 * i, 0, c8);
#pragma unroll
    for (int i = 0; i < C::LB; ++i) *(uint4*)(smem + C::BM * 128 + lds_off(r0 + 64 * i, c8)) = p.fixB(vb[0][i], r0 + 64 * i, 0, c8);
    __syncthreads();
    for (int kt = 0; kt < nk; kt += D) {
        gemm_iter<P, C, SWAP, D, 0, NOMATH>(p, smem, kt, nk, va, vb, acc, wm, wn, lane, r0, c8);
        if (D > 1 && kt + 1 < nk) gemm_iter<P, C, SWAP, D, 1, NOMATH>(p, smem, kt + 1, nk, va, vb, acc, wm, wn, lane, r0, c8);
        if (D > 2 && kt + 2 < nk) gemm_iter<P, C, SWAP, D, 2, NOMATH>(p, smem, kt + 2, nk, va, vb, acc, wm, wn, lane, r0, c8);
        if (D > 3 && kt + 3 < nk) gemm_iter<P, C, SWAP, D, 3, NOMATH>(p, smem, kt + 3, nk, va, vb, acc, wm, wn, lane, r0, c8);
    }
    int tid2 = tid;
    asm volatile("" : "+v"(tid2));
    p.template epi<C>(acc, (tid2 >> 6) / C::WN, (tid2 >> 6) % C::WN, tid2 & 63);
}

#define LAS3 __attribute__((address_space(3)))
template <class P, class C>
__device__ __forceinline__ void dma_stage(P& p, char* stage, int kt, int w, int lane) {
    const int rl = lane >> 3, cs = lane & 7;
#pragma unroll
    for (int i = 0; i < C::LA; ++i) {
        const int row = 64 * i + 8 * w + rl;
        __builtin_amdgcn_global_load_lds((const unsigned*)p.adA(row, kt, cs ^ ((row >> 1) & 7)), (LAS3 unsigned*)(stage + (64 * i + 8 * w) * 128), 16, 0, 0);
    }
#pragma unroll
    for (int i = 0; i < C::LB; ++i) {
        const int row = 64 * i + 8 * w + rl;
        __builtin_amdgcn_global_load_lds((const unsigned*)p.adB(row, kt, cs ^ ((row >> 1) & 7)), (LAS3 unsigned*)(stage + C::BM * 128 + (64 * i + 8 * w) * 128), 16, 0, 0);
    }
}
template <class P, class C, bool SWAP>
__device__ __forceinline__ void gemm_core_dma(P& p, char* smem, int nk, const int TID) {
    int tid = TID;
    asm volatile("" : "+v"(tid));
    const int lane = tid & 63, w = __builtin_amdgcn_readfirstlane(tid >> 6), wm = w / C::WN, wn = w % C::WN;
    f32x16 acc[C::MI][C::NI];
#pragma unroll
    for (int i = 0; i < C::MI; ++i)
#pragma unroll
        for (int j = 0; j < C::NI; ++j)
#pragma unroll
            for (int r = 0; r < 16; ++r) acc[i][j][r] = 0.f;
    dma_stage<P, C>(p, smem, 0, w, lane);
    __syncthreads();
    for (int kt = 0; kt < nk; ++kt) {
        char* cur = smem + (kt & 1) * C::STAGE;
        if (kt + 1 < nk) dma_stage<P, C>(p, smem + ((kt + 1) & 1) * C::STAGE, kt + 1, w, lane);
        __builtin_amdgcn_sched_barrier(0);
        bf16x8 a[2][C::MI], b[2][C::NI];
#pragma unroll
        for (int mi = 0; mi < C::MI; ++mi) a[0][mi] = *(const bf16x8*)(cur + lds_off(wm * (C::MI * 32) + mi * 32 + (lane & 31), (lane >> 5)));
#pragma unroll
        for (int ni = 0; ni < C::NI; ++ni) b[0][ni] = *(const bf16x8*)(cur + C::BM * 128 + lds_off(wn * (C::NI * 32) + ni * 32 + (lane & 31), (lane >> 5)));
#pragma unroll
        for (int ks = 0; ks < 4; ++ks) {
            if (ks < 3) {
#pragma unroll
                for (int mi = 0; mi < C::MI; ++mi) a[(ks + 1) & 1][mi] = *(const bf16x8*)(cur + lds_off(wm * (C::MI * 32) + mi * 32 + (lane & 31), (ks + 1) * 2 + (lane >> 5)));
#pragma unroll
                for (int ni = 0; ni < C::NI; ++ni) b[(ks + 1) & 1][ni] = *(const bf16x8*)(cur + C::BM * 128 + lds_off(wn * (C::NI * 32) + ni * 32 + (lane & 31), (ks + 1) * 2 + (lane >> 5)));
            }
            __builtin_amdgcn_sched_barrier(0);
#pragma unroll
            for (int mi = 0; mi < C::MI; ++mi)
#pragma unroll
                for (int ni = 0; ni < C::NI; ++ni) {
                    if (SWAP) acc[mi][ni] = __builtin_amdgcn_mfma_f32_32x32x16_bf16(b[ks & 1][ni], a[ks & 1][mi], acc[mi][ni], 0, 0, 0);
                    else      acc[mi][ni] = __builtin_amdgcn_mfma_f32_32x32x16_bf16(a[ks & 1][mi], b[ks & 1][ni], acc[mi][ni], 0, 0, 0);
                }
            __builtin_amdgcn_sched_barrier(0);
        }
        __syncthreads();
    }
    int tid2 = tid;
    asm volatile("" : "+v"(tid2));
    p.template epi<C>(acc, (tid2 >> 6) / C::WN, (tid2 >> 6) % C::WN, tid2 & 63);
}

__device__ __forceinline__ int lds_off64(int row, int c4) { return row * 64 + ((c4 ^ ((row >> 2) & 3)) << 4); }
template <class P, class C, bool SWAP>
__device__ __forceinline__ void gemm_core_dma4(P& p, char* smem, int nk, const int TID) {
    static_assert(C::BM == 256 && C::BN == 256, "sized for 256 x 256 tiles: 4 stages x 32 KiB");
    constexpr int STG = (C::BM + C::BN) * 64;
    int tid = TID;
    asm volatile("" : "+v"(tid));
    const int lane = tid & 63, w = __builtin_amdgcn_readfirstlane(tid >> 6), wm = w / C::WN, wn = w % C::WN;
    const int nsteps = nk * 2;
    f32x16 acc[C::MI][C::NI];
#pragma unroll
    for (int i = 0; i < C::MI; ++i)
#pragma unroll
        for (int j = 0; j < C::NI; ++j)
#pragma unroll
            for (int r = 0; r < 16; ++r) acc[i][j][r] = 0.f;
    const char* pa[2]; const char* pb[2];
#pragma unroll
    for (int i = 0; i < 2; ++i) {
        const int row = 32 * w + 16 * i + (lane >> 2);
        const int ch = (lane & 3) ^ ((row >> 2) & 3);
        pa[i] = (const char*)p.adA(row, 0, 0) + ch * 16;
        pb[i] = (const char*)p.adB(row, 0, 0) + ch * 16;
    }
#define DMA4_ISSUE(j) do { char* st_ = smem + ((j) & 3) * STG + (32 * w) * 64; _Pragma("unroll") for (int i_ = 0; i_ < 2; ++i_) { \
        __builtin_amdgcn_global_load_lds((const unsigned*)(pa[i_] + (size_t)(j) * 64), (LAS3 unsigned*)(st_ + i_ * 1024), 16, 0, 0); \
        __builtin_amdgcn_global_load_lds((const unsigned*)(pb[i_] + (size_t)(j) * 64), (LAS3 unsigned*)(st_ + C::BM * 64 + i_ * 1024), 16, 0, 0); } } while (0)
    DMA4_ISSUE(0);
    DMA4_ISSUE(1);
    for (int j = 0; j < nsteps; ++j) {
        if (j + 2 < nsteps) { DMA4_ISSUE(j + 2); asm volatile("s_waitcnt vmcnt(8)" ::: "memory"); }
        else if (j + 1 < nsteps) asm volatile("s_waitcnt vmcnt(4)" ::: "memory");
        else asm volatile("s_waitcnt vmcnt(0)" ::: "memory");
        __builtin_amdgcn_s_barrier();
        __builtin_amdgcn_sched_barrier(0);
        const char* cur = smem + (j & 3) * STG;
#pragma unroll
        for (int ks = 0; ks < 2; ++ks) {
            bf16x8 a[C::MI], b[C::NI];
#pragma unroll
            for (int mi = 0; mi < C::MI; ++mi) a[mi] = *(const bf16x8*)(cur + lds_off64(wm * (C::MI * 32) + mi * 32 + (lane & 31), ks * 2 + (lane >> 5)));
#pragma unroll
            for (int ni = 0; ni < C::NI; ++ni) b[ni] = *(const bf16x8*)(cur + C::BM * 64 + lds_off64(wn * (C::NI * 32) + ni * 32 + (lane & 31), ks * 2 + (lane >> 5)));
#pragma unroll
            for (int mi = 0; mi < C::MI; ++mi)
#pragma unroll
                for (int ni = 0; ni < C::NI; ++ni) {
                    if (SWAP) acc[mi][ni] = __builtin_amdgcn_mfma_f32_32x32x16_bf16(b[ni], a[mi], acc[mi][ni], 0, 0, 0);
                    else      acc[mi][ni] = __builtin_amdgcn_mfma_f32_32x32x16_bf16(a[mi], b[ni], acc[mi][ni], 0, 0, 0);
                }
        }
        __builtin_amdgcn_sched_barrier(0);
    }
#undef DMA4_ISSUE
    __syncthreads();
    int tid2 = tid;
    asm volatile("" : "+v"(tid2));
    p.template epi<C>(acc, (tid2 >> 6) / C::WN, (tid2 >> 6) % C::WN, tid2 & 63);
}

struct NoFix {
    __device__ __forceinline__ uint4 fixA(uint4 v, int, int, int) const { return v; }
    __device__ __forceinline__ uint4 fixB(uint4 v, int, int, int) const { return v; }
};
struct NoPre : NoFix { template <class C> __device__ __forceinline__ void pre(int, f32x16 (&)[C::MI][C::NI], int, int, int) {} };

#define PK4(A, g) make_uint2(pk_bf16((A)[(g) * 4 + 0], (A)[(g) * 4 + 1]), pk_bf16((A)[(g) * 4 + 2], (A)[(g) * 4 + 3]))

template <bool SWAP> struct PolProj : NoPre {
    const bf16_t* xA; const bf16_t* Bt; char* ws; int m0, n0, smask;
    __device__ __forceinline__ const bf16_t* adA(int row, int kt, int c8) const { return xA + (size_t)(m0 + row) * 1024 + kt * 64 + c8 * 8; }
    __device__ __forceinline__ const bf16_t* adB(int row, int kt, int c8) const { return Bt + (size_t)(n0 + row) * 1024 + kt * 64 + c8 * 8; }
    __device__ __forceinline__ uint4 ldA(int row, int kt, int c8) const { return *(const uint4*)adA(row, kt, c8); }
    __device__ __forceinline__ uint4 ldB(int row, int kt, int c8) const { return *(const uint4*)adB(row, kt, c8); }
    template <class C> __device__ __forceinline__ void epi(f32x16 (&acc)[C::MI][C::NI], int wm, int wn, int lane) const {
        static_assert(C::NI == 2, "rotary pairs need a 64-column wave tile");
        const int sec = n0 >> 10;
        bf16_t* Qb = (bf16_t*)(ws + R_Q); bf16_t* Kb = (bf16_t*)(ws + R_K); bf16_t* Ktb = (bf16_t*)(ws + R_KT);
        bf16_t* Vtb = (bf16_t*)(ws + R_VT); bf16_t* Gb = (bf16_t*)(ws + R_G);
        const float2* rot = (const float2*)(ws + R_ROT);
        const int mb = m0 + wm * (C::MI * 32);
        if (sec == 0) {
            const int cb = (n0 & 1023) + wn * 64;
            const int ib = ((cb & 255) >> 6) * 32 + (lane & 31);
            const int c1 = cb + (lane & 31);
#pragma unroll
            for (int mi = 0; mi < C::MI; ++mi)
#pragma unroll
                for (int r = 0; r < 16; ++r) {
                    const int tok = mb + mi * 32 + 8 * (r >> 2) + 4 * (lane >> 5) + (r & 3);
                    const float2 cs = rot[(size_t)(tok & smask) * 128 + ib];
                    const float x1 = acc[mi][0][r], x2 = acc[mi][1][r];
                    Qb[(size_t)tok * 1024 + c1] = f2bf(x1 * cs.x - x2 * cs.y);
                    Qb[(size_t)tok * 1024 + c1 + 32] = f2bf(x1 * cs.y + x2 * cs.x);
                }
        } else if (sec == 1) {
            const int cb = (n0 & 1023) + wn * 64;
            const int ib = ((cb & 255) >> 6) * 32 + (lane & 31);
            const int c1 = cb + (lane & 31);
#pragma unroll
            for (int mi = 0; mi < C::MI; ++mi)
#pragma unroll
                for (int g = 0; g < 4; ++g) {
                    const int tok0 = mb + mi * 32 + 8 * g + 4 * (lane >> 5);
                    float o1[4], o2[4];
#pragma unroll
                    for (int e = 0; e < 4; ++e) {
                        float2 cs = rot[(size_t)((tok0 + e) & smask) * 128 + ib];
                        float x1 = acc[mi][0][g * 4 + e], x2 = acc[mi][1][g * 4 + e];
                        o1[e] = x1 * cs.x - x2 * cs.y; o2[e] = x1 * cs.y + x2 * cs.x;
                        Kb[(size_t)(tok0 + e) * 1024 + c1] = f2bf(o1[e]);
                        Kb[(size_t)(tok0 + e) * 1024 + c1 + 32] = f2bf(o2[e]);
                    }
                    *(uint2*)(Ktb + ((size_t)(tok0 >> 7) * 1024 + c1) * 128 + (tok0 & 127)) = make_uint2(pk_bf16(o1[0], o1[1]), pk_bf16(o1[2], o1[3]));
                    *(uint2*)(Ktb + ((size_t)(tok0 >> 7) * 1024 + c1 + 32) * 128 + (tok0 & 127)) = make_uint2(pk_bf16(o2[0], o2[1]), pk_bf16(o2[2], o2[3]));
                    __builtin_amdgcn_sched_barrier(0);
                }
        } else if (sec < 4) {
#pragma unroll
            for (int mi = 0; mi < C::MI; ++mi) {
                const int tok = mb + mi * 32 + (lane & 31);
#pragma unroll
                for (int ni = 0; ni < 2; ++ni)
#pragma unroll
                    for (int r = 0; r < 16; ++r) {
                        const int col = n0 - 2048 + wn * 64 + ni * 32 + 8 * (r >> 2) + 4 * (lane >> 5) + (r & 3);
                        Vtb[((size_t)(tok >> 7) * 2048 + col) * 128 + (tok & 127)] = f2bf(acc[mi][ni][r]);
                    }
            }
        } else {
#pragma unroll
            for (int mi = 0; mi < C::MI; ++mi)
#pragma unroll
                for (int ni = 0; ni < 2; ++ni) {
                    const int col = n0 - 4096 + wn * 64 + ni * 32 + (lane & 31);
#pragma unroll
                    for (int r = 0; r < 16; ++r) {
                        const int tok = mb + mi * 32 + 8 * (r >> 2) + 4 * (lane >> 5) + (r & 3);
                        Gb[(size_t)tok * 2048 + col] = f2bf(acc[mi][ni][r]);
                    }
                }
        }
    }
};

#ifdef PROBE_MASK
struct PolNull : NoPre {
    float* sink;
    __device__ __forceinline__ uint4 ldA(int row, int kt, int c8) const { return make_uint4(row, kt, c8, 0x3f803f80u); }
    __device__ __forceinline__ uint4 ldB(int row, int kt, int c8) const { return make_uint4(0x3f803f80u, row ^ kt, c8, 0x3f803f80u); }
    template <class C> __device__ __forceinline__ void epi(f32x16 (&acc)[C::MI][C::NI], int wm, int wn, int lane) const {
        float t = 0.f;
#pragma unroll
        for (int mi = 0; mi < C::MI; ++mi)
#pragma unroll
            for (int ni = 0; ni < C::NI; ++ni)
#pragma unroll
                for (int r = 0; r < 16; ++r) t += acc[mi][ni][r];
        if (t == 123456.789f) *sink = t;
    }
};
#endif

#ifdef PROBE_MASK
struct PolLoadTest : NoPre {
    const bf16_t *A, *B; int lda; float* sink;
    __device__ __forceinline__ uint4 ldA(int row, int kt, int c8) const { return *(const uint4*)(A + (size_t)row * lda + kt * 64 + c8 * 8); }
    __device__ __forceinline__ uint4 ldB(int row, int kt, int c8) const { return *(const uint4*)(B + (size_t)row * lda + kt * 64 + c8 * 8); }
    template <class C> __device__ __forceinline__ void epi(f32x16 (&acc)[C::MI][C::NI], int, int, int) const { if (acc[0][0][0] == 123456.789f) *sink = 1.f; }
};
#endif

struct PolScore : NoPre {
    const bf16_t *A, *B; bf16_t* P; float lgf, lgb; char* smem;
    __device__ __forceinline__ const bf16_t* adA(int row, int kt, int c8) const { return A + (size_t)row * 1024 + kt * 64 + c8 * 8; }
    __device__ __forceinline__ const bf16_t* adB(int row, int kt, int c8) const { return B + (size_t)row * 1024 + kt * 64 + c8 * 8; }
    __device__ __forceinline__ uint4 ldA(int row, int kt, int c8) const { return *(const uint4*)adA(row, kt, c8); }
    __device__ __forceinline__ uint4 ldB(int row, int kt, int c8) const { return *(const uint4*)adB(row, kt, c8); }
    template <class C> __device__ __forceinline__ void epi(f32x16 (&acc)[C::MI][C::NI], int wm, int wn, int lane) const {
        float* tab = (float*)smem;
        const int tid = (wm * C::WN + wn) * 64 + lane;
        if (tid < 2 * RC - 1) { const int d = tid - (RC - 1); tab[tid] = (d >= 0) ? exp2f(lgf * (float)d) : exp2f(lgb * (float)(-d)); }
        __syncthreads();
#pragma unroll
        for (int mi = 0; mi < C::MI; ++mi)
#pragma unroll
            for (int ni = 0; ni < C::NI; ++ni) {
                const int j = wn * (C::NI * 32) + ni * 32 + (lane & 31);
#pragma unroll
                for (int r = 0; r < 16; ++r) {
                    const int i = wm * (C::MI * 32) + mi * 32 + 8 * (r >> 2) + 4 * (lane >> 5) + (r & 3);
                    P[(size_t)i * RC + j] = f2bf(acc[mi][ni][r] * tab[i - j + (RC - 1)]);
                }
            }
        __syncthreads();
    }
};

template <bool EMIT = true, bool SCALE = true> struct PolUscanT {
    const bf16_t *A, *B;
    bf16_t* UR;
    int nc, dir; float lg, dec, st, st2;
    __device__ __forceinline__ int rchunk(int kt) const { const int ci = kt >> 2; return dir ? (nc - 1 - ci) : ci; }
    __device__ __forceinline__ int chunk(int kt) const { return rchunk(kt) * 2 + ((kt & 3) >> 1); }
    __device__ __forceinline__ uint4 ldA(int row, int kt, int c8) const { return *(const uint4*)(A + (size_t)chunk(kt) * (2048 * 128) + (kt & 1) * 64 + (unsigned)(row * 128 + c8 * 8)); }
    __device__ __forceinline__ uint4 ldB(int row, int kt, int c8) const { return *(const uint4*)(B + (size_t)chunk(kt) * (1024 * 128) + (kt & 1) * 64 + (unsigned)(row * 128 + c8 * 8)); }
    __device__ __forceinline__ uint4 fixA(uint4 v, int, int, int) const { return v; }
    __device__ __forceinline__ uint4 fixB(uint4 v, int row, int kt, int c8) const {
        if (!SCALE) return v;
        const int j0 = (kt & 3) * 64 + c8 * 8;
        float w0 = exp2f(lg * (float)(dir ? j0 : (RC - 1 - j0)));
        float w1 = w0 * st;
        uint4 r;
        r.x = pk_bf16(bf_lo(v.x) * w0, bf_hi(v.x) * w1); w0 *= st2; w1 *= st2;
        r.y = pk_bf16(bf_lo(v.y) * w0, bf_hi(v.y) * w1); w0 *= st2; w1 *= st2;
        r.z = pk_bf16(bf_lo(v.z) * w0, bf_hi(v.z) * w1); w0 *= st2; w1 *= st2;
        r.w = pk_bf16(bf_lo(v.w) * w0, bf_hi(v.w) * w1);
        return r;
    }
    template <class C> __device__ __forceinline__ void pre(int kt, f32x16 (&acc)[C::MI][C::NI], int wm, int wn, int lane) const {
        if (kt & 3) return;
        const int ch = rchunk(kt);
        bf16_t* dst = UR + (size_t)ch * (4ull * 512 * 256);
#pragma unroll
        for (int mi = 0; mi < (EMIT ? C::MI : 0); ++mi)
#pragma unroll
            for (int ni = 0; ni < C::NI; ++ni) {
                const int n = wn * (C::NI * 32) + ni * 32 + (lane & 31);
#pragma unroll
                for (int r = 0; r < 16; ++r) {
                    const int m = wm * (C::MI * 32) + mi * 32 + 8 * (r >> 2) + 4 * (lane >> 5) + (r & 3);
                    dst[(size_t)m * 256 + n] = f2bf(acc[mi][ni][r]);
                }
            }
#pragma unroll
        for (int mi = 0; mi < C::MI; ++mi)
#pragma unroll
            for (int ni = 0; ni < C::NI; ++ni)
#pragma unroll
                for (int r = 0; r < 16; ++r) acc[mi][ni][r] *= dec;
    }
    template <class C> __device__ __forceinline__ void epi(f32x16 (&)[C::MI][C::NI], int, int, int) const {}
};

typedef PolUscanT<true, true> PolUscan;

struct PolO : NoPre {
    const bf16_t *Pp, *Qp, *Vp, *Rf, *Rb; bf16_t* O; float lgf, lgb; int half;
    __device__ __forceinline__ uint4 ldA(int row, int kt, int c8) const {
        if (kt < 4) return *(const uint4*)(Pp + kt * 64 + (unsigned)(row * RC + c8 * 8));
        const int kk = (kt - 4) & 3;
        return *(const uint4*)(Qp + kk * 64 + (unsigned)(row * 1024 + c8 * 8));
    }
    __device__ __forceinline__ uint4 fixA(uint4 v, int row, int kt, int) const {
        if (kt < 4) return v;
        const int seg = (kt - 4) >> 2, i = half * 128 + row;
        const float s = seg ? exp2f(lgb * (float)(RC - i)) : exp2f(lgf * (float)(i + 1));
        return scale8(v, s);
    }
    __device__ __forceinline__ uint4 ldB(int row, int kt, int c8) const {
        if (kt < 4) return *(const uint4*)(Vp + (size_t)(kt >> 1) * (2048 * 128) + (kt & 1) * 64 + (unsigned)(row * 128 + c8 * 8));
        const int seg = (kt - 4) >> 2, kk = (kt - 4) & 3;
        return *(const uint4*)((seg ? Rb : Rf) + kk * 64 + (unsigned)(row * 256 + c8 * 8));
    }
    template <class C> __device__ __forceinline__ void epi(f32x16 (&acc)[C::MI][C::NI], int wm, int wn, int lane) const {
#pragma unroll
        for (int mi = 0; mi < C::MI; ++mi)
#pragma unroll
            for (int ni = 0; ni < C::NI; ++ni) {
                const int n = wn * (C::NI * 32) + ni * 32 + (lane & 31);
#pragma unroll
                for (int r = 0; r < 16; ++r) {
                    const int m = wm * (C::MI * 32) + mi * 32 + 8 * (r >> 2) + 4 * (lane >> 5) + (r & 3);
                    O[(size_t)m * 2048 + n] = f2bf(acc[mi][ni][r]);
                }
            }
    }
};

struct PolResid : NoPre {
    const bf16_t *A, *B; int lda, ldb; const float* res; float* dst;
    __device__ __forceinline__ const bf16_t* adA(int row, int kt, int c8) const { return A + (size_t)row * lda + kt * 64 + c8 * 8; }
    __device__ __forceinline__ const bf16_t* adB(int row, int kt, int c8) const { return B + (size_t)row * ldb + kt * 64 + c8 * 8; }
    __device__ __forceinline__ uint4 ldA(int row, int kt, int c8) const { return *(const uint4*)adA(row, kt, c8); }
    __device__ __forceinline__ uint4 ldB(int row, int kt, int c8) const { return *(const uint4*)adB(row, kt, c8); }
    template <class C> __device__ __forceinline__ void epi(f32x16 (&acc)[C::MI][C::NI], int wm, int wn, int lane) const {
#pragma unroll
        for (int mi = 0; mi < C::MI; ++mi)
#pragma unroll
            for (int ni = 0; ni < C::NI; ++ni) {
                const int n = wn * (C::NI * 32) + ni * 32 + (lane & 31);
#pragma unroll
                for (int r = 0; r < 16; ++r) {
                    const int m = wm * (C::MI * 32) + mi * 32 + 8 * (r >> 2) + 4 * (lane >> 5) + (r & 3);
                    dst[(size_t)m * 1024 + n] = ALPHA * res[(size_t)m * 1024 + n] + acc[mi][ni][r];
                }
            }
    }
};

struct PolMoe1 : NoPre {
    const bf16_t *xb, *B; const int* idx; bf16_t* H; int n0;
    __device__ __forceinline__ const bf16_t* adA(int row, int kt, int c8) const { return xb + (size_t)idx[row] * 1024 + kt * 64 + c8 * 8; }
    __device__ __forceinline__ const bf16_t* adB(int row, int kt, int c8) const { return B + (size_t)row * 1024 + kt * 64 + c8 * 8; }
    __device__ __forceinline__ uint4 ldA(int row, int kt, int c8) const { return *(const uint4*)adA(row, kt, c8); }
    __device__ __forceinline__ uint4 ldB(int row, int kt, int c8) const { return *(const uint4*)adB(row, kt, c8); }
    template <class C> __device__ __forceinline__ void epi(f32x16 (&acc)[C::MI][C::NI], int wm, int wn, int lane) const {
        static_assert(C::NI == 2, "gate/up pairs need a 64-column wave tile");
        const int f = ((n0 + wn * 64) >> 1) + (lane & 31);
#pragma unroll
        for (int mi = 0; mi < C::MI; ++mi)
#pragma unroll
            for (int r = 0; r < 16; ++r) {
                const int m = wm * (C::MI * 32) + mi * 32 + 8 * (r >> 2) + 4 * (lane >> 5) + (r & 3);
                H[(size_t)m * 1024 + f] = f2bf(silu_f(acc[mi][0][r]) * acc[mi][1][r]);
            }
    }
};
struct PolMoe2 : NoPre {
    const bf16_t *A, *B; const float* gate; bf16_t* Y;
    __device__ __forceinline__ const bf16_t* adA(int row, int kt, int c8) const { return A + (size_t)row * 1024 + kt * 64 + c8 * 8; }
    __device__ __forceinline__ const bf16_t* adB(int row, int kt, int c8) const { return B + (size_t)row * 1024 + kt * 64 + c8 * 8; }
    __device__ __forceinline__ uint4 ldA(int row, int kt, int c8) const { return *(const uint4*)adA(row, kt, c8); }
    __device__ __forceinline__ uint4 ldB(int row, int kt, int c8) const { return *(const uint4*)adB(row, kt, c8); }
    template <class C> __device__ __forceinline__ void epi(f32x16 (&acc)[C::MI][C::NI], int wm, int wn, int lane) const {
#pragma unroll
        for (int mi = 0; mi < C::MI; ++mi)
#pragma unroll
            for (int r = 0; r < 16; ++r) {
                const int m = wm * (C::MI * 32) + mi * 32 + 8 * (r >> 2) + 4 * (lane >> 5) + (r & 3);
                const float gt = gate[m];
#pragma unroll
                for (int ni = 0; ni < C::NI; ++ni) Y[(size_t)m * 1024 + wn * (C::NI * 32) + ni * 32 + (lane & 31)] = f2bf(acc[mi][ni][r] * gt);
            }
    }
};
template <bool SWAP> struct PolQkv : NoPre {
    const bf16_t *A, *B; char* ws; int m0, n0;
    __device__ __forceinline__ const bf16_t* adA(int row, int kt, int c8) const { return A + (size_t)row * 1024 + kt * 64 + c8 * 8; }
    __device__ __forceinline__ const bf16_t* adB(int row, int kt, int c8) const { return B + (size_t)row * 1024 + kt * 64 + c8 * 8; }
    __device__ __forceinline__ uint4 ldA(int row, int kt, int c8) const { return *(const uint4*)adA(row, kt, c8); }
    __device__ __forceinline__ uint4 ldB(int row, int kt, int c8) const { return *(const uint4*)adB(row, kt, c8); }
    template <class C> __device__ __forceinline__ void epi(f32x16 (&acc)[C::MI][C::NI], int wm, int wn, int lane) const {
        const int mb = m0 + wm * (C::MI * 32);
        if (!SWAP) {
            bf16_t* dstb = (bf16_t*)(ws + ((n0 >> 10) ? N_K : N_Q));
#pragma unroll
            for (int mi = 0; mi < C::MI; ++mi)
#pragma unroll
                for (int ni = 0; ni < C::NI; ++ni) {
                    const int hh = ((n0 & 1023) + wn * (C::NI * 32) + ni * 32) >> 5;
#pragma unroll
                    for (int r = 0; r < 16; ++r) {
                        const int tok = mb + mi * 32 + 8 * (r >> 2) + 4 * (lane >> 5) + (r & 3);
                        dstb[((size_t)hh * T_ALL + tok) * 32 + (lane & 31)] = f2bf(acc[mi][ni][r]);
                    }
                }
        } else {
            bf16_t* Vt = (bf16_t*)(ws + N_VT);
#pragma unroll
            for (int mi = 0; mi < C::MI; ++mi) {
                const int tok = mb + mi * 32 + (lane & 31);
#pragma unroll
                for (int ni = 0; ni < C::NI; ++ni)
#pragma unroll
                    for (int r = 0; r < 16; ++r) {
                        const int col = n0 - 2048 + wn * (C::NI * 32) + ni * 32 + 8 * (r >> 2) + 4 * (lane >> 5) + (r & 3);
                        Vt[(size_t)col * T_ALL + tok] = f2bf(acc[mi][ni][r]);
                    }
            }
        }
    }
};

__device__ __forceinline__ void transpose_tile(const float* src0, const float* src1, int ld, bf16_t* dst, int K, int n0, int k0, int mode, char* smem, const int TID) {
    float* tile = (float*)smem;
    const int t = TID;
    {
        const int n4 = (t & 15) * 4, kr = t >> 4;
        const int np = n0 + n4;
        const float* s = src0; int col = np;
        if (mode == 1 && np < 2048) {
            const int base = np & ~255, r = np & 255, g = r >> 5, u = r & 31;
            const int i = g * 16 + (u & 15);
            col = base + ((u < 16) ? i : (i + 128));
        } else if (mode == 2) {
            const int g = np >> 5, u = np & 31;
            if (u >= 16) s = src1;
            col = g * 16 + (u & 15);
        }
#pragma unroll
        for (int kk = 0; kk < 4; ++kk) {
            const int k = kr + 32 * kk;
            const float4 v = *(const float4*)(s + (size_t)(k0 + k) * ld + col);
            tile[k * 65 + n4 + 0] = v.x; tile[k * 65 + n4 + 1] = v.y; tile[k * 65 + n4 + 2] = v.z; tile[k * 65 + n4 + 3] = v.w;
        }
    }
    __syncthreads();
    {
        const int n = t >> 3, kc = (t & 7) * 16;
        const int np = n0 + n;
        float sc = 1.f;
        if (mode == 1 && np >= 1024 && np < 2048) sc = 0.0625f;
        if (mode == 3 && np < 1024) sc = 0.17677669529663687f * 1.4426950408889634f;
        unsigned o[8];
#pragma unroll
        for (int j = 0; j < 8; ++j) o[j] = pk_bf16(tile[(kc + 2 * j) * 65 + n] * sc, tile[(kc + 2 * j + 1) * 65 + n] * sc);
        uint4* d = (uint4*)(dst + (size_t)np * K + k0 + kc);
        d[0] = make_uint4(o[0], o[1], o[2], o[3]);
        d[1] = make_uint4(o[4], o[5], o[6], o[7]);
    }
    __syncthreads();
}
__device__ void convert_matrix(const float* src0, const float* src1, int ld, bf16_t* dst, int N, int K, int mode, char* smem, int& rot, const int TID, int wid, int nw) {
    const int ntn = N / 64, ntk = K / 128, nt = ntn * ntk;
    if (wid >= 0) {
        int start = (wid + nw - (rot % nw)) % nw;
        for (int t = start; t < nt; t += nw) transpose_tile(src0, src1, ld, dst, K, (t % ntn) * 64, (t / ntn) * 128, mode, smem, TID);
    }
    rot += nt;
}

template <int MODE_SRC, bool WRITE_XB, bool ROUTER>
__device__ void ln_phase(const Params& p, const float* gam, const float* bet, const float* wr, size_t xb_off, char* smem, const int TID) {
    float* wrT = (float*)smem;
    if (ROUTER) {
        for (int i = TID; i < 16 * 1024; i += NT) { const int d = i >> 4, e = i & 15; wrT[e * 1024 + d] = wr[i]; }
        __syncthreads();
    }
    const int lane = TID & 63, w = TID >> 6;
    bf16_t* xb = (bf16_t*)(p.ws + xb_off);
    const bf16_t* ye = (const bf16_t*)(p.ws + M_YE);
    const int* pos = (const int*)(p.ws + M_POS);
    float* aff = (float*)(p.ws + M_AFF);
    const int tstride = gridDim.x * 8;
    int tok = blockIdx.x * 8 + w;
    float4 nv[4]; int npos = -1;
    if (tok < T_ALL) {
#pragma unroll
        for (int k = 0; k < 4; ++k) nv[k] = *(const float4*)(p.out + (size_t)tok * 1024 + k * 256 + lane * 4);
        if (MODE_SRC == 1) npos = pos[(size_t)tok * 16 + (lane & 15)];
    }
    for (; tok < T_ALL; tok += tstride) {
        float* xr = p.out + (size_t)tok * 1024;
        float4 v[4];
#pragma unroll
        for (int k = 0; k < 4; ++k) v[k] = nv[k];
        const int cpos = npos;
        if (tok + tstride < T_ALL) {
#pragma unroll
            for (int k = 0; k < 4; ++k) nv[k] = *(const float4*)(p.out + (size_t)(tok + tstride) * 1024 + k * 256 + lane * 4);
            if (MODE_SRC == 1) npos = pos[(size_t)(tok + tstride) * 16 + (lane & 15)];
        }
        if (MODE_SRC == 1) {
#pragma unroll
            for (int k = 0; k < 4; ++k) { v[k].x *= ALPHA; v[k].y *= ALPHA; v[k].z *= ALPHA; v[k].w *= ALPHA; }
            const int trunk = tok >= T_PROMPT;
            const int cap = trunk ? CAP_S : CAP_P;
            const size_t rb = trunk ? (size_t)16 * CAP_P : 0;
            unsigned long long m = __ballot(cpos >= 0) & 0xffffull;
            while (m) {
                const int e0 = __builtin_ctzll(m); m &= m - 1;
                const int e1 = m ? __builtin_ctzll(m) : -1; if (m) m &= m - 1;
                const int p0 = __builtin_amdgcn_readlane(cpos, e0);
                const int p1 = __builtin_amdgcn_readlane(cpos, e1 >= 0 ? e1 : e0);
                const bf16_t* y0 = ye + (rb + (size_t)e0 * cap + p0) * 1024;
                const bf16_t* y1 = ye + (rb + (size_t)(e1 >= 0 ? e1 : e0) * cap + (e1 >= 0 ? p1 : p0)) * 1024;
                uint2 u0[4], u1[4];
#pragma unroll
                for (int k = 0; k < 4; ++k) { u0[k] = *(const uint2*)(y0 + k * 256 + lane * 4); u1[k] = *(const uint2*)(y1 + k * 256 + lane * 4); }
                const float s1 = (e1 >= 0) ? 1.f : 0.f;
#pragma unroll
                for (int k = 0; k < 4; ++k) {
                    v[k].x += bf_lo(u0[k].x); v[k].y += bf_hi(u0[k].x); v[k].z += bf_lo(u0[k].y); v[k].w += bf_hi(u0[k].y);
                    v[k].x += s1 * bf_lo(u1[k].x); v[k].y += s1 * bf_hi(u1[k].x); v[k].z += s1 * bf_lo(u1[k].y); v[k].w += s1 * bf_hi(u1[k].y);
                }
            }
        }
        float s = 0.f;
#pragma unroll
        for (int k = 0; k < 4; ++k) s += v[k].x + v[k].y + v[k].z + v[k].w;
        const float mu = wave_sum(s) * (1.f / 1024.f);
        float q = 0.f;
#pragma unroll
        for (int k = 0; k < 4; ++k) {
            v[k].x -= mu; v[k].y -= mu; v[k].z -= mu; v[k].w -= mu;
            q += v[k].x * v[k].x + v[k].y * v[k].y + v[k].z * v[k].z + v[k].w * v[k].w;
        }
        const float rstd = rsqrtf(wave_sum(q) * (1.f / 1024.f) + LN_EPS);
#pragma unroll
        for (int k = 0; k < 4; ++k) {
            const float4 g = *(const float4*)(gam + k * 256 + lane * 4);
            const float4 b = *(const float4*)(bet + k * 256 + lane * 4);
            v[k].x = v[k].x * rstd * g.x + b.x; v[k].y = v[k].y * rstd * g.y + b.y;
            v[k].z = v[k].z * rstd * g.z + b.z; v[k].w = v[k].w * rstd * g.w + b.w;
            *(float4*)(xr + k * 256 + lane * 4) = v[k];
            if (WRITE_XB) *(uint2*)(xb + (size_t)tok * 1024 + k * 256 + lane * 4) = make_uint2(pk_bf16(v[k].x, v[k].y), pk_bf16(v[k].z, v[k].w));
        }
        if (ROUTER) {
            float mylog = -1e30f;
#pragma unroll 2
            for (int e = 0; e < 16; ++e) {
                float a = 0.f;
#pragma unroll
                for (int k = 0; k < 4; ++k) {
                    const float4 wv = *(const float4*)(wrT + e * 1024 + k * 256 + lane * 4);
                    a += v[k].x * wv.x + v[k].y * wv.y + v[k].z * wv.z + v[k].w * wv.w;
                }
                a = wave_sum(a);
                if (lane == e) mylog = a;
            }
            const float mx = row16_max(mylog);
            const float ex = (lane < 16) ? expf(mylog - mx) : 0.f;
            const float mine = ex / row16_sum(ex);
            if (lane < 16) {
                const int trunk = tok >= T_PROMPT;
                const int tt = trunk ? T3 : T_PROMPT;
                const int tl = trunk ? tok - T_PROMPT : tok;
                aff[(trunk ? (size_t)T_PROMPT * 16 : 0) + (size_t)lane * tt + tl] = mine;
            }
        }
    }
    __syncthreads();
}

template <int NPT>
__device__ __forceinline__ void topk_item(const float* a, int cap, int* idx, float* gate, int* pos, int e, char* smem, const int TID) {
    int* part = (int*)smem;
    int* sh_cnt = (int*)(smem + 64);
    unsigned key[NPT];
#pragma unroll
    for (int k = 0; k < NPT; ++k) key[k] = __float_as_uint(a[k * NT + TID]);
    if (TID == 0) *sh_cnt = 0;
    const int lane = TID & 63, w = TID >> 6;
    u64 pref = 0ull;
    for (int bit = 45; bit >= 0; --bit) {
        const u64 cand = pref | (1ull << bit);
        const unsigned cb = (unsigned)(cand >> 15), ci = (unsigned)(cand & 32767ull);
        int c = 0;
        const int lim = 32767 - TID - (int)ci;
#pragma unroll
        for (int k = 0; k < NPT; ++k) c += (key[k] > cb || (key[k] == cb && k * NT <= lim)) ? 1 : 0;
#pragma unroll
        for (int o = 32; o > 0; o >>= 1) c += __shfl_xor(c, o, 64);
        int* pp = part + (bit & 1) * 8;
        if (lane == 0) pp[w] = c;
        __syncthreads();
        const int tot = pp[0] + pp[1] + pp[2] + pp[3] + pp[4] + pp[5] + pp[6] + pp[7];
        if (tot >= cap) pref = cand;
    }
    const unsigned cb = (unsigned)(pref >> 15), ci = (unsigned)(pref & 32767ull);
    int mine = 0;
    const int lim = 32767 - TID - (int)ci;
#pragma unroll
    for (int k = 0; k < NPT; ++k) mine += (key[k] > cb || (key[k] == cb && k * NT <= lim)) ? 1 : 0;
    int slot = atomicAdd(sh_cnt, mine);
    const float* ap = a + TID;
    int* pp = pos + (size_t)TID * 16 + e;
#pragma unroll 4
    for (int k = 0; k < NPT; ++k) {
        const float av = ap[(size_t)k * NT];
        const unsigned kb = __float_as_uint(av);
        const bool sel = (kb > cb || (kb == cb && k * NT <= lim));
        int ps = -1;
        if (sel) { ps = slot++; idx[ps] = k * NT + TID; gate[ps] = av; }
        pp[(size_t)k * (NT * 16)] = ps;
    }
    __syncthreads();
}
__device__ void topk_phase(const Params& p, char* smem, const int TID) {
    const float* aff = (const float*)(p.ws + M_AFF);
    int* idx = (int*)(p.ws + M_IDX);
    float* gate = (float*)(p.ws + M_GATE);
    int* pos = (int*)(p.ws + M_POS);
    for (int item = blockIdx.x; item < 32; item += gridDim.x) {
        const int trunk = item >> 4, e = item & 15;
        if (trunk == 0) topk_item<64>(aff + (size_t)e * T_PROMPT, CAP_P, idx + (size_t)e * CAP_P, gate + (size_t)e * CAP_P, pos, e, smem, TID);
        else topk_item<32>(aff + (size_t)T_PROMPT * 16 + (size_t)e * T3, CAP_S, idx + (size_t)16 * CAP_P + (size_t)e * CAP_S, gate + (size_t)16 * CAP_P + (size_t)e * CAP_S,
                           pos + (size_t)T_PROMPT * 16, e, smem, TID);
    }
}

typedef unsigned u32x2v __attribute__((ext_vector_type(2)));
__device__ __forceinline__ float xrow_max(float v) {
    u32x2v r = __builtin_amdgcn_permlane16_swap(__float_as_uint(v), __float_as_uint(v), false, false);
    v = fmaxf(__uint_as_float(r[0]), __uint_as_float(r[1]));
    r = __builtin_amdgcn_permlane32_swap(__float_as_uint(v), __float_as_uint(v), false, false);
    return fmaxf(__uint_as_float(r[0]), __uint_as_float(r[1]));
}
__device__ __forceinline__ float xrow_sum(float v) {
    u32x2v r = __builtin_amdgcn_permlane16_swap(__float_as_uint(v), __float_as_uint(v), false, false);
    v = __uint_as_float(r[0]) + __uint_as_float(r[1]);
    r = __builtin_amdgcn_permlane32_swap(__float_as_uint(v), __float_as_uint(v), false, false);
    return __uint_as_float(r[0]) + __uint_as_float(r[1]);
}

constexpr int NA_VSTR = 1936;
constexpr int NA_SK = 0, NA_SV = 61440, NA_SB = 61440 + 32 * NA_VSTR;
__device__ void na_phase(const Params& p, char* smem, const int TID) {
    const bf16_t* Qh = (const bf16_t*)(p.ws + N_Q);
    const bf16_t* Kh = (const bf16_t*)(p.ws + N_K);
    const bf16_t* NVt = (const bf16_t*)(p.ws + N_VT);
    bf16_t* O = (bf16_t*)(p.ws + M_XB2);
    char* sK = smem + NA_SK; char* sV = smem + NA_SV; float* sB = (float*)(smem + NA_SB);
    const int lane = TID & 63, w = TID >> 6, qi = lane & 15, hi = lane >> 4;
    for (int item = blockIdx.x; item < 96 * 32; item += gridDim.x) {
        const int h = item & 31, rgp = item >> 5;
        int seq_base, rows, g;
        if (rgp < 64) { seq_base = (rgp >> 2) * 2048; rows = 32; g = rgp & 3; }
        else { seq_base = T_PROMPT; rows = 256; g = rgp - 64; }
        const int r0 = g * 8;
        const int rs0 = min(max(r0 - 4, 0), rows - 8), rs1 = min(max(r0 + 3, 0), rows - 8);
        const int nrows = rs1 + 8 - rs0;
        __syncthreads();
        {
            const uint4* src = (const uint4*)(Kh + ((size_t)h * T_ALL + seq_base + rs0 * 64) * 32);
            const int nk16 = nrows * 256, nv16 = nrows * 8;
            uint4 kv[8], vv[8];
#pragma unroll
            for (int i = 0; i < 8; ++i) kv[i] = src[min(TID + i * NT, nk16 - 1)];
#pragma unroll
            for (int j = 0; j < 4; ++j) {
                const uint4* vs = (const uint4*)(NVt + (size_t)(h * 32 + w + 8 * j) * T_ALL + seq_base + rs0 * 64);
#pragma unroll
                for (int i = 0; i < 2; ++i) vv[j * 2 + i] = vs[min(lane + 64 * i, nv16 - 1)];
            }
#define NA_PIN4(v) asm volatile("" : "+v"((v).x), "+v"((v).y), "+v"((v).z), "+v"((v).w))
#pragma unroll
            for (int i = 0; i < 8; ++i) { NA_PIN4(kv[i]); NA_PIN4(vv[i]); }
#undef NA_PIN4
#pragma unroll
            for (int i = 0; i < 8; ++i) { const int c = TID + i * NT; if (c < nk16) ((uint4*)sK)[c] = kv[i]; }
#pragma unroll
            for (int j = 0; j < 4; ++j)
#pragma unroll
                for (int i = 0; i < 2; ++i) { const int c = lane + 64 * i; if (c < nv16) *(uint4*)(sV + (w + 8 * j) * NA_VSTR + c * 16) = vv[j * 2 + i]; }
            for (int c = TID; c < 465; c += NT) sB[c] = p.na_rpb[h * 465 + c] * 1.4426950408889634f;
        }
        __syncthreads();
        const int r = r0 + w;
        const int rs = min(max(r - 4, 0), rows - 8);
        const int lr0 = rs - rs0;
#pragma unroll 1
        for (int qb = 0; qb < 4; ++qb) {
            const int c = qb * 16 + qi;
            const int cs = min(max(c - 8, 0), 48);
            const int kb0 = min(max(qb - 1, 0), 1);
            const int tq = seq_base + r * 64 + c;
            const bf16x8 qf = *(const bf16x8*)(Qh + ((size_t)h * T_ALL + tq) * 32 + hi * 8);
            typedef float f32x2v __attribute__((ext_vector_type(2)));
            f32x2v s[24][2];
            f32x2v mk[3][2];
#pragma unroll
            for (int jb = 0; jb < 3; ++jb)
#pragma unroll
                for (int e = 0; e < 4; ++e) {
                    const int kcol = (kb0 + jb) * 16 + 4 * hi + e;
                    mk[jb][e >> 1][e & 1] = ((kcol >= cs) && (kcol < cs + 16)) ? 0.f : -1e30f;
                }
            float mx = -1e30f;
#pragma unroll
            for (int a = 0; a < 8; ++a)
#pragma unroll
                for (int jb = 0; jb < 3; ++jb) {
                    const int kcb = (kb0 + jb) * 16;
                    const bf16x8 kf = *(const bf16x8*)(sK + ((lr0 + a) * 64 + kcb + qi) * 64 + hi * 16);
                    f32x4 z = {0.f, 0.f, 0.f, 0.f};
                    const f32x4 sc = __builtin_amdgcn_mfma_f32_16x16x32_bf16(kf, qf, z, 0, 0, 0);
                    const float* rpr = sB + (rs + a - r + 7) * 31;
                    f32x2v bv[2];
#pragma unroll
                    for (int e = 0; e < 4; ++e) bv[e >> 1][e & 1] = rpr[min(max(kcb + 4 * hi + e - c + 15, 0), 30)];
                    const f32x2v v0 = (f32x2v){sc[0], sc[1]} + (bv[0] + mk[jb][0]);
                    const f32x2v v1 = (f32x2v){sc[2], sc[3]} + (bv[1] + mk[jb][1]);
                    s[a * 3 + jb][0] = v0; s[a * 3 + jb][1] = v1;
                    mx = fmaxf(fmaxf(mx, fmaxf(v0[0], v0[1])), fmaxf(v1[0], v1[1]));
                }
            mx = xrow_max(mx);
            const f32x2v mxv = {mx, mx};
            f32x2v sumv = {0.f, 0.f};
#pragma unroll
            for (int t = 0; t < 24; ++t)
#pragma unroll
                for (int hh = 0; hh < 2; ++hh) {
                    const f32x2v d = s[t][hh] - mxv;
                    f32x2v pv; pv[0] = __builtin_amdgcn_exp2f(d[0]); pv[1] = __builtin_amdgcn_exp2f(d[1]);
                    s[t][hh] = pv; sumv += pv;
                }
            const float inv = __builtin_amdgcn_rcpf(xrow_sum(sumv[0] + sumv[1]));
            const f32x2v invv = {inv, inv};
            f32x4 o0 = {0.f, 0.f, 0.f, 0.f}, o1 = {0.f, 0.f, 0.f, 0.f};
            const char* vr0 = sV + qi * NA_VSTR;
            const char* vr1 = sV + (16 + qi) * NA_VSTR;
#pragma unroll
            for (int pi = 0; pi < 12; ++pi) {
                const int t0 = 2 * pi, t1 = 2 * pi + 1;
                const int ka = ((lr0 + t0 / 3) * 64 + (kb0 + t0 % 3) * 16 + 4 * hi) * 2;
                const int kb = ((lr0 + t1 / 3) * 64 + (kb0 + t1 % 3) * 16 + 4 * hi) * 2;
                union { bf16x8 v; unsigned u[4]; } pf, v0, v1;
                const f32x2v q00 = s[t0][0] * invv, q01 = s[t0][1] * invv, q10 = s[t1][0] * invv, q11 = s[t1][1] * invv;
                pf.u[0] = pk_bf16(q00[0], q00[1]); pf.u[1] = pk_bf16(q01[0], q01[1]);
                pf.u[2] = pk_bf16(q10[0], q10[1]); pf.u[3] = pk_bf16(q11[0], q11[1]);
                const uint2 a0 = *(const uint2*)(vr0 + ka), b0 = *(const uint2*)(vr0 + kb);
                const uint2 a1 = *(const uint2*)(vr1 + ka), b1 = *(const uint2*)(vr1 + kb);
                v0.u[0] = a0.x; v0.u[1] = a0.y; v0.u[2] = b0.x; v0.u[3] = b0.y;
                v1.u[0] = a1.x; v1.u[1] = a1.y; v1.u[2] = b1.x; v1.u[3] = b1.y;
                o0 = __builtin_amdgcn_mfma_f32_16x16x32_bf16(pf.v, v0.v, o0, 0, 0, 0);
                o1 = __builtin_amdgcn_mfma_f32_16x16x32_bf16(pf.v, v1.v, o1, 0, 0, 0);
            }
#pragma unroll
            for (int e = 0; e < 4; ++e) {
                const int q = 4 * hi + e;
                bf16_t* dst = O + (size_t)(seq_base + r * 64 + qb * 16 + q) * 1024 + h * 32 + qi;
                dst[0] = f2bf(o0[e]);
                dst[16] = f2bf(o1[e]);
            }
        }
    }
}

#define XB_TMO      128
#define XB_XCNT(j)  (256  + 64 * (j))
#define XB_XSUB(j)  (1280 + 64 * (j))
#define XB_XGEN(j)  (2304 + 64 * (j))
#define XB_TOP      3328
#define XB_TOPGEN   3392
#define XCD_BAR_WORDS 3456
#define XB_SPIN_CAP (1u << 18)
__device__ __forceinline__ unsigned xb_ld(unsigned* p)              { return __hip_atomic_load(p, __ATOMIC_RELAXED, __HIP_MEMORY_SCOPE_AGENT); }
__device__ __forceinline__ unsigned xb_add(unsigned* p, unsigned v) { return __hip_atomic_fetch_add(p, v, __ATOMIC_RELAXED, __HIP_MEMORY_SCOPE_AGENT); }
__device__ __forceinline__ unsigned xb_xcc_id() { return (unsigned)__builtin_amdgcn_s_getreg((3 << 11) | 20) & 0xFu; }
#define XB_SPIN(cond, bar) do { unsigned _sp = 0; while (cond) { __builtin_amdgcn_s_sleep(1); \
    if ((++_sp & 255u) == 0u) { if (xb_ld(&(bar)[XB_TMO])) break; if (_sp > XB_SPIN_CAP) { atomicAdd(&(bar)[XB_TMO], 1u); break; } } } } while (0)
struct XcdBarrier { unsigned* bar; unsigned x; volatile LAS3 unsigned* st; };
__device__ __forceinline__ XcdBarrier xcd_barrier_post(unsigned* bar, volatile LAS3 unsigned* st, int tid) {
    XcdBarrier b; b.bar = bar; b.x = xb_xcc_id(); b.st = st;
    if (tid == 0) (void)xb_add(&bar[XB_XCNT(b.x)], 1u);
    return b;
}
__device__ __forceinline__ void xcd_barrier_complete(unsigned* bar, unsigned x, unsigned& nloc, unsigned& nx) {
    const unsigned G = gridDim.x * gridDim.y * gridDim.z;
    unsigned sum, cnt, mine, sp = 0u;
    for (;;) {
        sum = 0u; cnt = 0u; mine = 0u;
#pragma unroll
        for (unsigned j = 0; j < 16; ++j) { const unsigned c = xb_ld(&bar[XB_XCNT(j)]); sum += c; cnt += (c > 0u) ? 1u : 0u; mine = (j == x) ? c : mine; }
        if (sum == G) break;
        __builtin_amdgcn_s_sleep(1);
        if ((++sp & 255u) == 0u) { if (xb_ld(&bar[XB_TMO])) break; if (sp > XB_SPIN_CAP) { atomicAdd(&bar[XB_TMO], 1u); break; } }
    }
    nloc = mine > 0u ? mine : 1u; nx = cnt > 0u ? cnt : 1u;
}
__device__ __forceinline__ void xcd_barrier(const XcdBarrier& b, int tid) {
    asm volatile("s_waitcnt vmcnt(0)" ::: "memory");
    __syncthreads();
    if (tid == 0) {
        unsigned* bar = b.bar;
        __builtin_amdgcn_s_waitcnt(0);
        unsigned nloc = b.st[0], nx = b.st[1];
        if (nloc == 0u) { xcd_barrier_complete(bar, b.x, nloc, nx); b.st[0] = nloc; b.st[1] = nx; }
        const unsigned old = xb_add(&bar[XB_XSUB(b.x)], 1u);
        const unsigned gen = old / nloc;
        if (old + 1u == (gen + 1u) * nloc) {
            __builtin_amdgcn_fence(__ATOMIC_RELEASE, "agent");
            asm volatile("s_waitcnt vmcnt(0)" ::: "memory");
            const unsigned og = xb_add(&bar[XB_TOP], 1u);
            const unsigned tg = og / nx;
            if (og + 1u == (tg + 1u) * nx) xb_add(&bar[XB_TOPGEN], 1u);
            else XB_SPIN(xb_ld(&bar[XB_TOPGEN]) == tg, bar);
            __builtin_amdgcn_fence(__ATOMIC_ACQUIRE, "agent");
            xb_add(&bar[XB_XGEN(b.x)], 1u);
            asm volatile("s_waitcnt vmcnt(0)" ::: "memory");
        } else {
            XB_SPIN(xb_ld(&bar[XB_XGEN(b.x)]) == gen, bar);
            __builtin_amdgcn_fence(__ATOMIC_ACQUIRE, "agent");
            asm volatile("s_waitcnt vmcnt(0)" ::: "memory");
        }
    }
    __syncthreads();
}

__device__ __forceinline__ bool tile_map(int k, int MT, int NTN, int MS, int NS, int& m, int& n) {
    const int bid = blockIdx.x;
    if (gridDim.x != 256) { const int t = k * gridDim.x + bid; if (t >= MT * NTN) return false; m = t / NTN; n = t % NTN; return true; }
    const int NG = NTN / NS, total = (MT / MS) * NG;
    const int s = k * 8 + (bid & 7);
    if (s >= total) return false;
    const int j = bid >> 3;
    m = (s / NG) * MS + j / NS; n = (s % NG) * NS + j % NS;
    return true;
}

enum { PH_PRE = 0, PH_R0 = 1  , PH_LN0A = 16, PH_TOPK0, PH_MOE1_0, PH_MOE2_0, PH_LN0B, PH_QKV, PH_NA, PH_NAOUT, PH_LN1A, PH_TOPK1, PH_MOE1_1, PH_MOE2_1, PH_LN1B, PH_COUNT };

namespace pg8 {
#define PG8_LAS __attribute__((address_space(3)))
typedef unsigned short bf16_t;
typedef short bf16x8 __attribute__((ext_vector_type(8)));
typedef float f32x4 __attribute__((ext_vector_type(4)));
typedef unsigned u32x4 __attribute__((ext_vector_type(4)));
constexpr int BM = 256, BK = 64, HALF = 128, HTB = HALF * BK * 2  , STAGE_BYTES = 8 * HTB, NXCD = 8, WGM = 8;

__host__ __device__ __forceinline__ int lds_byte(int r, int c) { const int st = (r >> 4) * 2 + (c >> 5), rr = r & 15, cc = c & 31, ob = rr * 64 + cc * 2; return st * 1024 + (ob ^ (((ob >> 9) & 1) << 5)); }
__host__ __device__ __forceinline__ void stage_rc(int b, int& R, int& C) { const int st = b / 1024, sb = b % 1024, swz = sb ^ (((sb >> 9) & 1) << 5); R = (st >> 1) * 16 + swz / 64; C = (st & 1) * 32 + (swz % 64) / 2; }
__host__ __device__ __forceinline__ int perm32(int rho) { const int n = rho >> 4, i = rho & 15; return 8 * (i >> 2) + 4 * n + (i & 3); }

struct Unit { int pm, pn; };
struct Gemm { const bf16_t* A; const bf16_t* Bt; int M, N, K; };

template <class Epi, class Sched, bool STAMP = false>
__device__ __forceinline__ void gemm_phase(PG8_LAS unsigned char* lds, const Gemm g, const Sched& S, const Epi& E, unsigned long long* stamps, const int tid_in) {
    const int tid = tid_in, wid = __builtin_amdgcn_readfirstlane(tid >> 6), lane = tid & 63, wr = wid >> 2, wc = wid & 3, fr = lane & 15, fq = lane >> 4;
    const int K = g.K, nt = K / BK;
    int ts_lo = 0, ts_hi = 0, nts = 0; const unsigned long long rt_entry = STAMP ? (unsigned long long)wall_clock64() : 0ull;
#define PG8_STAMP() do { if (STAMP && wid == 0 && nts < 64) { const unsigned long long _c = (unsigned long long)clock64(); \
        ts_lo = (lane == nts) ? (int)(unsigned)_c : ts_lo; ts_hi = (lane == nts) ? (int)(unsigned)(_c >> 32) : ts_hi; ++nts; } } while (0)
    PG8_STAMP();
    unsigned voffA[2], voffB[2];
#pragma unroll
    for (int i = 0; i < 2; ++i) { int R, C; stage_rc(tid * 16 + i * 8192, R, C); const int Rb = Epi::PERM ? ((R & ~31) + perm32(R & 31)) : R;
        voffA[i] = (unsigned)(R * K + C) * 2u; voffB[i] = (unsigned)(Rb * K + C) * 2u; }
    const size_t kstep = (size_t)(BK * 2);
    const size_t hstep = (size_t)HALF * K * 2;
    const size_t tstep = 2 * hstep;
    const unsigned ldsw = (unsigned)wid * 1024u;
    const int aoff = lds_byte(wr * 64 + fr, fq * 8), boff = lds_byte(wc * 32 + fr, fq * 8);
#define PG8_SA(b, h) (((b) * 2 + (h)) * HTB)
#define PG8_SB(b, h) ((4 + (b) * 2 + (h)) * HTB)
#define PG8_STAGE(bufoff, gbase, voff) do { _Pragma("unroll") for (int _i = 0; _i < 2; ++_i) \
        __builtin_amdgcn_global_load_lds((const unsigned*)((const char*)(gbase) + (voff)[_i]), (PG8_LAS unsigned*)(lds + (bufoff) + ldsw + _i * 8192), 16, 0, 0); } while (0)
#define PG8_LDA(dst, b, h) do { _Pragma("unroll") for (int m = 0; m < 4; ++m) _Pragma("unroll") for (int k = 0; k < 2; ++k) dst[m][k] = *(const PG8_LAS bf16x8*)(lds + PG8_SA(b, h) + aoff + m * 2048 + k * 1024); } while (0)
#define PG8_LDB(dst, b, h) do { _Pragma("unroll") for (int n = 0; n < 2; ++n) _Pragma("unroll") for (int k = 0; k < 2; ++k) dst[n][k] = *(const PG8_LAS bf16x8*)(lds + PG8_SB(b, h) + boff + n * 2048 + k * 1024); } while (0)
#define PG8_MMA(ai, bj, At, Bt) do { __builtin_amdgcn_s_setprio(1); _Pragma("unroll") for (int m = 0; m < 4; ++m) _Pragma("unroll") for (int n = 0; n < 2; ++n) _Pragma("unroll") for (int k = 0; k < 2; ++k) \
        acc[ai][bj][m][n] = __builtin_amdgcn_mfma_f32_16x16x32_bf16(Bt[n][k], At[m][k], acc[ai][bj][m][n], 0, 0, 0); __builtin_amdgcn_s_setprio(0); } while (0)
#define PG8_WAIT_V(n) asm volatile("s_waitcnt vmcnt(" #n ")" ::: "memory")
#define PG8_WAIT_L(n) asm volatile("s_waitcnt lgkmcnt(" #n ")" ::: "memory")
#define PG8_BAR __builtin_amdgcn_s_barrier()
#define PG8_SCHED __builtin_amdgcn_sched_barrier(0)
    Unit cur, nxt; int ui = 0;
    if (!S.next(0, cur)) return;
    f32x4 acc[2][2][4][2];
#pragma unroll
    for (int a = 0; a < 2; ++a)
#pragma unroll
        for (int b = 0; b < 2; ++b)
#pragma unroll
            for (int m = 0; m < 4; ++m)
#pragma unroll
                for (int n = 0; n < 2; ++n) acc[a][b][m][n] = (f32x4){0.f, 0.f, 0.f, 0.f};
    bf16x8 At[4][2], B0[2][2], B1[2][2];
    const char* cA = (const char*)g.A + (size_t)cur.pm * tstep; const char* cB = (const char*)g.Bt + (size_t)cur.pn * tstep;
    S.a_ready(cur);
    PG8_STAGE(PG8_SB(0, 0), cB, voffB); PG8_STAGE(PG8_SA(0, 0), cA, voffA); PG8_STAGE(PG8_SB(0, 1), cB + hstep, voffB); PG8_STAGE(PG8_SA(0, 1), cA + hstep, voffA);
    if (wr == 1) PG8_BAR;
    PG8_WAIT_V(4); PG8_BAR;
    PG8_STAGE(PG8_SB(1, 0), cB + kstep, voffB); PG8_STAGE(PG8_SA(1, 0), cA + kstep, voffA); PG8_STAGE(PG8_SB(1, 1), cB + hstep + kstep, voffB);
    PG8_WAIT_V(6); PG8_BAR;
    PG8_STAMP();
    for (;;) {
        const bool has_next = S.next(ui + 1, nxt);
        const char* nA = has_next ? (const char*)g.A + (size_t)nxt.pm * tstep : cA; const char* nB = has_next ? (const char*)g.Bt + (size_t)nxt.pn * tstep : cB;
        for (int t = 0; t < nt; t += 2) {
            const bool last = (t == nt - 2);
            const char* a1 = cA + (size_t)(t + 1) * kstep;
            const char* a2 = last ? nA : cA + (size_t)(t + 2) * kstep; const char* b2 = last ? nB : cB + (size_t)(t + 2) * kstep;
            const char* a3 = a2 + kstep; const char* b3 = b2 + kstep;
            if (last && has_next) S.a_ready(nxt);
            PG8_LDB(B0, 0, 0); PG8_SCHED; PG8_LDA(At, 0, 0); PG8_STAGE(PG8_SA(1, 1), a1 + hstep, voffA);
            PG8_WAIT_L(8); PG8_BAR; PG8_WAIT_L(0); PG8_MMA(0, 0, At, B0); PG8_BAR; PG8_SCHED;
            PG8_LDB(B1, 0, 1); PG8_STAGE(PG8_SB(0, 0), b2, voffB);
            PG8_BAR; PG8_WAIT_L(0); PG8_MMA(0, 1, At, B1); PG8_BAR;
            PG8_LDA(At, 0, 1); PG8_STAGE(PG8_SA(0, 0), a2, voffA);
            PG8_BAR; PG8_WAIT_L(0); PG8_MMA(1, 0, At, B0); PG8_BAR; PG8_SCHED;
            PG8_STAGE(PG8_SB(0, 1), b2 + hstep, voffB);
            PG8_WAIT_V(6); PG8_BAR; PG8_MMA(1, 1, At, B1); PG8_BAR;
            PG8_LDB(B0, 1, 0); PG8_SCHED; PG8_LDA(At, 1, 0); PG8_STAGE(PG8_SA(0, 1), a2 + hstep, voffA);
            PG8_WAIT_L(8); PG8_BAR; PG8_WAIT_L(0); PG8_MMA(0, 0, At, B0); PG8_BAR; PG8_SCHED;
            PG8_LDB(B1, 1, 1); PG8_STAGE(PG8_SB(1, 0), b3, voffB);
            PG8_BAR; PG8_WAIT_L(0); PG8_MMA(0, 1, At, B1); PG8_BAR;
            PG8_LDA(At, 1, 1); PG8_STAGE(PG8_SA(1, 0), a3, voffA);
            PG8_BAR; PG8_WAIT_L(0); PG8_MMA(1, 0, At, B0); PG8_BAR; PG8_SCHED;
            PG8_STAGE(PG8_SB(1, 1), b3 + hstep, voffB);
            PG8_WAIT_V(6); PG8_BAR; PG8_MMA(1, 1, At, B1); PG8_BAR;
        }
        PG8_STAMP();
        if constexpr (!Epi::AFTER_DRAIN) { E(acc, cur, wr, wc, fr, fq); S.done(cur); }
        PG8_STAMP();
        if (!has_next) break;
#pragma unroll
        for (int a = 0; a < 2; ++a)
#pragma unroll
            for (int b = 0; b < 2; ++b)
#pragma unroll
                for (int m = 0; m < 4; ++m)
#pragma unroll
                    for (int n = 0; n < 2; ++n) acc[a][b][m][n] = (f32x4){0.f, 0.f, 0.f, 0.f};
        cur = nxt; cA = nA; cB = nB; ++ui;
    }
    PG8_WAIT_V(0);
    if (wr == 0) PG8_BAR;
    PG8_BAR;
    if constexpr (Epi::AFTER_DRAIN) { E.fused(acc, cur, wr, wc, fr, fq, lds, wid, lane); S.done(cur); }
    PG8_STAMP();
    if (STAMP && wid == 0) { stamps[lane] = lane < nts ? (((unsigned long long)(unsigned)ts_hi << 32) | (unsigned)ts_lo) : 0ull;
        if (lane == 62) stamps[62] = rt_entry; if (lane == 63) stamps[63] = (unsigned long long)wall_clock64(); }
#undef PG8_STAMP
#undef PG8_SA
#undef PG8_SB
#undef PG8_STAGE
#undef PG8_LDA
#undef PG8_LDB
#undef PG8_MMA
#undef PG8_WAIT_V
#undef PG8_WAIT_L
#undef PG8_BAR
#undef PG8_SCHED
}
template <class Epi, class Sched, bool STAMP = false>
__device__ __forceinline__ void gemm_phase_gather(PG8_LAS unsigned char* lds, const Gemm g, const Sched& S, const Epi& E, unsigned long long* stamps, const int tid_in, const int* gidx, int split_row, int split_add) {
    const int tid = tid_in, wid = __builtin_amdgcn_readfirstlane(tid >> 6), lane = tid & 63, wr = wid >> 2, wc = wid & 3, fr = lane & 15, fq = lane >> 4;
    const int K = g.K, nt = K / BK;
    int ts_lo = 0, ts_hi = 0, nts = 0; const unsigned long long rt_entry = STAMP ? (unsigned long long)wall_clock64() : 0ull;
#define PG8_STAMP() do { if (STAMP && wid == 0 && nts < 64) { const unsigned long long _c = (unsigned long long)clock64(); \
        ts_lo = (lane == nts) ? (int)(unsigned)_c : ts_lo; ts_hi = (lane == nts) ? (int)(unsigned)(_c >> 32) : ts_hi; ++nts; } } while (0)
    PG8_STAMP();
    unsigned voffA[2], voffB[2];
    int Rg[2], Cg[2];
#pragma unroll
    for (int i = 0; i < 2; ++i) { int R, C; stage_rc(tid * 16 + i * 8192, R, C); const int Rb = Epi::PERM ? ((R & ~31) + perm32(R & 31)) : R;
        voffA[i] = (unsigned)(R * K + C) * 2u; voffB[i] = (unsigned)(Rb * K + C) * 2u; Rg[i] = R; Cg[i] = C; }
    unsigned voffC[2][2], voffN[2][2];
#define PG8_GOFF(dst, unit) do { _Pragma("unroll") for (int _h = 0; _h < 2; ++_h) _Pragma("unroll") for (int _i = 0; _i < 2; ++_i) { \
        const int _r = (unit).pm * BM + _h * HALF + Rg[_i]; const int _src = gidx[_r] + (_r >= split_row ? split_add : 0); dst[_h][_i] = (unsigned)(_src * K + Cg[_i]) * 2u; } } while (0)
#define PG8_STAGE_A(bufoff, kbytes, VO, h) do { _Pragma("unroll") for (int _i = 0; _i < 2; ++_i) \
        __builtin_amdgcn_global_load_lds((const unsigned*)(cA + (kbytes) + (VO)[h][_i]), (PG8_LAS unsigned*)(lds + (bufoff) + ldsw + _i * 8192), 16, 0, 0); } while (0)
    const size_t kstep = (size_t)(BK * 2);
    const size_t hstep = (size_t)HALF * K * 2;
    const size_t tstep = 2 * hstep;
    const unsigned ldsw = (unsigned)wid * 1024u;
    const int aoff = lds_byte(wr * 64 + fr, fq * 8), boff = lds_byte(wc * 32 + fr, fq * 8);
#define PG8_SA(b, h) (((b) * 2 + (h)) * HTB)
#define PG8_SB(b, h) ((4 + (b) * 2 + (h)) * HTB)
#define PG8_STAGE(bufoff, gbase, voff) do { _Pragma("unroll") for (int _i = 0; _i < 2; ++_i) \
        __builtin_amdgcn_global_load_lds((const unsigned*)((const char*)(gbase) + (voff)[_i]), (PG8_LAS unsigned*)(lds + (bufoff) + ldsw + _i * 8192), 16, 0, 0); } while (0)
#define PG8_LDA(dst, b, h) do { _Pragma("unroll") for (int m = 0; m < 4; ++m) _Pragma("unroll") for (int k = 0; k < 2; ++k) dst[m][k] = *(const PG8_LAS bf16x8*)(lds + PG8_SA(b, h) + aoff + m * 2048 + k * 1024); } while (0)
#define PG8_LDB(dst, b, h) do { _Pragma("unroll") for (int n = 0; n < 2; ++n) _Pragma("unroll") for (int k = 0; k < 2; ++k) dst[n][k] = *(const PG8_LAS bf16x8*)(lds + PG8_SB(b, h) + boff + n * 2048 + k * 1024); } while (0)
#define PG8_MMA(ai, bj, At, Bt) do { __builtin_amdgcn_s_setprio(1); _Pragma("unroll") for (int m = 0; m < 4; ++m) _Pragma("unroll") for (int n = 0; n < 2; ++n) _Pragma("unroll") for (int k = 0; k < 2; ++k) \
        acc[ai][bj][m][n] = __builtin_amdgcn_mfma_f32_16x16x32_bf16(Bt[n][k], At[m][k], acc[ai][bj][m][n], 0, 0, 0); __builtin_amdgcn_s_setprio(0); } while (0)
#define PG8_WAIT_V(n) asm volatile("s_waitcnt vmcnt(" #n ")" ::: "memory")
#define PG8_WAIT_L(n) asm volatile("s_waitcnt lgkmcnt(" #n ")" ::: "memory")
#define PG8_BAR __builtin_amdgcn_s_barrier()
#define PG8_SCHED __builtin_amdgcn_sched_barrier(0)
    Unit cur, nxt; int ui = 0;
    if (!S.next(0, cur)) return;
    f32x4 acc[2][2][4][2];
#pragma unroll
    for (int a = 0; a < 2; ++a)
#pragma unroll
        for (int b = 0; b < 2; ++b)
#pragma unroll
            for (int m = 0; m < 4; ++m)
#pragma unroll
                for (int n = 0; n < 2; ++n) acc[a][b][m][n] = (f32x4){0.f, 0.f, 0.f, 0.f};
    bf16x8 At[4][2], B0[2][2], B1[2][2];
    const char* cA = (const char*)g.A; const char* cB = (const char*)g.Bt + (size_t)cur.pn * tstep;
    S.a_ready(cur);
    PG8_GOFF(voffC, cur);
    PG8_STAGE(PG8_SB(0, 0), cB, voffB); PG8_STAGE_A(PG8_SA(0, 0), 0, voffC, 0); PG8_STAGE(PG8_SB(0, 1), cB + hstep, voffB); PG8_STAGE_A(PG8_SA(0, 1), 0, voffC, 1);
    if (wr == 1) PG8_BAR;
    PG8_WAIT_V(4); PG8_BAR;
    PG8_STAGE(PG8_SB(1, 0), cB + kstep, voffB); PG8_STAGE_A(PG8_SA(1, 0), kstep, voffC, 0); PG8_STAGE(PG8_SB(1, 1), cB + hstep + kstep, voffB);
    PG8_WAIT_V(6); PG8_BAR;
    PG8_STAMP();
    for (;;) {
        const bool has_next = S.next(ui + 1, nxt);
        const char* nB = has_next ? (const char*)g.Bt + (size_t)nxt.pn * tstep : cB;
#pragma unroll
        for (int _h = 0; _h < 2; ++_h)
#pragma unroll
            for (int _i = 0; _i < 2; ++_i) voffN[_h][_i] = voffC[_h][_i];
        for (int t = 0; t < nt; t += 2) {
            const bool last = (t == nt - 2);
            const size_t kb1 = (size_t)(t + 1) * kstep;
            const size_t kb2 = last ? 0 : (size_t)(t + 2) * kstep; const char* b2 = last ? nB : cB + (size_t)(t + 2) * kstep;
            const size_t kb3 = kb2 + kstep; const char* b3 = b2 + kstep;
            if (last && has_next) { S.a_ready(nxt); PG8_GOFF(voffN, nxt); }
            unsigned v2[2][2];
#pragma unroll
            for (int _h = 0; _h < 2; ++_h)
#pragma unroll
                for (int _i = 0; _i < 2; ++_i) v2[_h][_i] = last ? voffN[_h][_i] : voffC[_h][_i];
            PG8_LDB(B0, 0, 0); PG8_SCHED; PG8_LDA(At, 0, 0); PG8_STAGE_A(PG8_SA(1, 1), kb1, voffC, 1);
            PG8_WAIT_L(8); PG8_BAR; PG8_WAIT_L(0); PG8_MMA(0, 0, At, B0); PG8_BAR; PG8_SCHED;
            PG8_LDB(B1, 0, 1); PG8_STAGE(PG8_SB(0, 0), b2, voffB);
            PG8_BAR; PG8_WAIT_L(0); PG8_MMA(0, 1, At, B1); PG8_BAR;
            PG8_LDA(At, 0, 1); PG8_STAGE_A(PG8_SA(0, 0), kb2, v2, 0);
            PG8_BAR; PG8_WAIT_L(0); PG8_MMA(1, 0, At, B0); PG8_BAR; PG8_SCHED;
            PG8_STAGE(PG8_SB(0, 1), b2 + hstep, voffB);
            PG8_WAIT_V(6); PG8_BAR; PG8_MMA(1, 1, At, B1); PG8_BAR;
            PG8_LDB(B0, 1, 0); PG8_SCHED; PG8_LDA(At, 1, 0); PG8_STAGE_A(PG8_SA(0, 1), kb2, v2, 1);
            PG8_WAIT_L(8); PG8_BAR; PG8_WAIT_L(0); PG8_MMA(0, 0, At, B0); PG8_BAR; PG8_SCHED;
            PG8_LDB(B1, 1, 1); PG8_STAGE(PG8_SB(1, 0), b3, voffB);
            PG8_BAR; PG8_WAIT_L(0); PG8_MMA(0, 1, At, B1); PG8_BAR;
            PG8_LDA(At, 1, 1); PG8_STAGE_A(PG8_SA(1, 0), kb3, v2, 0);
            PG8_BAR; PG8_WAIT_L(0); PG8_MMA(1, 0, At, B0); PG8_BAR; PG8_SCHED;
            PG8_STAGE(PG8_SB(1, 1), b3 + hstep, voffB);
            PG8_WAIT_V(6); PG8_BAR; PG8_MMA(1, 1, At, B1); PG8_BAR;
        }
        PG8_STAMP();
        if constexpr (!Epi::AFTER_DRAIN) { E(acc, cur, wr, wc, fr, fq); S.done(cur); }
        PG8_STAMP();
        if (!has_next) break;
#pragma unroll
        for (int a = 0; a < 2; ++a)
#pragma unroll
            for (int b = 0; b < 2; ++b)
#pragma unroll
                for (int m = 0; m < 4; ++m)
#pragma unroll
                    for (int n = 0; n < 2; ++n) acc[a][b][m][n] = (f32x4){0.f, 0.f, 0.f, 0.f};
        cur = nxt; cB = nB; ++ui;
#pragma unroll
        for (int _h = 0; _h < 2; ++_h)
#pragma unroll
            for (int _i = 0; _i < 2; ++_i) voffC[_h][_i] = voffN[_h][_i];
    }
    PG8_WAIT_V(0);
    if (wr == 0) PG8_BAR;
    PG8_BAR;
    if constexpr (Epi::AFTER_DRAIN) { E.fused(acc, cur, wr, wc, fr, fq, lds, wid, lane); S.done(cur); }
    PG8_STAMP();
    if (STAMP && wid == 0) { stamps[lane] = lane < nts ? (((unsigned long long)(unsigned)ts_hi << 32) | (unsigned)ts_lo) : 0ull;
        if (lane == 62) stamps[62] = rt_entry; if (lane == 63) stamps[63] = (unsigned long long)wall_clock64(); }
#undef PG8_STAMP
#undef PG8_SA
#undef PG8_SB
#undef PG8_STAGE
#undef PG8_STAGE_A
#undef PG8_GOFF
#undef PG8_LDA
#undef PG8_LDB
#undef PG8_MMA
#undef PG8_WAIT_V
#undef PG8_WAIT_L
#undef PG8_BAR
#undef PG8_SCHED
}
}

struct Pg8SchedMoe2 {
    __device__ bool next(int i, pg8::Unit& u) const {
        int tm, nt; if (!tile_map(i, 384, 4, 8, 4, tm, nt)) return false;
        const int e = (tm < 256) ? (tm >> 4) : ((tm - 256) >> 3);
        u.pm = tm; u.pn = e * 4 + nt; return true;
    }
    __device__ __forceinline__ void a_ready(const pg8::Unit&) const {}
    __device__ __forceinline__ void done(const pg8::Unit&) const {}
};
struct Pg8EpiMoe2 {
    static constexpr bool PERM = false, AFTER_DRAIN = false;
    const float* gate; bf16_t* Y;
    __device__ __forceinline__ void operator()(const pg8::f32x4 (&acc)[2][2][4][2], const pg8::Unit& u, int wr, int wc, int fr, int fq) const {
        const int row0 = u.pm * 256 + wr * 64 + fr, col0 = (u.pn & 3) * 256 + wc * 32 + 4 * fq;
#pragma unroll
        for (int ai = 0; ai < 2; ++ai)
#pragma unroll
            for (int m = 0; m < 4; ++m) {
                const int row = row0 + ai * 128 + m * 16;
                const float gt = gate[row];
                bf16_t* rowp = Y + (size_t)row * 1024 + col0;
#pragma unroll
                for (int bj = 0; bj < 2; ++bj)
#pragma unroll
                    for (int n = 0; n < 2; ++n) {
                        const pg8::f32x4 v = acc[ai][bj][m][n];
                        *(uint2*)(rowp + bj * 128 + n * 16) = make_uint2(pk_bf16(v[0] * gt, v[1] * gt), pk_bf16(v[2] * gt, v[3] * gt));
                    }
            }
    }
};

struct Pg8Sched {
    int MT, NTN, MS, NS, wid, nw;
    __device__ bool next(int i, pg8::Unit& u) const {
        if (nw == 256 && gridDim.x == 256) return tile_map(i, MT, NTN, MS, NS, u.pm, u.pn);
        if (wid < 0) return false;
        const int t = wid + i * nw; if (t >= MT * NTN) return false;
        u.pm = t / NTN; u.pn = t % NTN; return true;
    }
    __device__ __forceinline__ void a_ready(const pg8::Unit&) const {}
    __device__ __forceinline__ void done(const pg8::Unit&) const {}
};
struct Pg8EpiResid {
    static constexpr bool PERM = false, AFTER_DRAIN = false;
    const float* res; float* dst;
    __device__ __forceinline__ void operator()(const pg8::f32x4 (&acc)[2][2][4][2], const pg8::Unit& u, int wr, int wc, int fr, int fq) const {
        const int row0 = u.pm * 256 + wr * 64 + fr, col0 = u.pn * 256 + wc * 32 + 4 * fq;
#pragma unroll
        for (int ai = 0; ai < 2; ++ai)
#pragma unroll
            for (int mp = 0; mp < 2; ++mp) {
                float4 x[2][2][2];
#pragma unroll
                for (int mm = 0; mm < 2; ++mm)
#pragma unroll
                    for (int bj = 0; bj < 2; ++bj)
#pragma unroll
                        for (int n = 0; n < 2; ++n)
                            x[mm][bj][n] = *(const float4*)(res + (size_t)(row0 + ai * 128 + (mp * 2 + mm) * 16) * 1024 + col0 + bj * 128 + n * 16);
#pragma unroll
                for (int mm = 0; mm < 2; ++mm)
#pragma unroll
                    for (int bj = 0; bj < 2; ++bj)
#pragma unroll
                        for (int n = 0; n < 2; ++n) {
                            const pg8::f32x4 v = acc[ai][bj][mp * 2 + mm][n];
                            const float4 xx = x[mm][bj][n];
                            *(float4*)(dst + (size_t)(row0 + ai * 128 + (mp * 2 + mm) * 16) * 1024 + col0 + bj * 128 + n * 16) =
                                make_float4(ALPHA * xx.x + v[0], ALPHA * xx.y + v[1], ALPHA * xx.z + v[2], ALPHA * xx.w + v[3]);
                        }
            }
    }
};
struct Pg8EpiQK {
    static constexpr bool PERM = false, AFTER_DRAIN = false;
    char* ws;
    __device__ __forceinline__ void operator()(const pg8::f32x4 (&acc)[2][2][4][2], const pg8::Unit& u, int wr, int wc, int fr, int fq) const {
        const int n0 = u.pn * 256;
        bf16_t* dstb = (bf16_t*)(ws + ((n0 >> 10) ? N_K : N_Q));
        const int row0 = u.pm * 256 + wr * 64 + fr;
#pragma unroll
        for (int ai = 0; ai < 2; ++ai)
#pragma unroll
            for (int m = 0; m < 4; ++m) {
                const int tok = row0 + ai * 128 + m * 16;
#pragma unroll
                for (int bj = 0; bj < 2; ++bj) {
                    const int hh = ((n0 & 1023) + bj * 128 + wc * 32) >> 5;
#pragma unroll
                    for (int n = 0; n < 2; ++n) {
                        const pg8::f32x4 v = acc[ai][bj][m][n];
                        *(uint2*)(dstb + ((size_t)hh * T_ALL + tok) * 32 + n * 16 + 4 * fq) = make_uint2(pk_bf16(v[0], v[1]), pk_bf16(v[2], v[3]));
                    }
                }
            }
    }
};
struct Pg8EpiRows {
    static constexpr bool PERM = false, AFTER_DRAIN = false;
    bf16_t* O; size_t ldc;
    __device__ __forceinline__ void operator()(const pg8::f32x4 (&acc)[2][2][4][2], const pg8::Unit& u, int wr, int wc, int fr, int fq) const {
        const int row0 = u.pm * 256 + wr * 64 + fr, col0 = u.pn * 256 + wc * 32 + 4 * fq;
#pragma unroll
        for (int ai = 0; ai < 2; ++ai)
#pragma unroll
            for (int m = 0; m < 4; ++m) {
                bf16_t* rowp = O + (size_t)(row0 + ai * 128 + m * 16) * ldc + col0;
#pragma unroll
                for (int bj = 0; bj < 2; ++bj)
#pragma unroll
                    for (int n = 0; n < 2; ++n) {
                        const pg8::f32x4 v = acc[ai][bj][m][n];
                        *(uint2*)(rowp + bj * 128 + n * 16) = make_uint2(pk_bf16(v[0], v[1]), pk_bf16(v[2], v[3]));
                    }
            }
    }
};

struct Pg8EpiQKrot {
    static constexpr bool PERM = false, AFTER_DRAIN = false;
    char* ws; int smask;
    __device__ __forceinline__ void operator()(const pg8::f32x4 (&acc)[2][2][4][2], const pg8::Unit& u, int wr, int wc, int fr, int fq) const {
        const int n0 = u.pn * 256;
        const bool isk = (n0 >> 10) != 0;
        bf16_t* nat = (bf16_t*)(ws + (isk ? R_K : R_Q));
        bf16_t* Ktb = (bf16_t*)(ws + R_KT);
        const float2* rot = (const float2*)(ws + R_ROT);
        const int row0 = u.pm * 256 + wr * 64 + fr;
#pragma unroll
        for (int ai = 0; ai < 2; ++ai)
#pragma unroll
            for (int m = 0; m < 4; ++m) {
                const int tok = row0 + ai * 128 + m * 16;
                const float2* rr = rot + (size_t)(tok & smask) * 128;
#pragma unroll
                for (int bj = 0; bj < 2; ++bj) {
                    const int cb = (n0 & 1023) + bj * 128 + wc * 32;
                    const int ib = ((cb & 255) >> 5) * 16 + 4 * fq;
                    const float4 cs01 = *(const float4*)(rr + ib), cs23 = *(const float4*)(rr + ib + 2);
                    const pg8::f32x4 x1 = acc[ai][bj][m][0], x2 = acc[ai][bj][m][1];
                    const float o10 = x1[0] * cs01.x - x2[0] * cs01.y, o20 = x1[0] * cs01.y + x2[0] * cs01.x;
                    const float o11 = x1[1] * cs01.z - x2[1] * cs01.w, o21 = x1[1] * cs01.w + x2[1] * cs01.z;
                    const float o12 = x1[2] * cs23.x - x2[2] * cs23.y, o22 = x1[2] * cs23.y + x2[2] * cs23.x;
                    const float o13 = x1[3] * cs23.z - x2[3] * cs23.w, o23 = x1[3] * cs23.w + x2[3] * cs23.z;
                    const unsigned p10 = pk_bf16(o10, o11), p11 = pk_bf16(o12, o13), p20 = pk_bf16(o20, o21), p21 = pk_bf16(o22, o23);
                    bf16_t* dst = nat + (size_t)tok * 1024 + cb + 4 * fq;
                    *(uint2*)dst = make_uint2(p10, p11);
                    *(uint2*)(dst + 16) = make_uint2(p20, p21);
                    if (isk) {
                        bf16_t* kt = Ktb + ((size_t)(tok >> 7) * 1024 + cb + 4 * fq) * 128 + (tok & 127);
                        kt[0 * 128] = (bf16_t)(p10 & 0xffffu); kt[1 * 128] = (bf16_t)(p10 >> 16); kt[2 * 128] = (bf16_t)(p11 & 0xffffu); kt[3 * 128] = (bf16_t)(p11 >> 16);
                        kt[16 * 128] = (bf16_t)(p20 & 0xffffu); kt[17 * 128] = (bf16_t)(p20 >> 16); kt[18 * 128] = (bf16_t)(p21 & 0xffffu); kt[19 * 128] = (bf16_t)(p21 >> 16);
                    }
                }
            }
    }
};
struct Pg8EpiVtBlk {
    static constexpr bool PERM = false, AFTER_DRAIN = false;
    bf16_t* Vt;
    __device__ __forceinline__ void operator()(const pg8::f32x4 (&acc)[2][2][4][2], const pg8::Unit& u, int wr, int wc, int fr, int fq) const {
        const int row0 = u.pm * 256 + wr * 64 + fr, col0 = u.pn * 256 + wc * 32 + 4 * fq;
#pragma unroll
        for (int ai = 0; ai < 2; ++ai)
#pragma unroll
            for (int m = 0; m < 4; ++m) {
                const int row = row0 + ai * 128 + m * 16;
#pragma unroll
                for (int bj = 0; bj < 2; ++bj)
#pragma unroll
                    for (int n = 0; n < 2; ++n) {
                        const int tok0 = col0 + bj * 128 + n * 16;
                        const pg8::f32x4 v = acc[ai][bj][m][n];
                        *(uint2*)(Vt + ((size_t)(tok0 >> 7) * 2048 + row) * 128 + (tok0 & 127)) = make_uint2(pk_bf16(v[0], v[1]), pk_bf16(v[2], v[3]));
                    }
            }
    }
};

struct Pg8SchedMoe1 {
    __device__ bool next(int i, pg8::Unit& u) const {
        int tm, nt;
        if (gridDim.x == 256) { if (!tile_map(i, 384, 8, 4, 8, tm, nt)) return false; }
        else { const int t = blockIdx.x + i * gridDim.x; if (t >= 384 * 8) return false; tm = t >> 3; nt = t & 7; }
        const int e = (tm < 256) ? (tm >> 4) : ((tm - 256) >> 3);
        u.pm = tm; u.pn = e * 8 + nt; return true;
    }
    __device__ __forceinline__ void a_ready(const pg8::Unit&) const {}
    __device__ __forceinline__ void done(const pg8::Unit&) const {}
};
struct Pg8EpiMoe1 {
    static constexpr bool PERM = false, AFTER_DRAIN = false;
    bf16_t* H;
    __device__ __forceinline__ void operator()(const pg8::f32x4 (&acc)[2][2][4][2], const pg8::Unit& u, int wr, int wc, int fr, int fq) const {
        const int row0 = u.pm * 256 + wr * 64 + fr, f0 = (u.pn & 7) * 128 + wc * 16 + 4 * fq;
#pragma unroll
        for (int ai = 0; ai < 2; ++ai)
#pragma unroll
            for (int m = 0; m < 4; ++m) {
                bf16_t* rowp = H + (size_t)(row0 + ai * 128 + m * 16) * 1024 + f0;
#pragma unroll
                for (int bj = 0; bj < 2; ++bj) {
                    const pg8::f32x4 gt = acc[ai][bj][m][0], up = acc[ai][bj][m][1];
                    *(uint2*)(rowp + bj * 64) = make_uint2(pk_bf16(silu_f(gt[0]) * up[0], silu_f(gt[1]) * up[1]), pk_bf16(silu_f(gt[2]) * up[2], silu_f(gt[3]) * up[3]));
                }
            }
    }
};

__device__ __forceinline__ void g5_tiles(const Params& p, int th, char* smem, const int TID, int wid, int nw) {
    char* ws = p.ws;
    const float* xin = (th < 2) ? (p.x_prompt + (size_t)th * T3 * 1024) : p.x_sample;
    pg8::Gemm g; g.A = (const bf16_t*)(ws + R_O); g.Bt = (const bf16_t*)(ws + R_WOUT); g.M = T3; g.N = 1024; g.K = 2048;
    Pg8Sched S; S.MT = 64; S.NTN = 4; S.MS = 8; S.NS = 4; S.wid = wid; S.nw = nw;
    Pg8EpiResid E; E.res = xin; E.dst = p.out + (size_t)th * T3 * 1024;
    pg8::gemm_phase<Pg8EpiResid, Pg8Sched, false>((LAS3 unsigned char*)smem, g, S, E, nullptr, TID);
}

#ifndef ONLY
#define EN(k) 1
#else
#define EN(k) (ONLY == (k))
#endif
__device__ void run_phase(const Params& p, int ph, char* smem, const int TID) {
    const int bid = blockIdx.x, G = gridDim.x;
    char* ws = p.ws;
    if (EN(0) && ph == PH_PRE) {
        int rot = 0;
        convert_matrix(p.ret_w_in, nullptr, 6144, (bf16_t*)(ws + R_WIN), 6144, 1024, 1, smem, rot, TID, bid, G);
        convert_matrix(p.ret_w_out, nullptr, 1024, (bf16_t*)(ws + R_WOUT), 1024, 2048, 0, smem, rot, TID, bid, G);
        for (int th = 0; th < 3; ++th) {
            const float* xs = (th < 2) ? (p.x_prompt + (size_t)th * T3 * 1024) : p.x_sample;
            bf16_t* xd = (bf16_t*)(p.out + (size_t)th * T3 * 1024);
            for (size_t i = (size_t)bid * NT + TID; i < (size_t)T3 * 1024 / 8; i += (size_t)G * NT) {
                const float4 a = ((const float4*)xs)[2 * i], b = ((const float4*)xs)[2 * i + 1];
                ((uint4*)xd)[i] = make_uint4(pk_bf16(a.x, a.y), pk_bf16(a.z, a.w), pk_bf16(b.x, b.y), pk_bf16(b.z, b.w));
            }
        }
#ifdef PROBE_NULLGEMM
        {
            __syncthreads();
            const unsigned long long t0 = wall_clock64();
            PolNull pn; pn.sink = (float*)(ws + R_O);
            gemm_core<PolNull, C256, true>(pn, smem, 1024, TID);
            __syncthreads();
            const unsigned long long t1 = wall_clock64();
            if (bid == 0 && TID == 0) *(unsigned long long*)(ws + R_O + 64) = t1 - t0;
        }
#endif
#ifdef PROBE_SCANTEST
        for (int var = 0; var < 2; ++var) {
            __syncthreads();
            const unsigned long long t0 = wall_clock64();
            if (bid < 64) {
                const int dkt = bid & 1, dvt = (bid >> 1) & 3, dir = (bid >> 3) & 1, h = (bid >> 4) & 3;
                if (var == 0) {
                    PolUscanT<false, true> pol;
                    pol.A = (const bf16_t*)(ws + R_VT) + ((size_t)h * 512 + dvt * 128) * 128; pol.B = (const bf16_t*)(ws + R_KT) + ((size_t)h * 256 + dkt * 128) * 128;
                    pol.UR = (bf16_t*)(ws + R_UR) + (size_t)dir * (128ull * 4 * 512 * 256) + (size_t)h * (512 * 256) + (size_t)(dvt * 128) * 256 + dkt * 128;
                    pol.nc = 128; pol.dir = dir; pol.lg = -0.01f; pol.dec = 0.5f; pol.st = 1.001f; pol.st2 = 1.002f;
                    gemm_core<PolUscanT<false, true>, C128, false>(pol, smem, 256, TID);
                } else {
                    PolUscanT<true, false> pol;
                    pol.A = (const bf16_t*)(ws + R_VT) + ((size_t)h * 512 + dvt * 128) * 128; pol.B = (const bf16_t*)(ws + R_KT) + ((size_t)h * 256 + dkt * 128) * 128;
                    pol.UR = (bf16_t*)(ws + R_UR) + (size_t)dir * (128ull * 4 * 512 * 256) + (size_t)h * (512 * 256) + (size_t)(dvt * 128) * 256 + dkt * 128;
                    pol.nc = 128; pol.dir = dir; pol.lg = -0.01f; pol.dec = 0.5f; pol.st = 1.001f; pol.st2 = 1.002f;
                    gemm_core<PolUscanT<true, false>, C128, false>(pol, smem, 256, TID);
                }
            }
            __syncthreads();
            const unsigned long long t1 = wall_clock64();
            if (bid == 0 && TID == 0) ((unsigned long long*)(ws + R_END - 64))[var] = (var ? 4 : 1) * (t1 - t0);
        }
#endif
#ifdef PROBE_LOADTEST
        for (int var = 0; var < 2; ++var) {
            __syncthreads();
            const unsigned long long t0 = wall_clock64();
            const int lda = var ? 1024 : 1088;
            for (int k = 0, tm, nt; tile_map(k, 384, 4, 8, 4, tm, nt); ++k) {
                PolLoadTest pol; pol.lda = lda; pol.sink = (float*)(ws + M_AFF);
                pol.A = (const bf16_t*)(ws + M_H) + (size_t)(tm * 256) * lda;
                pol.B = (const bf16_t*)(ws + M_WGU) + (size_t)((tm >> 4) * 1024 + nt * 256) * lda;
                gemm_core<PolLoadTest, C256, true, 1, true>(pol, smem, 16, TID);
            }
            __syncthreads();
            const unsigned long long t1 = wall_clock64();
            if (bid == 0 && TID == 0) ((unsigned long long*)(ws + M_AFF + 1024))[var] = t1 - t0;
        }
#endif
        float2* rt = (float2*)(ws + R_ROT);
        for (int i = bid * NT + TID; i < 16384 * 128; i += G * NT) {
            const int s = i >> 7, fi = i & 127;
            const float inv = exp2f(-(float)fi * (13.287712379549449f / 128.0f));
            const float ang = (float)s * inv;
            const double rev = (double)ang * 0.15915494309189535;
            const float fr = (float)(rev - (double)(long long)(rev + 0.5));
            rt[i] = make_float2(__builtin_amdgcn_cosf(fr), __builtin_amdgcn_sinf(fr));
        }
        return;
    }
    if (ph >= PH_R0 && ph < PH_R0 + 15) {
        const int th = (ph - PH_R0) / 5, sub = (ph - PH_R0) % 5;
        const int nseq = (th < 2) ? 8 : 1, nc = (th < 2) ? 16 : 128, smask = (th < 2) ? 2047 : 16383;
        const float* xin = (th < 2) ? (p.x_prompt + (size_t)th * T3 * 1024) : p.x_sample;
        if (EN(1) && sub == 0) {
            const bf16_t* xbt = (const bf16_t*)(p.out + (size_t)th * T3 * 1024);
            const bf16_t* Wt = (const bf16_t*)(ws + R_WIN);
            {
                pg8::Gemm g; g.A = xbt; g.Bt = Wt; g.M = T3; g.N = 2048; g.K = 1024;
                Pg8Sched S; S.MT = 64; S.NTN = 8; S.MS = 4; S.NS = 8; S.wid = bid; S.nw = G;
                Pg8EpiQKrot E; E.ws = ws; E.smask = smask;
                pg8::gemm_phase<Pg8EpiQKrot, Pg8Sched, false>((LAS3 unsigned char*)smem, g, S, E, nullptr, TID);
            }
            {
                pg8::Gemm g; g.A = Wt + (size_t)2048 * 1024; g.Bt = xbt; g.M = 2048; g.N = T3; g.K = 1024;
                Pg8Sched S; S.MT = 8; S.NTN = 64; S.MS = 4; S.NS = 8; S.wid = bid; S.nw = G;
                Pg8EpiVtBlk E; E.Vt = (bf16_t*)(ws + R_VT);
                pg8::gemm_phase<Pg8EpiVtBlk, Pg8Sched, false>((LAS3 unsigned char*)smem, g, S, E, nullptr, TID);
            }
            {
                pg8::Gemm g; g.A = xbt; g.Bt = Wt + (size_t)4096 * 1024; g.M = T3; g.N = 2048; g.K = 1024;
                Pg8Sched S; S.MT = 64; S.NTN = 8; S.MS = 4; S.NS = 8; S.wid = bid; S.nw = G;
                Pg8EpiRows E; E.O = (bf16_t*)(ws + R_G); E.ldc = 2048;
                pg8::gemm_phase<Pg8EpiRows, Pg8Sched, false>((LAS3 unsigned char*)smem, g, S, E, nullptr, TID);
            }
            if (th == 1 && G == 256 && EN(5)) g5_tiles(p, 0, smem, TID, bid, G);
        } else if (EN(2) && sub == 1) {
            const int nscan = nseq * 4 * 2 * 8;
            const int nscore = NCH3 * 4;
            const int ncr = nc / 2;
            if (th == 2 && G == 256 && EN(5)) g5_tiles(p, 1, smem, TID, bid - 64, 192);
            for (int t = bid; t < nscan + nscore; ) {
                if (t < nscan) {
                    int u = t;
                    if (G == 256) {
                        const int k = t >> 8, b = t & 255, x = b & 7, sl = b >> 3;
                        if (nscan >= 256) u = ((k * 32 + x * 4 + (sl >> 3)) << 3) | (sl & 7);
                        else u = (x << 3) | sl;
                    }
                    const int dkt = u & 1; u >>= 1; const int dvt = u & 3; u >>= 2; const int dir = u & 1; u >>= 1; const int h = u & 3; u >>= 2; const int seq = u;
                    PolUscan pol;
                    pol.A = (const bf16_t*)(ws + R_VT) + ((size_t)(seq * nc) * 2048 + h * 512 + dvt * 128) * 128;
                    pol.B = (const bf16_t*)(ws + R_KT) + ((size_t)(seq * nc) * 1024 + h * 256 + dkt * 128) * 128;
                    pol.UR = (bf16_t*)(ws + R_UR) + (size_t)dir * ((size_t)NCH3 * 4 * 512 * 256) + (size_t)(seq * ncr) * (4ull * 512 * 256) + (size_t)h * (512 * 256) + (size_t)(dvt * 128) * 256 + dkt * 128;
                    pol.nc = ncr; pol.dir = dir;
                    pol.lg = log2_sigmoid(p.ret_decay[dir * 4 + h]);
                    pol.dec = exp2f(pol.lg * (float)RC);
                    pol.st = exp2f(dir ? pol.lg : -pol.lg); pol.st2 = pol.st * pol.st;
                    gemm_core<PolUscan, C128, false>(pol, smem, ncr * 4, TID);
                } else {
                    const int u = t - nscan; const int h = u & 3, cgi = u >> 2;
                    PolScore pol;
                    pol.A = (const bf16_t*)(ws + R_Q) + (size_t)(cgi * RC) * 1024 + h * 256;
                    pol.B = (const bf16_t*)(ws + R_K) + (size_t)(cgi * RC) * 1024 + h * 256;
                    pol.P = (bf16_t*)(ws + R_P) + (size_t)((cgi * 4 + h) * RC) * RC;
                    pol.lgf = log2_sigmoid(p.ret_decay[h]); pol.lgb = log2_sigmoid(p.ret_decay[4 + h]); pol.smem = smem;
                    gemm_core<PolScore, C256, false, 1>(pol, smem, 4, TID);
                }
                if (th == 2 && G == 256) t = (t == bid && bid >= 64 && bid < 128) ? bid + 192 : nscan + nscore;
                else t += G;
            }
        } else if (EN(3) && sub == 2) {
            for (int t = bid; t < NCH3 * 2 * 4 * 2; t += G) {
                int u = t;
                if (G == 256) { const int k = t >> 8, b = t & 255, x = b & 7, sl = b >> 3; u = ((k * 64 + x * 8 + (sl >> 2)) << 2) | (sl & 3); }
                const int dvt = u & 1, half = (u >> 1) & 1, h = (u >> 2) & 3, cgi = u >> 4;
                PolO pol;
                pol.half = half;
                pol.Pp = (const bf16_t*)(ws + R_P) + (size_t)((cgi * 4 + h) * RC + half * 128) * RC;
                pol.Qp = (const bf16_t*)(ws + R_Q) + (size_t)(cgi * RC + half * 128) * 1024 + h * 256;
                pol.Vp = (const bf16_t*)(ws + R_VT) + ((size_t)(cgi * 2) * 2048 + h * 512 + dvt * 256) * 128;
                const size_t ro = (size_t)cgi * (4ull * 512 * 256) + (size_t)h * (512 * 256) + (size_t)(dvt * 256) * 256;
                pol.Rf = (const bf16_t*)(ws + R_UR) + ro;
                pol.Rb = (const bf16_t*)(ws + R_UR) + (size_t)NCH3 * 4 * 512 * 256 + ro;
                pol.O = (bf16_t*)(ws + R_O) + (size_t)(cgi * RC + half * 128) * 2048 + h * 512 + dvt * 256;
                pol.lgf = log2_sigmoid(p.ret_decay[h]); pol.lgb = log2_sigmoid(p.ret_decay[4 + h]);
                gemm_core<PolO, CO, false>(pol, smem, 12, TID);
            }
        } else if (EN(4) && sub == 3) {
            const int lane = TID & 63, w = TID >> 6;
            bf16_t* O = (bf16_t*)(ws + R_O); const bf16_t* Gb = (const bf16_t*)(ws + R_G);
            int it = bid * 8 + w;
            uint4 nov = make_uint4(0, 0, 0, 0), ngv = nov;
            if (it < T3 * 4) { nov = *(const uint4*)(O + (size_t)it * 512 + lane * 8); ngv = *(const uint4*)(Gb + (size_t)it * 512 + lane * 8); }
            for (; it < T3 * 4; it += G * 8) {
                const size_t off = (size_t)it * 512 + lane * 8;
                const uint4 ov = nov, gv = ngv;
                if (it + G * 8 < T3 * 4) { nov = *(const uint4*)(O + off + (size_t)G * 8 * 512); ngv = *(const uint4*)(Gb + off + (size_t)G * 8 * 512); }
                float y[8] = {bf_lo(ov.x), bf_hi(ov.x), bf_lo(ov.y), bf_hi(ov.y), bf_lo(ov.z), bf_hi(ov.z), bf_lo(ov.w), bf_hi(ov.w)};
                const float g[8] = {bf_lo(gv.x), bf_hi(gv.x), bf_lo(gv.y), bf_hi(gv.y), bf_lo(gv.z), bf_hi(gv.z), bf_lo(gv.w), bf_hi(gv.w)};
                float s = 0.f;
#pragma unroll
                for (int e = 0; e < 8; ++e) s += y[e];
                const float mu = wave_sum(s) * (1.f / 512.f);
                float q = 0.f;
#pragma unroll
                for (int e = 0; e < 8; ++e) { y[e] -= mu; q += y[e] * y[e]; }
                const float rstd = rsqrtf(wave_sum(q) * (1.f / 512.f) + GN_EPS);
#pragma unroll
                for (int e = 0; e < 8; ++e) y[e] = y[e] * rstd * silu_f(g[e]);
                *(uint4*)(O + off) = make_uint4(pk_bf16(y[0], y[1]), pk_bf16(y[2], y[3]), pk_bf16(y[4], y[5]), pk_bf16(y[6], y[7]));
            }
        } else if (EN(5) && sub == 4) {
            if (th == 2 || G != 256) g5_tiles(p, th, smem, TID, bid, G);
        }
        return;
    }
    if (EN(6) && (ph == PH_LN0A || ph == PH_LN1A)) {
        const int L = (ph == PH_LN1A);
        ln_phase<0, true, true>(p, p.ln_mix_g + L * 1024, p.ln_mix_b + L * 1024, p.w_router + (size_t)L * 1024 * 16, M_XB, smem, TID);
        return;
    }
    if (EN(7) && (ph == PH_TOPK0 || ph == PH_TOPK1)) {
        const int L = (ph == PH_TOPK1);
        topk_phase(p, smem, TID);
        const int wid = (G > 64) ? bid - 32 : bid, nw = (G > 64) ? G - 32 : G;
        int rot = 0;
        for (int e = 0; e < 16; ++e) {
            const size_t wo = ((size_t)L * 16 + e) * 1024 * 1024;
            convert_matrix(p.w_gate + wo, p.w_up + wo, 1024, (bf16_t*)(ws + M_WGU) + (size_t)e * 2048 * 1024, 2048, 1024, 2, smem, rot, TID, wid, nw);
            convert_matrix(p.w_down + wo, nullptr, 1024, (bf16_t*)(ws + M_WD) + (size_t)e * 1024 * 1024, 1024, 1024, 0, smem, rot, TID, wid, nw);
        }
        if (!L) {
            convert_matrix(p.na_w_in, nullptr, 3072, (bf16_t*)(ws + M_NWIN), 3072, 1024, 3, smem, rot, TID, wid, nw);
            convert_matrix(p.na_w_out, nullptr, 1024, (bf16_t*)(ws + M_NWOUT), 1024, 1024, 0, smem, rot, TID, wid, nw);
        }
        return;
    }
    if (EN(8) && (ph == PH_MOE1_0 || ph == PH_MOE1_1)) {
        pg8::Gemm g; g.A = (const bf16_t*)(ws + M_XB); g.Bt = (const bf16_t*)(ws + M_WGU); g.M = 2 * T_ALL; g.N = 16 * 2048; g.K = 1024;
        Pg8SchedMoe1 S; Pg8EpiMoe1 E; E.H = (bf16_t*)(ws + M_H);
        pg8::gemm_phase_gather<Pg8EpiMoe1, Pg8SchedMoe1, false>((LAS3 unsigned char*)smem, g, S, E, nullptr, TID, (const int*)(ws + M_IDX), 16 * CAP_P, T_PROMPT);
        return;
    }
    if (EN(9) && (ph == PH_MOE2_0 || ph == PH_MOE2_1)) {
        if (G == 256) {
            pg8::Gemm g; g.A = (const bf16_t*)(ws + M_H); g.Bt = (const bf16_t*)(ws + M_WD); g.M = 2 * T_ALL; g.N = 16 * 1024; g.K = 1024;
            Pg8SchedMoe2 S; Pg8EpiMoe2 E; E.gate = (const float*)(ws + M_GATE); E.Y = (bf16_t*)(ws + M_YE);
            pg8::gemm_phase<Pg8EpiMoe2, Pg8SchedMoe2, false>((LAS3 unsigned char*)smem, g, S, E, nullptr, TID);
            return;
        }
        for (int k = 0, tm, nt; tile_map(k, 384, 4, 8, 4, tm, nt); ++k) {
            int trunk, e, mt;
            if (tm < 256) { trunk = 0; mt = tm & 15; e = tm >> 4; }
            else { const int u = tm - 256; trunk = 1; mt = u & 7; e = u >> 3; }
            const int cap = trunk ? CAP_S : CAP_P;
            const size_t rb = (trunk ? (size_t)16 * CAP_P : 0) + (size_t)e * cap + mt * 256;
            PolMoe2 pol;
            pol.A = (const bf16_t*)(ws + M_H) + rb * 1024;
            pol.B = (const bf16_t*)(ws + M_WD) + ((size_t)e * 1024 + nt * 256) * 1024;
            pol.gate = (const float*)(ws + M_GATE) + rb;
            pol.Y = (bf16_t*)(ws + M_YE) + rb * 1024 + nt * 256;
            gemm_core_dma<PolMoe2, C256, false>(pol, smem, 16, TID);
        }
        return;
    }
    if (EN(10) && ph == PH_LN0B) { ln_phase<1, true, false>(p, p.ln_ffn_g, p.ln_ffn_b, nullptr, M_XB2, smem, TID); return; }
    if (EN(10) && ph == PH_LN1B) { ln_phase<1, false, false>(p, p.ln_ffn_g + 1024, p.ln_ffn_b + 1024, nullptr, M_XB2, smem, TID); return; }
    if (EN(11) && ph == PH_QKV) {
        {
            pg8::Gemm g; g.A = (const bf16_t*)(ws + M_XB2); g.Bt = (const bf16_t*)(ws + M_NWIN); g.M = T_ALL; g.N = 2048; g.K = 1024;
            Pg8Sched S; S.MT = 192; S.NTN = 8; S.MS = 4; S.NS = 8; S.wid = bid; S.nw = G;
            Pg8EpiQK E; E.ws = ws;
            pg8::gemm_phase<Pg8EpiQK, Pg8Sched, false>((LAS3 unsigned char*)smem, g, S, E, nullptr, TID);
        }
        {
            pg8::Gemm g; g.A = (const bf16_t*)(ws + M_NWIN) + (size_t)2048 * 1024; g.Bt = (const bf16_t*)(ws + M_XB2); g.M = 1024; g.N = T_ALL; g.K = 1024;
            Pg8Sched S; S.MT = 4; S.NTN = 192; S.MS = 4; S.NS = 8; S.wid = bid; S.nw = G;
            Pg8EpiRows E; E.O = (bf16_t*)(ws + N_VT); E.ldc = T_ALL;
            pg8::gemm_phase<Pg8EpiRows, Pg8Sched, false>((LAS3 unsigned char*)smem, g, S, E, nullptr, TID);
        }
        return;
    }
    if (EN(12) && ph == PH_NA) { na_phase(p, smem, TID); return; }
    if (EN(13) && ph == PH_NAOUT) {
        pg8::Gemm g; g.A = (const bf16_t*)(ws + M_XB2); g.Bt = (const bf16_t*)(ws + M_NWOUT); g.M = T_ALL; g.N = 1024; g.K = 1024;
        Pg8Sched S; S.MT = 192; S.NTN = 4; S.MS = 8; S.NS = 4; S.wid = bid; S.nw = G;
        Pg8EpiResid E; E.res = p.out; E.dst = p.out;
        pg8::gemm_phase<Pg8EpiResid, Pg8Sched, false>((LAS3 unsigned char*)smem, g, S, E, nullptr, TID);
        return;
    }
}

__device__ __forceinline__ int lane_id_opaque() {
    int l;
    asm volatile("v_mbcnt_lo_u32_b32 %0, -1, 0\n\tv_mbcnt_hi_u32_b32 %0, -1, %0" : "=v"(l));
    return l;
}

__global__ void __launch_bounds__(512, 2) fwd_megakernel(Params p) {
    extern __shared__ __attribute__((aligned(16))) char smem_dyn[];
    char* smem = smem_dyn;
    cg::grid_group grid = cg::this_grid();
    const int wave_id = __builtin_amdgcn_readfirstlane((int)(threadIdx.x >> 6));
#define MK_TID() ((wave_id << 6) | lane_id_opaque())
    if (MK_TID() == 0) *(uint4*)(smem_dyn + 131072) = make_uint4(0u, 0u, 0u, 0u);
    __syncthreads();
    (void)xcd_barrier_post((unsigned*)(p.ws + BAR_OFF), (volatile LAS3 unsigned*)(smem_dyn + 131072), MK_TID());
#ifdef PROBE_MASK
    unsigned long long t_prev = wall_clock64(), t_acc = 0, t_accb = 0, t_null = 0, t_sync = 0, t_syncb = 0;
#endif
    for (int ph = p.ph_lo; ph < p.ph_hi; ++ph) {
        Params q = p;
        {
            size_t z = 0;
            asm volatile("" : "+s"(z));
            q.ws = p.ws + z; q.out = p.out + z; q.x_prompt = p.x_prompt + z; q.x_sample = p.x_sample + z; q.ret_decay = p.ret_decay + z;
            q.w_gate = p.w_gate + z; q.w_up = p.w_up + z; q.w_down = p.w_down + z;
        }
        int phv = ph;
        asm volatile("" : "+s"(phv));
        int tidv = MK_TID();
        asm volatile("" : "+v"(tidv));
        const bool empty_ph = (gridDim.x == 256) && (ph == PH_R0 + 4 || ph == PH_R0 + 9);
        if (empty_ph) continue;
        run_phase(q, phv, smem, tidv);
#ifdef PROBE_MASK
        const unsigned long long t_s0 = wall_clock64();
#endif
        if (ph + 1 < p.ph_hi) { if (ph == p.ph_lo) grid.sync(); else { XcdBarrier xb; xb.bar = (unsigned*)(p.ws + BAR_OFF); xb.x = xb_xcc_id(); xb.st = (volatile LAS3 unsigned*)(smem_dyn + 131072); xcd_barrier(xb, MK_TID()); } }
#ifdef PROBE_MASK
        { const unsigned long long dt_ = wall_clock64() - t_s0; if ((PROBE_MASK >> ph) & 1ull) t_sync += dt_; else t_syncb += dt_; }
#endif
#ifdef PROBE_MASK
#if defined(PROBE_LOADTEST) || defined(PROBE_SCANTEST)
        if (ph == 0 && blockIdx.x == 0 && threadIdx.x == 0) { t_acc = ((volatile unsigned long long*)(p.ws + R_END - 64))[0]; t_accb = ((volatile unsigned long long*)(p.ws + R_END - 64))[1]; }
#endif
        { const unsigned long long t_now = wall_clock64(); if ((PROBE_MASK >> ph) & 1ull) t_acc += t_now - t_prev; if ((PROBE_MASK_B >> ph) & 1ull) t_accb += t_now - t_prev; t_prev = t_now; }
#endif
    }
#ifdef PROBE_MASK
    if (blockIdx.x == 0 && threadIdx.x == 0) {
        const float v = (float)t_sync * 0.001f, vb = (float)t_syncb * 0.001f;
        p.out[5] += sqrtf(v);
        p.out[1024 + 5] += sqrtf(vb);
    }
#endif
}

extern "C" void kernel_launch(void* const* d_in, const int* in_sizes, int n_in, void* d_out, int out_size, void* d_ws, size_t ws_size, hipStream_t stream) {
    static int grid_blocks = 0;
    if (!grid_blocks) {
        int dev = 0, cus = 0, per_cu = 0;
        (void)hipGetDevice(&dev);
        (void)hipDeviceGetAttribute(&cus, hipDeviceAttributeMultiprocessorCount, dev);
        (void)hipFuncSetAttribute((const void*)fwd_megakernel, hipFuncAttributeMaxDynamicSharedMemorySize, LDS_BYTES);
        (void)hipOccupancyMaxActiveBlocksPerMultiprocessor(&per_cu, fwd_megakernel, NT, LDS_BYTES);
        if (per_cu < 1) per_cu = 1;
        if (per_cu > 1) per_cu = 1;
        grid_blocks = cus * per_cu;
        if (ws_size < R_END || ws_size < M_END) fprintf(stderr, "kernel_launch: workspace too small: %zu < %zu\n", ws_size, (size_t)(R_END > M_END ? R_END : M_END));
    }
    if (ws_size < R_END || ws_size < M_END || ws_size < BAR_END || R_END > BAR_OFF || M_END > BAR_OFF) return;
    (void)hipMemsetAsync((char*)d_ws + BAR_OFF, 0, 16384, stream);
    Params p{};
    p.x_prompt = (const float*)d_in[0]; p.x_sample = (const float*)d_in[1]; p.ret_w_in = (const float*)d_in[2]; p.ret_decay = (const float*)d_in[3];
    p.ret_w_out = (const float*)d_in[4]; p.na_w_in = (const float*)d_in[5]; p.na_rpb = (const float*)d_in[6]; p.na_w_out = (const float*)d_in[7];
    p.ln_mix_g = (const float*)d_in[8]; p.ln_mix_b = (const float*)d_in[9]; p.ln_ffn_g = (const float*)d_in[10]; p.ln_ffn_b = (const float*)d_in[11];
    p.w_router = (const float*)d_in[12]; p.w_gate = (const float*)d_in[13]; p.w_up = (const float*)d_in[14]; p.w_down = (const float*)d_in[15];
    p.out = (float*)d_out; p.ws = (char*)d_ws; p.ph_lo = 0; p.ph_hi = PH_COUNT;
    void* args[] = {&p};
    hipError_t e = hipLaunchCooperativeKernel((void*)fwd_megakernel, dim3(grid_blocks), dim3(NT), args, LDS_BYTES, stream);
    if (e != hipSuccess) fprintf(stderr, "cooperative launch failed: %s (grid %d)\n", hipGetErrorString(e), grid_blocks);
}
```

```cpp
#include <hip/hip_runtime.h>
#include <hip/hip_cooperative_groups.h>
#include <cstdio>
namespace cg = cooperative_groups;

typedef unsigned short bf16_t;
typedef short bf16x8 __attribute__((ext_vector_type(8)));
typedef float f32x16 __attribute__((ext_vector_type(16)));
typedef float f32x4 __attribute__((ext_vector_type(4)));
typedef unsigned long long u64;

constexpr int D = 1024;
constexpr int T_ALL = 49152;
constexpr int T_PROMPT = 32768;
constexpr int T3 = 16384;
constexpr float ALPHA = 1.41421356237309515f;
constexpr float LN_EPS = 1e-5f, GN_EPS = 1e-6f;
constexpr int CAP_P = 4096, CAP_S = 2048;
constexpr int RC = 256, NCH3 = T3 / RC;

constexpr size_t R_WIN = 0;
constexpr size_t R_WOUT = R_WIN + 6144ull * 1024 * 2;
constexpr size_t R_ROT = R_WOUT + 1024ull * 2048 * 2;
constexpr size_t R_Q = R_ROT + 16384ull * 128 * 8;
constexpr size_t R_K = R_Q + (size_t)T3 * 1024 * 2;
constexpr size_t R_KT = R_K + (size_t)T3 * 1024 * 2;
constexpr size_t R_VT = R_KT + (size_t)T3 * 1024 * 2;
constexpr size_t R_G = R_VT + (size_t)T3 * 2048 * 2;
constexpr size_t R_P = R_G + (size_t)T3 * 2048 * 2;
constexpr size_t R_UR = R_P + (size_t)NCH3 * 4 * RC * RC * 2;
constexpr size_t R_O = R_UR + 2ull * NCH3 * 4 * 512 * 256 * 2;
constexpr size_t R_END = R_O + (size_t)T3 * 2048 * 2;
constexpr size_t UNIT = (size_t)T_ALL * 1024 * 2;
constexpr size_t M_XB = 0;
constexpr size_t M_XB2 = 2 * UNIT;
constexpr size_t M_YE = 0;
constexpr size_t M_H = 2 * UNIT;
constexpr size_t M_WGU = M_H + 2ull * T_ALL * 1024 * 2;
constexpr size_t M_WD = M_WGU + 16ull * 2048 * 1024 * 2;
constexpr size_t M_AFF = M_WD + 16ull * 1024 * 1024 * 2;
constexpr size_t M_IDX = M_AFF + (size_t)T_ALL * 16 * 4;
constexpr size_t M_GATE = M_IDX + 2ull * T_ALL * 4;
constexpr size_t M_POS = M_GATE + 2ull * T_ALL * 4;
constexpr size_t M_NWIN = M_POS + (size_t)T_ALL * 16 * 4;
constexpr size_t M_NWOUT = M_NWIN + 3072ull * 1024 * 2;
constexpr size_t M_END = M_NWOUT + 1024ull * 1024 * 2;
constexpr size_t BAR_OFF = (R_END > M_END ? R_END : M_END);
constexpr size_t BAR_END = BAR_OFF + 16384;
constexpr size_t N_Q = 3 * UNIT;
constexpr size_t N_K = 0;
constexpr size_t N_VT = UNIT;

constexpr int LDS_BYTES = 131072 + 16;
struct Params {
    const float *x_prompt, *x_sample, *ret_w_in, *ret_decay, *ret_w_out, *na_w_in, *na_rpb, *na_w_out;
    const float *ln_mix_g, *ln_mix_b, *ln_ffn_g, *ln_ffn_b, *w_router, *w_gate, *w_up, *w_down;
    float* out;
    char* ws;
    int ph_lo, ph_hi;
};

typedef __bf16 bf16x2_t __attribute__((ext_vector_type(2)));
typedef float f32x2_t __attribute__((ext_vector_type(2)));
__device__ __forceinline__ unsigned pk_bf16(float lo, float hi) {
    f32x2_t v = {lo, hi};
    bf16x2_t b = __builtin_convertvector(v, bf16x2_t);
    return __builtin_bit_cast(unsigned, b);
}
__device__ __forceinline__ bf16_t f2bf(float f) { return (bf16_t)(pk_bf16(f, 0.f) & 0xffffu); }
__device__ __forceinline__ float bf_lo(unsigned u) { return __uint_as_float(u << 16); }
__device__ __forceinline__ float bf_hi(unsigned u) { return __uint_as_float(u & 0xffff0000u); }
__device__ __forceinline__ float silu_f(float g) { return g * __builtin_amdgcn_rcpf(1.f + __expf(-g)); }
template <int CTRL, int RMASK> __device__ __forceinline__ float dpp_mov0(float v) {
    return __builtin_bit_cast(float, __builtin_amdgcn_update_dpp(0, __builtin_bit_cast(int, v), CTRL, RMASK, 0xf, false));
}
__device__ __forceinline__ float wave_sum(float v) {
    v += dpp_mov0<0xB1, 0xf>(v);
    v += dpp_mov0<0x4E, 0xf>(v);
    v += dpp_mov0<0x141, 0xf>(v);
    v += dpp_mov0<0x140, 0xf>(v);
    v += dpp_mov0<0x142, 0xa>(v);
    v += dpp_mov0<0x143, 0xc>(v);
    return __builtin_bit_cast(float, __builtin_amdgcn_readlane(__builtin_bit_cast(int, v), 63));
}
template <int CTRL> __device__ __forceinline__ float dpp_perm(float v) { return __builtin_bit_cast(float, __builtin_amdgcn_update_dpp(0, __builtin_bit_cast(int, v), CTRL, 0xf, 0xf, true)); }
__device__ __forceinline__ float row16_max(float v) {
    v = fmaxf(v, dpp_perm<0xB1>(v)); v = fmaxf(v, dpp_perm<0x4E>(v)); v = fmaxf(v, dpp_perm<0x141>(v)); return fmaxf(v, dpp_perm<0x140>(v));
}
__device__ __forceinline__ float row16_sum(float v) {
    v += dpp_perm<0xB1>(v); v += dpp_perm<0x4E>(v); v += dpp_perm<0x141>(v); return v + dpp_perm<0x140>(v);
}
__device__ __forceinline__ uint4 scale8(uint4 v, float s) {
    uint4 r;
    r.x = pk_bf16(bf_lo(v.x) * s, bf_hi(v.x) * s);
    r.y = pk_bf16(bf_lo(v.y) * s, bf_hi(v.y) * s);
    r.z = pk_bf16(bf_lo(v.z) * s, bf_hi(v.z) * s);
    r.w = pk_bf16(bf_lo(v.w) * s, bf_hi(v.w) * s);
    return r;
}
__device__ __forceinline__ float log2_sigmoid(float x) { return -log1pf(expf(-x)) * 1.44269504088896341f; }

__device__ __forceinline__ int lds_off(int row, int c8) { return row * 128 + ((c8 ^ ((row >> 1) & 7)) << 4); }
constexpr int NT = 512;
template <int MI_, int NI_, int WM_, int WN_, int DEPTH_> struct Cfg {
    static constexpr int DEPTH = DEPTH_;
    static constexpr int MI = MI_, NI = NI_, WM = WM_, WN = WN_, BM = WM_ * MI_ * 32, BN = WN_ * NI_ * 32, LA = BM / 64, LB = BN / 64, STAGE = (BM + BN) * 128;
    static_assert(WM_ * WN_ == 8, "8 waves");
};
typedef Cfg<4, 2, 2, 4, 2> C256;
typedef Cfg<2, 1, 2, 4, 4> C128;
typedef Cfg<2, 2, 2, 4, 3> CO;

template <class P, class C, bool SWAP, int D, int S0, bool NOMATH = false>
__device__ __forceinline__ void gemm_iter(P& p, char* smem, int kt, int nk, uint4 (&va)[D][C::LA], uint4 (&vb)[D][C::LB], f32x16 (&acc)[C::MI][C::NI],
                                          int wm, int wn, int lane, int r0, int c8) {
    constexpr int S = S0 % D, SN = (S0 + 1) % D;
    char* cur = smem + (kt & 1) * C::STAGE;
    char* nxt = smem + ((kt + 1) & 1) * C::STAGE;
    if (kt + D < nk) {
#pragma unroll
        for (int i = 0; i < C::LA; ++i) va[S][i] = p.ldA(r0 + 64 * i, kt + D, c8);
#pragma unroll
        for (int i = 0; i < C::LB; ++i) vb[S][i] = p.ldB(r0 + 64 * i, kt + D, c8);
    }
    __builtin_amdgcn_sched_barrier(0);
    p.template pre<C>(kt, acc, wm, wn, lane);
#pragma unroll
    for (int ks = 0; ks < (NOMATH ? 0 : 4); ++ks) {
        bf16x8 a[C::MI], b[C::NI];
#pragma unroll
        for (int mi = 0; mi < C::MI; ++mi) a[mi] = *(const bf16x8*)(cur + lds_off(wm * (C::MI * 32) + mi * 32 + (lane & 31), ks * 2 + (lane >> 5)));
#pragma unroll
        for (int ni = 0; ni < C::NI; ++ni) b[ni] = *(const bf16x8*)(cur + C::BM * 128 + lds_off(wn * (C::NI * 32) + ni * 32 + (lane & 31), ks * 2 + (lane >> 5)));
#pragma unroll
        for (int mi = 0; mi < C::MI; ++mi)
#pragma unroll
            for (int ni = 0; ni < C::NI; ++ni) {
                if (SWAP) acc[mi][ni] = __builtin_amdgcn_mfma_f32_32x32x16_bf16(b[ni], a[mi], acc[mi][ni], 0, 0, 0);
                else      acc[mi][ni] = __builtin_amdgcn_mfma_f32_32x32x16_bf16(a[mi], b[ni], acc[mi][ni], 0, 0, 0);
            }
    }
    if (kt + 1 < nk) {
#pragma unroll
        for (int i = 0; i < C::LA; ++i) *(uint4*)(nxt + lds_off(r0 + 64 * i, c8)) = p.fixA(va[SN][i], r0 + 64 * i, kt + 1, c8);
#pragma unroll
        for (int i = 0; i < C::LB; ++i) *(uint4*)(nxt + C::BM * 128 + lds_off(r0 + 64 * i, c8)) = p.fixB(vb[SN][i], r0 + 64 * i, kt + 1, c8);
    }
    __syncthreads();
}

template <class P, class C, bool SWAP, int D = C::DEPTH, bool NOMATH = false>
__device__ __forceinline__ void gemm_core(P& p, char* smem, int nk, const int TID) {
    int tid = TID;
    asm volatile("" : "+v"(tid));
    const int lane = tid & 63, w = tid >> 6, wm = w / C::WN, wn = w % C::WN;
    const int c8 = tid & 7, r0 = tid >> 3;
    f32x16 acc[C::MI][C::NI];
#pragma unroll
    for (int i = 0; i < C::MI; ++i)
#pragma unroll
        for (int j = 0; j < C::NI; ++j)
#pragma unroll
            for (int r = 0; r < 16; ++r) acc[i][j][r] = 0.f;
    uint4 va[D][C::LA], vb[D][C::LB];
#pragma unroll
    for (int d = 0; d < D; ++d) {
        if (d < nk) {
#pragma unroll
            for (int i = 0; i < C::LA; ++i) va[d][i] = p.ldA(r0 + 64 * i, d, c8);
#pragma unroll
            for (int i = 0; i < C::LB; ++i) vb[d][i] = p.ldB(r0 + 64 * i, d, c8);
        }
    }
#pragma unroll
    for (int i = 0; i < C::LA; ++i) *(uint4*)(smem + lds_off(r0 + 64 * i, c8)) = p.fixA(va[0][i], r0 + 64 * i, 0, c8);
#pragma unroll
    for (int i = 0; i < C::LB; ++i) *(uint4*)(smem + C::BM * 128 + lds_off(r0 + 64 * i, c8)) = p.fixB(vb[0][i], r0 + 64 * i, 0, c8);
    __syncthreads();
    for (int kt = 0; kt < nk; kt += D) {
        gemm_iter<P, C, SWAP, D, 0, NOMATH>(p, smem, kt, nk, va, vb, acc, wm, wn, lane, r0, c8);
        if (D > 1 && kt + 1 < nk) gemm_iter<P, C, SWAP, D, 1, NOMATH>(p, smem, kt + 1, nk, va, vb, acc, wm, wn, lane, r0, c8);
        if (D > 2 && kt + 2 < nk) gemm_iter<P, C, SWAP, D, 2, NOMATH>(p, smem, kt + 2, nk, va, vb, acc, wm, wn, lane, r0, c8);
        if (D > 3 && kt + 3 < nk) gemm_iter<P, C, SWAP, D, 3, NOMATH>(p, smem, kt + 3, nk, va, vb, acc, wm, wn, lane, r0, c8);
    }
    int tid2 = tid;
    asm volatile("" : "+v"(tid2));
    p.template epi<C>(acc, (tid2 >> 6) / C::WN, (tid2 >> 6) % C::WN, tid2 & 63);
}

#define LAS3 __attribute__((address_space(3)))
template <class P, class C>
__device__ __forceinline__ void dma_stage(P& p, char* stage, int kt, int w, int lane) {
    const int rl = lane >> 3, cs = lane & 7;
#pragma unroll
    for (int i = 0; i < C::LA; ++i) {
        const int row = 64 * i + 8 * w + rl;
        __builtin_amdgcn_global_load_lds((const unsigned*)p.adA(row, kt, cs ^ ((row >> 1) & 7)), (LAS3 unsigned*)(stage + (64 * i + 8 * w) * 128), 16, 0, 0);
    }
#pragma unroll
    for (int i = 0; i < C::LB; ++i) {
        const int row = 64 * i + 8 * w + rl;
        __builtin_amdgcn_global_load_lds((const unsigned*)p.adB(row, kt, cs ^ ((row >> 1) & 7)), (LAS3 unsigned*)(stage + C::BM * 128 + (64 * i + 8 * w) * 128), 16, 0, 0);
    }
}
template <class P, class C, bool SWAP>
__device__ __forceinline__ void gemm_core_dma(P& p, char* smem, int nk, const int TID) {
    int tid = TID;
    asm volatile("" : "+v"(tid));
    const int lane = tid & 63, w = __builtin_amdgcn_readfirstlane(tid >> 6), wm = w / C::WN, wn = w % C::WN;
    f32x16 acc[C::MI][C::NI];
#pragma unroll
    for (int i = 0; i < C::MI; ++i)
#pragma unroll
        for (int j = 0; j < C::NI; ++j)
#pragma unroll
            for (int r = 0; r < 16; ++r) acc[i][j][r] = 0.f;
    dma_stage<P, C>(p, smem, 0, w, lane);
    __syncthreads();
    for (int kt = 0; kt < nk; ++kt) {
        char* cur = smem + (kt & 1) * C::STAGE;
        if (kt + 1 < nk) dma_stage<P, C>(p, smem + ((kt + 1) & 1) * C::STAGE, kt + 1, w, lane);
        __builtin_amdgcn_sched_barrier(0);
        bf16x8 a[2][C::MI], b[2][C::NI];
#pragma unroll
        for (int mi = 0; mi < C::MI; ++mi) a[0][mi] = *(const bf16x8*)(cur + lds_off(wm * (C::MI * 32) + mi * 32 + (lane & 31), (lane >> 5)));
#pragma unroll
        for (int ni = 0; ni < C::NI; ++ni) b[0][ni] = *(const bf16x8*)(cur + C::BM * 128 + lds_off(wn * (C::NI * 32) + ni * 32 + (lane & 31), (lane >> 5)));
#pragma unroll
        for (int ks = 0; ks < 4; ++ks) {
            if (ks < 3) {
#pragma unroll
                for (int mi = 0; mi < C::MI; ++mi) a[(ks + 1) & 1][mi] = *(const bf16x8*)(cur + lds_off(wm * (C::MI * 32) + mi * 32 + (lane & 31), (ks + 1) * 2 + (lane >> 5)));
#pragma unroll
                for (int ni = 0; ni < C::NI; ++ni) b[(ks + 1) & 1][ni] = *(const bf16x8*)(cur + C::BM * 128 + lds_off(wn * (C::NI * 32) + ni * 32 + (lane & 31), (ks + 1) * 2 + (lane >> 5)));
            }
            __builtin_amdgcn_sched_barrier(0);
#pragma unroll
            for (int mi = 0; mi < C::MI; ++mi)
#pragma unroll
                for (int ni = 0; ni < C::NI; ++ni) {
                    if (SWAP) acc[mi][ni] = __builtin_amdgcn_mfma_f32_32x32x16_bf16(b[ks & 1][ni], a[ks & 1][mi], acc[mi][ni], 0, 0, 0);
                    else      acc[mi][ni] = __builtin_amdgcn_mfma_f32_32x32x16_bf16(a[ks & 1][mi], b[ks & 1][ni], acc[mi][ni], 0, 0, 0);
                }
            __builtin_amdgcn_sched_barrier(0);
        }
        __syncthreads();
    }
    int tid2 = tid;
    asm volatile("" : "+v"(tid2));
    p.template epi<C>(acc, (tid2 >> 6) / C::WN, (tid2 >> 6) % C::WN, tid2 & 63);
}

__device__ __forceinline__ int lds_off64(int row, int c4) { return row * 64 + ((c4 ^ ((row >> 2) & 3)) << 4); }
template <class P, class C, bool SWAP>
__device__ __forceinline__ void gemm_core_dma4(P& p, char* smem, int nk, const int TID) {
    static_assert(C::BM == 256 && C::BN == 256, "sized for 256 x 256 tiles: 4 stages x 32 KiB");
    constexpr int STG = (C::BM + C::BN) * 64;
    int tid = TID;
    asm volatile("" : "+v"(tid));
    const int lane = tid & 63, w = __builtin_amdgcn_readfirstlane(tid >> 6), wm = w / C::WN, wn = w % C::WN;
    const int nsteps = nk * 2;
    f32x16 acc[C::MI][C::NI];
#pragma unroll
    for (int i = 0; i < C::MI; ++i)
#pragma unroll
        for (int j = 0; j < C::NI; ++j)
#pragma unroll
            for (int r = 0; r < 16; ++r) acc[i][j][r] = 0.f;
    const char* pa[2]; const char* pb[2];
#pragma unroll
    for (int i = 0; i < 2; ++i) {
        const int row = 32 * w + 16 * i + (lane >> 2);
        const int ch = (lane & 3) ^ ((row >> 2) & 3);
        pa[i] = (const char*)p.adA(row, 0, 0) + ch * 16;
        pb[i] = (const char*)p.adB(row, 0, 0) + ch * 16;
    }
#define DMA4_ISSUE(j) do { char* st_ = smem + ((j) & 3) * STG + (32 * w) * 64; _Pragma("unroll") for (int i_ = 0; i_ < 2; ++i_) { \
        __builtin_amdgcn_global_load_lds((const unsigned*)(pa[i_] + (size_t)(j) * 64), (LAS3 unsigned*)(st_ + i_ * 1024), 16, 0, 0); \
        __builtin_amdgcn_global_load_lds((const unsigned*)(pb[i_] + (size_t)(j) * 64), (LAS3 unsigned*)(st_ + C::BM * 64 + i_ * 1024), 16, 0, 0); } } while (0)
    DMA4_ISSUE(0);
    DMA4_ISSUE(1);
    for (int j = 0; j < nsteps; ++j) {
        if (j + 2 < nsteps) { DMA4_ISSUE(j + 2); asm volatile("s_waitcnt vmcnt(8)" ::: "memory"); }
        else if (j + 1 < nsteps) asm volatile("s_waitcnt vmcnt(4)" ::: "memory");
        else asm volatile("s_waitcnt vmcnt(0)" ::: "memory");
        __builtin_amdgcn_s_barrier();
        __builtin_amdgcn_sched_barrier(0);
        const char* cur = smem + (j & 3) * STG;
#pragma unroll
        for (int ks = 0; ks < 2; ++ks) {
            bf16x8 a[C::MI], b[C::NI];
#pragma unroll
            for (int mi = 0; mi < C::MI; ++mi) a[mi] = *(const bf16x8*)(cur + lds_off64(wm * (C::MI * 32) + mi * 32 + (lane & 31), ks * 2 + (lane >> 5)));
#pragma unroll
            for (int ni = 0; ni < C::NI; ++ni) b[ni] = *(const bf16x8*)(cur + C::BM * 64 + lds_off64(wn * (C::NI * 32) + ni * 32 + (lane & 31), ks * 2 + (lane >> 5)));
#pragma unroll
            for (int mi = 0; mi < C::MI; ++mi)
#pragma unroll
                for (int ni = 0; ni < C::NI; ++ni) {
                    if (SWAP) acc[mi][ni] = __builtin_amdgcn_mfma_f32_32x32x16_bf16(b[ni], a[mi], acc[mi][ni], 0, 0, 0);
                    else      acc[mi][ni] = __builtin_amdgcn_mfma_f32_32x32x16_bf16(a[mi], b[ni], acc[mi][ni], 0, 0, 0);
                }
        }
        __builtin_amdgcn_sched_barrier(0);
    }
#undef DMA4_ISSUE
    __syncthreads();
    int tid2 = tid;
    asm volatile("" : "+v"(tid2));
    p.template epi<C>(acc, (tid2 >> 6) / C::WN, (tid2 >> 6) % C::WN, tid2 & 63);
}

struct NoFix {
    __device__ __forceinline__ uint4 fixA(uint4 v, int, int, int) const { return v; }
    __device__ __forceinline__ uint4 fixB(uint4 v, int, int, int) const { return v; }
};
struct NoPre : NoFix { template <class C> __device__ __forceinline__ void pre(int, f32x16 (&)[C::MI][C::NI], int, int, int) {} };

#define PK4(A, g) make_uint2(pk_bf16((A)[(g) * 4 + 0], (A)[(g) * 4 + 1]), pk_bf16((A)[(g) * 4 + 2], (A)[(g) * 4 + 3]))

template <bool SWAP> struct PolProj : NoPre {
    const bf16_t* xA; const bf16_t* Bt; char* ws; int m0, n0, smask;
    __device__ __forceinline__ const bf16_t* adA(int row, int kt, int c8) const { return xA + (size_t)(m0 + row) * 1024 + kt * 64 + c8 * 8; }
    __device__ __forceinline__ const bf16_t* adB(int row, int kt, int c8) const { return Bt + (size_t)(n0 + row) * 1024 + kt * 64 + c8 * 8; }
    __device__ __forceinline__ uint4 ldA(int row, int kt, int c8) const { return *(const uint4*)adA(row, kt, c8); }
    __device__ __forceinline__ uint4 ldB(int row, int kt, int c8) const { return *(const uint4*)adB(row, kt, c8); }
    template <class C> __device__ __forceinline__ void epi(f32x16 (&acc)[C::MI][C::NI], int wm, int wn, int lane) const {
        static_assert(C::NI == 2, "rotary pairs need a 64-column wave tile");
        const int sec = n0 >> 10;
        bf16_t* Qb = (bf16_t*)(ws + R_Q); bf16_t* Kb = (bf16_t*)(ws + R_K); bf16_t* Ktb = (bf16_t*)(ws + R_KT);
        bf16_t* Vtb = (bf16_t*)(ws + R_VT); bf16_t* Gb = (bf16_t*)(ws + R_G);
        const float2* rot = (const float2*)(ws + R_ROT);
        const int mb = m0 + wm * (C::MI * 32);
        if (sec == 0) {
            const int cb = (n0 & 1023) + wn * 64;
            const int ib = ((cb & 255) >> 6) * 32 + (lane & 31);
            const int c1 = cb + (lane & 31);
#pragma unroll
            for (int mi = 0; mi < C::MI; ++mi)
#pragma unroll
                for (int r = 0; r < 16; ++r) {
                    const int tok = mb + mi * 32 + 8 * (r >> 2) + 4 * (lane >> 5) + (r & 3);
                    const float2 cs = rot[(size_t)(tok & smask) * 128 + ib];
                    const float x1 = acc[mi][0][r], x2 = acc[mi][1][r];
                    Qb[(size_t)tok * 1024 + c1] = f2bf(x1 * cs.x - x2 * cs.y);
                    Qb[(size_t)tok * 1024 + c1 + 32] = f2bf(x1 * cs.y + x2 * cs.x);
                }
        } else if (sec == 1) {
            const int cb = (n0 & 1023) + wn * 64;
            const int ib = ((cb & 255) >> 6) * 32 + (lane & 31);
            const int c1 = cb + (lane & 31);
#pragma unroll
            for (int mi = 0; mi < C::MI; ++mi)
#pragma unroll
                for (int g = 0; g < 4; ++g) {
                    const int tok0 = mb + mi * 32 + 8 * g + 4 * (lane >> 5);
                    float o1[4], o2[4];
#pragma unroll
                    for (int e = 0; e < 4; ++e) {
                        float2 cs = rot[(size_t)((tok0 + e) & smask) * 128 + ib];
                        float x1 = acc[mi][0][g * 4 + e], x2 = acc[mi][1][g * 4 + e];
                        o1[e] = x1 * cs.x - x2 * cs.y; o2[e] = x1 * cs.y + x2 * cs.x;
                        Kb[(size_t)(tok0 + e) * 1024 + c1] = f2bf(o1[e]);
                        Kb[(size_t)(tok0 + e) * 1024 + c1 + 32] = f2bf(o2[e]);
                    }
                    *(uint2*)(Ktb + ((size_t)(tok0 >> 7) * 1024 + c1) * 128 + (tok0 & 127)) = make_uint2(pk_bf16(o1[0], o1[1]), pk_bf16(o1[2], o1[3]));
                    *(uint2*)(Ktb + ((size_t)(tok0 >> 7) * 1024 + c1 + 32) * 128 + (tok0 & 127)) = make_uint2(pk_bf16(o2[0], o2[1]), pk_bf16(o2[2], o2[3]));
                    __builtin_amdgcn_sched_barrier(0);
                }
        } else if (sec < 4) {
#pragma unroll
            for (int mi = 0; mi < C::MI; ++mi) {
                const int tok = mb + mi * 32 + (lane & 31);
#pragma unroll
                for (int ni = 0; ni < 2; ++ni)
#pragma unroll
                    for (int r = 0; r < 16; ++r) {
                        const int col = n0 - 2048 + wn * 64 + ni * 32 + 8 * (r >> 2) + 4 * (lane >> 5) + (r & 3);
                        Vtb[((size_t)(tok >> 7) * 2048 + col) * 128 + (tok & 127)] = f2bf(acc[mi][ni][r]);
                    }
            }
        } else {
#pragma unroll
            for (int mi = 0; mi < C::MI; ++mi)
#pragma unroll
                for (int ni = 0; ni < 2; ++ni) {
                    const int col = n0 - 4096 + wn * 64 + ni * 32 + (lane & 31);
#pragma unroll
                    for (int r = 0; r < 16; ++r) {
                        const int tok = mb + mi * 32 + 8 * (r >> 2) + 4 * (lane >> 5) + (r & 3);
                        Gb[(size_t)tok * 2048 + col] = f2bf(acc[mi][ni][r]);
                    }
                }
        }
    }
};

#ifdef PROBE_MASK
struct PolNull : NoPre {
    float* sink;
    __device__ __forceinline__ uint4 ldA(int row, int kt, int c8) const { return make_uint4(row, kt, c8, 0x3f803f80u); }
    __device__ __forceinline__ uint4 ldB(int row, int kt, int c8) const { return make_uint4(0x3f803f80u, row ^ kt, c8, 0x3f803f80u); }
    template <class C> __device__ __forceinline__ void epi(f32x16 (&acc)[C::MI][C::NI], int wm, int wn, int lane) const {
        float t = 0.f;
#pragma unroll
        for (int mi = 0; mi < C::MI; ++mi)
#pragma unroll
            for (int ni = 0; ni < C::NI; ++ni)
#pragma unroll
                for (int r = 0; r < 16; ++r) t += acc[mi][ni][r];
        if (t == 123456.789f) *sink = t;
    }
};
#endif

#ifdef PROBE_MASK
struct PolLoadTest : NoPre {
    const bf16_t *A, *B; int lda; float* sink;
    __device__ __forceinline__ uint4 ldA(int row, int kt, int c8) const { return *(const uint4*)(A + (size_t)row * lda + kt * 64 + c8 * 8); }
    __device__ __forceinline__ uint4 ldB(int row, int kt, int c8) const { return *(const uint4*)(B + (size_t)row * lda + kt * 64 + c8 * 8); }
    template <class C> __device__ __forceinline__ void epi(f32x16 (&acc)[C::MI][C::NI], int, int, int) const { if (acc[0][0][0] == 123456.789f) *sink = 1.f; }
};
#endif

struct PolScore : NoPre {
    const bf16_t *A, *B; bf16_t* P; float lgf, lgb; char* smem;
    __device__ __forceinline__ const bf16_t* adA(int row, int kt, int c8) const { return A + (size_t)row * 1024 + kt * 64 + c8 * 8; }
    __device__ __forceinline__ const bf16_t* adB(int row, int kt, int c8) const { return B + (size_t)row * 1024 + kt * 64 + c8 * 8; }
    __device__ __forceinline__ uint4 ldA(int row, int kt, int c8) const { return *(const uint4*)adA(row, kt, c8); }
    __device__ __forceinline__ uint4 ldB(int row, int kt, int c8) const { return *(const uint4*)adB(row, kt, c8); }
    template <class C> __device__ __forceinline__ void epi(f32x16 (&acc)[C::MI][C::NI], int wm, int wn, int lane) const {
        float* tab = (float*)smem;
        const int tid = (wm * C::WN + wn) * 64 + lane;
        if (tid < 2 * RC - 1) { const int d = tid - (RC - 1); tab[tid] = (d >= 0) ? exp2f(lgf * (float)d) : exp2f(lgb * (float)(-d)); }
        __syncthreads();
#pragma unroll
        for (int mi = 0; mi < C::MI; ++mi)
#pragma unroll
            for (int ni = 0; ni < C::NI; ++ni) {
                const int j = wn * (C::NI * 32) + ni * 32 + (lane & 31);
#pragma unroll
                for (int r = 0; r < 16; ++r) {
                    const int i = wm * (C::MI * 32) + mi * 32 + 8 * (r >> 2) + 4 * (lane >> 5) + (r & 3);
                    P[(size_t)i * RC + j] = f2bf(acc[mi][ni][r] * tab[i - j + (RC - 1)]);
                }
            }
        __syncthreads();
    }
};

template <bool EMIT = true, bool SCALE = true> struct PolUscanT {
    const bf16_t *A, *B;
    bf16_t* UR;
    int nc, dir; float lg, dec, st, st2;
    __device__ __forceinline__ int rchunk(int kt) const { const int ci = kt >> 2; return dir ? (nc - 1 - ci) : ci; }
    __device__ __forceinline__ int chunk(int kt) const { return rchunk(kt) * 2 + ((kt & 3) >> 1); }
    __device__ __forceinline__ uint4 ldA(int row, int kt, int c8) const { return *(const uint4*)(A + (size_t)chunk(kt) * (2048 * 128) + (kt & 1) * 64 + (unsigned)(row * 128 + c8 * 8)); }
    __device__ __forceinline__ uint4 ldB(int row, int kt, int c8) const { return *(const uint4*)(B + (size_t)chunk(kt) * (1024 * 128) + (kt & 1) * 64 + (unsigned)(row * 128 + c8 * 8)); }
    __device__ __forceinline__ uint4 fixA(uint4 v, int, int, int) const { return v; }
    __device__ __forceinline__ uint4 fixB(uint4 v, int row, int kt, int c8) const {
        if (!SCALE) return v;
        const int j0 = (kt & 3) * 64 + c8 * 8;
        float w0 = exp2f(lg * (float)(dir ? j0 : (RC - 1 - j0)));
        float w1 = w0 * st;
        uint4 r;
        r.x = pk_bf16(bf_lo(v.x) * w0, bf_hi(v.x) * w1); w0 *= st2; w1 *= st2;
        r.y = pk_bf16(bf_lo(v.y) * w0, bf_hi(v.y) * w1); w0 *= st2; w1 *= st2;
        r.z = pk_bf16(bf_lo(v.z) * w0, bf_hi(v.z) * w1); w0 *= st2; w1 *= st2;
        r.w = pk_bf16(bf_lo(v.w) * w0, bf_hi(v.w) * w1);
        return r;
    }
    template <class C> __device__ __forceinline__ void pre(int kt, f32x16 (&acc)[C::MI][C::NI], int wm, int wn, int lane) const {
        if (kt & 3) return;
        const int ch = rchunk(kt);
        bf16_t* dst = UR + (size_t)ch * (4ull * 512 * 256);
#pragma unroll
        for (int mi = 0; mi < (EMIT ? C::MI : 0); ++mi)
#pragma unroll
            for (int ni = 0; ni < C::NI; ++ni) {
                const int n = wn * (C::NI * 32) + ni * 32 + (lane & 31);
#pragma unroll
                for (int r = 0; r < 16; ++r) {
                    const int m = wm * (C::MI * 32) + mi * 32 + 8 * (r >> 2) + 4 * (lane >> 5) + (r & 3);
                    dst[(size_t)m * 256 + n] = f2bf(acc[mi][ni][r]);
                }
            }
#pragma unroll
        for (int mi = 0; mi < C::MI; ++mi)
#pragma unroll
            for (int ni = 0; ni < C::NI; ++ni)
#pragma unroll
                for (int r = 0; r < 16; ++r) acc[mi][ni][r] *= dec;
    }
    template <class C> __device__ __forceinline__ void epi(f32x16 (&)[C::MI][C::NI], int, int, int) const {}
};

typedef PolUscanT<true, true> PolUscan;

struct PolO : NoPre {
    const bf16_t *Pp, *Qp, *Vp, *Rf, *Rb; bf16_t* O; float lgf, lgb; int half;
    __device__ __forceinline__ uint4 ldA(int row, int kt, int c8) const {
        if (kt < 4) return *(const uint4*)(Pp + kt * 64 + (unsigned)(row * RC + c8 * 8));
        const int kk = (kt - 4) & 3;
        return *(const uint4*)(Qp + kk * 64 + (unsigned)(row * 1024 + c8 * 8));
    }
    __device__ __forceinline__ uint4 fixA(uint4 v, int row, int kt, int) const {
        if (kt < 4) return v;
        const int seg = (kt - 4) >> 2, i = half * 128 + row;
        const float s = seg ? exp2f(lgb * (float)(RC - i)) : exp2f(lgf * (float)(i + 1));
        return scale8(v, s);
    }
    __device__ __forceinline__ uint4 ldB(int row, int kt, int c8) const {
        if (kt < 4) return *(const uint4*)(Vp + (size_t)(kt >> 1) * (2048 * 128) + (kt & 1) * 64 + (unsigned)(row * 128 + c8 * 8));
        const int seg = (kt - 4) >> 2, kk = (kt - 4) & 3;
        return *(const uint4*)((seg ? Rb : Rf) + kk * 64 + (unsigned)(row * 256 + c8 * 8));
    }
    template <class C> __device__ __forceinline__ void epi(f32x16 (&acc)[C::MI][C::NI], int wm, int wn, int lane) const {
#pragma unroll
        for (int mi = 0; mi < C::MI; ++mi)
#pragma unroll
            for (int ni = 0; ni < C::NI; ++ni) {
                const int n = wn * (C::NI * 32) + ni * 32 + (lane & 31);
#pragma unroll
                for (int r = 0; r < 16; ++r) {
                    const int m = wm * (C::MI * 32) + mi * 32 + 8 * (r >> 2) + 4 * (lane >> 5) + (r & 3);
                    O[(size_t)m * 2048 + n] = f2bf(acc[mi][ni][r]);
                }
            }
    }
};

struct PolResid : NoPre {
    const bf16_t *A, *B; int lda, ldb; const float* res; float* dst;
    __device__ __forceinline__ const bf16_t* adA(int row, int kt, int c8) const { return A + (size_t)row * lda + kt * 64 + c8 * 8; }
    __device__ __forceinline__ const bf16_t* adB(int row, int kt, int c8) const { return B + (size_t)row * ldb + kt * 64 + c8 * 8; }
    __device__ __forceinline__ uint4 ldA(int row, int kt, int c8) const { return *(const uint4*)adA(row, kt, c8); }
    __device__ __forceinline__ uint4 ldB(int row, int kt, int c8) const { return *(const uint4*)adB(row, kt, c8); }
    template <class C> __device__ __forceinline__ void epi(f32x16 (&acc)[C::MI][C::NI], int wm, int wn, int lane) const {
#pragma unroll
        for (int mi = 0; mi < C::MI; ++mi)
#pragma unroll
            for (int ni = 0; ni < C::NI; ++ni) {
                const int n = wn * (C::NI * 32) + ni * 32 + (lane & 31);
#pragma unroll
                for (int r = 0; r < 16; ++r) {
                    const int m = wm * (C::MI * 32) + mi * 32 + 8 * (r >> 2) + 4 * (lane >> 5) + (r & 3);
                    dst[(size_t)m * 1024 + n] = ALPHA * res[(size_t)m * 1024 + n] + acc[mi][ni][r];
                }
            }
    }
};

struct PolMoe1 : NoPre {
    const bf16_t *xb, *B; const int* idx; bf16_t* H; int n0;
    __device__ __forceinline__ const bf16_t* adA(int row, int kt, int c8) const { return xb + (size_t)idx[row] * 1024 + kt * 64 + c8 * 8; }
    __device__ __forceinline__ const bf16_t* adB(int row, int kt, int c8) const { return B + (size_t)row * 1024 + kt * 64 + c8 * 8; }
    __device__ __forceinline__ uint4 ldA(int row, int kt, int c8) const { return *(const uint4*)adA(row, kt, c8); }
    __device__ __forceinline__ uint4 ldB(int row, int kt, int c8) const { return *(const uint4*)adB(row, kt, c8); }
    template <class C> __device__ __forceinline__ void epi(f32x16 (&acc)[C::MI][C::NI], int wm, int wn, int lane) const {
        static_assert(C::NI == 2, "gate/up pairs need a 64-column wave tile");
        const int f = ((n0 + wn * 64) >> 1) + (lane & 31);
#pragma unroll
        for (int mi = 0; mi < C::MI; ++mi)
#pragma unroll
            for (int r = 0; r < 16; ++r) {
                const int m = wm * (C::MI * 32) + mi * 32 + 8 * (r >> 2) + 4 * (lane >> 5) + (r & 3);
                H[(size_t)m * 1024 + f] = f2bf(silu_f(acc[mi][0][r]) * acc[mi][1][r]);
            }
    }
};
struct PolMoe2 : NoPre {
    const bf16_t *A, *B; const float* gate; bf16_t* Y;
    __device__ __forceinline__ const bf16_t* adA(int row, int kt, int c8) const { return A + (size_t)row * 1024 + kt * 64 + c8 * 8; }
    __device__ __forceinline__ const bf16_t* adB(int row, int kt, int c8) const { return B + (size_t)row * 1024 + kt * 64 + c8 * 8; }
    __device__ __forceinline__ uint4 ldA(int row, int kt, int c8) const { return *(const uint4*)adA(row, kt, c8); }
    __device__ __forceinline__ uint4 ldB(int row, int kt, int c8) const { return *(const uint4*)adB(row, kt, c8); }
    template <class C> __device__ __forceinline__ void epi(f32x16 (&acc)[C::MI][C::NI], int wm, int wn, int lane) const {
#pragma unroll
        for (int mi = 0; mi < C::MI; ++mi)
#pragma unroll
            for (int r = 0; r < 16; ++r) {
                const int m = wm * (C::MI * 32) + mi * 32 + 8 * (r >> 2) + 4 * (lane >> 5) + (r & 3);
                const float gt = gate[m];
#pragma unroll
                for (int ni = 0; ni < C::NI; ++ni) Y[(size_t)m * 1024 + wn * (C::NI * 32) + ni * 32 + (lane & 31)] = f2bf(acc[mi][ni][r] * gt);
            }
    }
};
template <bool SWAP> struct PolQkv : NoPre {
    const bf16_t *A, *B; char* ws; int m0, n0;
    __device__ __forceinline__ const bf16_t* adA(int row, int kt, int c8) const { return A + (size_t)row * 1024 + kt * 64 + c8 * 8; }
    __device__ __forceinline__ const bf16_t* adB(int row, int kt, int c8) const { return B + (size_t)row * 1024 + kt * 64 + c8 * 8; }
    __device__ __forceinline__ uint4 ldA(int row, int kt, int c8) const { return *(const uint4*)adA(row, kt, c8); }
    __device__ __forceinline__ uint4 ldB(int row, int kt, int c8) const { return *(const uint4*)adB(row, kt, c8); }
    template <class C> __device__ __forceinline__ void epi(f32x16 (&acc)[C::MI][C::NI], int wm, int wn, int lane) const {
        const int mb = m0 + wm * (C::MI * 32);
        if (!SWAP) {
            bf16_t* dstb = (bf16_t*)(ws + ((n0 >> 10) ? N_K : N_Q));
#pragma unroll
            for (int mi = 0; mi < C::MI; ++mi)
#pragma unroll
                for (int ni = 0; ni < C::NI; ++ni) {
                    const int hh = ((n0 & 1023) + wn * (C::NI * 32) + ni * 32) >> 5;
#pragma unroll
                    for (int r = 0; r < 16; ++r) {
                        const int tok = mb + mi * 32 + 8 * (r >> 2) + 4 * (lane >> 5) + (r & 3);
                        dstb[((size_t)hh * T_ALL + tok) * 32 + (lane & 31)] = f2bf(acc[mi][ni][r]);
                    }
                }
        } else {
            bf16_t* Vt = (bf16_t*)(ws + N_VT);
#pragma unroll
            for (int mi = 0; mi < C::MI; ++mi) {
                const int tok = mb + mi * 32 + (lane & 31);
#pragma unroll
                for (int ni = 0; ni < C::NI; ++ni)
#pragma unroll
                    for (int r = 0; r < 16; ++r) {
                        const int col = n0 - 2048 + wn * (C::NI * 32) + ni * 32 + 8 * (r >> 2) + 4 * (lane >> 5) + (r & 3);
                        Vt[(size_t)col * T_ALL + tok] = f2bf(acc[mi][ni][r]);
                    }
            }
        }
    }
};

__device__ __forceinline__ void transpose_tile(const float* src0, const float* src1, int ld, bf16_t* dst, int K, int n0, int k0, int mode, char* smem, const int TID) {
    float* tile = (float*)smem;
    const int t = TID;
    {
        const int n4 = (t & 15) * 4, kr = t >> 4;
        const int np = n0 + n4;
        const float* s = src0; int col = np;
        if (mode == 1 && np < 2048) {
            const int base = np & ~255, r = np & 255, g = r >> 5, u = r & 31;
            const int i = g * 16 + (u & 15);
            col = base + ((u < 16) ? i : (i + 128));
        } else if (mode == 2) {
            const int g = np >> 5, u = np & 31;
            if (u >= 16) s = src1;
            col = g * 16 + (u & 15);
        }
#pragma unroll
        for (int kk = 0; kk < 4; ++kk) {
            const int k = kr + 32 * kk;
            const float4 v = *(const float4*)(s + (size_t)(k0 + k) * ld + col);
            tile[k * 65 + n4 + 0] = v.x; tile[k * 65 + n4 + 1] = v.y; tile[k * 65 + n4 + 2] = v.z; tile[k * 65 + n4 + 3] = v.w;
        }
    }
    __syncthreads();
    {
        const int n = t >> 3, kc = (t & 7) * 16;
        const int np = n0 + n;
        float sc = 1.f;
        if (mode == 1 && np >= 1024 && np < 2048) sc = 0.0625f;
        if (mode == 3 && np < 1024) sc = 0.17677669529663687f * 1.4426950408889634f;
        unsigned o[8];
#pragma unroll
        for (int j = 0; j < 8; ++j) o[j] = pk_bf16(tile[(kc + 2 * j) * 65 + n] * sc, tile[(kc + 2 * j + 1) * 65 + n] * sc);
        uint4* d = (uint4*)(dst + (size_t)np * K + k0 + kc);
        d[0] = make_uint4(o[0], o[1], o[2], o[3]);
        d[1] = make_uint4(o[4], o[5], o[6], o[7]);
    }
    __syncthreads();
}
__device__ void convert_matrix(const float* src0, const float* src1, int ld, bf16_t* dst, int N, int K, int mode, char* smem, int& rot, const int TID, int wid, int nw) {
    const int ntn = N / 64, ntk = K / 128, nt = ntn * ntk;
    if (wid >= 0) {
        int start = (wid + nw - (rot % nw)) % nw;
        for (int t = start; t < nt; t += nw) transpose_tile(src0, src1, ld, dst, K, (t % ntn) * 64, (t / ntn) * 128, mode, smem, TID);
    }
    rot += nt;
}

template <int MODE_SRC, bool WRITE_XB, bool ROUTER>
__device__ void ln_phase(const Params& p, const float* gam, const float* bet, const float* wr, size_t xb_off, char* smem, const int TID) {
    float* wrT = (float*)smem;
    if (ROUTER) {
        for (int i = TID; i < 16 * 1024; i += NT) { const int d = i >> 4, e = i & 15; wrT[e * 1024 + d] = wr[i]; }
        __syncthreads();
    }
    const int lane = TID & 63, w = TID >> 6;
    bf16_t* xb = (bf16_t*)(p.ws + xb_off);
    const bf16_t* ye = (const bf16_t*)(p.ws + M_YE);
    const int* pos = (const int*)(p.ws + M_POS);
    float* aff = (float*)(p.ws + M_AFF);
    const int tstride = gridDim.x * 8;
    int tok = blockIdx.x * 8 + w;
    float4 nv[4]; int npos = -1;
    if (tok < T_ALL) {
#pragma unroll
        for (int k = 0; k < 4; ++k) nv[k] = *(const float4*)(p.out + (size_t)tok * 1024 + k * 256 + lane * 4);
        if (MODE_SRC == 1) npos = pos[(size_t)tok * 16 + (lane & 15)];
    }
    for (; tok < T_ALL; tok += tstride) {
        float* xr = p.out + (size_t)tok * 1024;
        float4 v[4];
#pragma unroll
        for (int k = 0; k < 4; ++k) v[k] = nv[k];
        const int cpos = npos;
        if (tok + tstride < T_ALL) {
#pragma unroll
            for (int k = 0; k < 4; ++k) nv[k] = *(const float4*)(p.out + (size_t)(tok + tstride) * 1024 + k * 256 + lane * 4);
            if (MODE_SRC == 1) npos = pos[(size_t)(tok + tstride) * 16 + (lane & 15)];
        }
        if (MODE_SRC == 1) {
#pragma unroll
            for (int k = 0; k < 4; ++k) { v[k].x *= ALPHA; v[k].y *= ALPHA; v[k].z *= ALPHA; v[k].w *= ALPHA; }
            const int trunk = tok >= T_PROMPT;
            const int cap = trunk ? CAP_S : CAP_P;
            const size_t rb = trunk ? (size_t)16 * CAP_P : 0;
            unsigned long long m = __ballot(cpos >= 0) & 0xffffull;
            while (m) {
                const int e0 = __builtin_ctzll(m); m &= m - 1;
                const int e1 = m ? __builtin_ctzll(m) : -1; if (m) m &= m - 1;
                const int p0 = __builtin_amdgcn_readlane(cpos, e0);
                const int p1 = __builtin_amdgcn_readlane(cpos, e1 >= 0 ? e1 : e0);
                const bf16_t* y0 = ye + (rb + (size_t)e0 * cap + p0) * 1024;
                const bf16_t* y1 = ye + (rb + (size_t)(e1 >= 0 ? e1 : e0) * cap + (e1 >= 0 ? p1 : p0)) * 1024;
                uint2 u0[4], u1[4];
#pragma unroll
                for (int k = 0; k < 4; ++k) { u0[k] = *(const uint2*)(y0 + k * 256 + lane * 4); u1[k] = *(const uint2*)(y1 + k * 256 + lane * 4); }
                const float s1 = (e1 >= 0) ? 1.f : 0.f;
#pragma unroll
                for (int k = 0; k < 4; ++k) {
                    v[k].x += bf_lo(u0[k].x); v[k].y += bf_hi(u0[k].x); v[k].z += bf_lo(u0[k].y); v[k].w += bf_hi(u0[k].y);
                    v[k].x += s1 * bf_lo(u1[k].x); v[k].y += s1 * bf_hi(u1[k].x); v[k].z += s1 * bf_lo(u1[k].y); v[k].w += s1 * bf_hi(u1[k].y);
                }
            }
        }
        float s = 0.f;
#pragma unroll
        for (int k = 0; k < 4; ++k) s += v[k].x + v[k].y + v[k].z + v[k].w;
        const float mu = wave_sum(s) * (1.f / 1024.f);
        float q = 0.f;
#pragma unroll
        for (int k = 0; k < 4; ++k) {
            v[k].x -= mu; v[k].y -= mu; v[k].z -= mu; v[k].w -= mu;
            q += v[k].x * v[k].x + v[k].y * v[k].y + v[k].z * v[k].z + v[k].w * v[k].w;
        }
        const float rstd = rsqrtf(wave_sum(q) * (1.f / 1024.f) + LN_EPS);
#pragma unroll
        for (int k = 0; k < 4; ++k) {
            const float4 g = *(const float4*)(gam + k * 256 + lane * 4);
            const float4 b = *(const float4*)(bet + k * 256 + lane * 4);
            v[k].x = v[k].x * rstd * g.x + b.x; v[k].y = v[k].y * rstd * g.y + b.y;
            v[k].z = v[k].z * rstd * g.z + b.z; v[k].w = v[k].w * rstd * g.w + b.w;
            *(float4*)(xr + k * 256 + lane * 4) = v[k];
            if (WRITE_XB) *(uint2*)(xb + (size_t)tok * 1024 + k * 256 + lane * 4) = make_uint2(pk_bf16(v[k].x, v[k].y), pk_bf16(v[k].z, v[k].w));
        }
        if (ROUTER) {
            float mylog = -1e30f;
#pragma unroll 2
            for (int e = 0; e < 16; ++e) {
                float a = 0.f;
#pragma unroll
                for (int k = 0; k < 4; ++k) {
                    const float4 wv = *(const float4*)(wrT + e * 1024 + k * 256 + lane * 4);
                    a += v[k].x * wv.x + v[k].y * wv.y + v[k].z * wv.z + v[k].w * wv.w;
                }
                a = wave_sum(a);
                if (lane == e) mylog = a;
            }
            const float mx = row16_max(mylog);
            const float ex = (lane < 16) ? expf(mylog - mx) : 0.f;
            const float mine = ex / row16_sum(ex);
            if (lane < 16) {
                const int trunk = tok >= T_PROMPT;
                const int tt = trunk ? T3 : T_PROMPT;
                const int tl = trunk ? tok - T_PROMPT : tok;
                aff[(trunk ? (size_t)T_PROMPT * 16 : 0) + (size_t)lane * tt + tl] = mine;
            }
        }
    }
    __syncthreads();
}

template <int NPT>
__device__ __forceinline__ void topk_item(const float* a, int cap, int* idx, float* gate, int* pos, int e, char* smem, const int TID) {
    int* part = (int*)smem;
    int* sh_cnt = (int*)(smem + 64);
    unsigned key[NPT];
#pragma unroll
    for (int k = 0; k < NPT; ++k) key[k] = __float_as_uint(a[k * NT + TID]);
    if (TID == 0) *sh_cnt = 0;
    const int lane = TID & 63, w = TID >> 6;
    u64 pref = 0ull;
    for (int bit = 45; bit >= 0; --bit) {
        const u64 cand = pref | (1ull << bit);
        const unsigned cb = (unsigned)(cand >> 15), ci = (unsigned)(cand & 32767ull);
        int c = 0;
        const int lim = 32767 - TID - (int)ci;
#pragma unroll
        for (int k = 0; k < NPT; ++k) c += (key[k] > cb || (key[k] == cb && k * NT <= lim)) ? 1 : 0;
#pragma unroll
        for (int o = 32; o > 0; o >>= 1) c += __shfl_xor(c, o, 64);
        int* pp = part + (bit & 1) * 8;
        if (lane == 0) pp[w] = c;
        __syncthreads();
        const int tot = pp[0] + pp[1] + pp[2] + pp[3] + pp[4] + pp[5] + pp[6] + pp[7];
        if (tot >= cap) pref = cand;
    }
    const unsigned cb = (unsigned)(pref >> 15), ci = (unsigned)(pref & 32767ull);
    int mine = 0;
    const int lim = 32767 - TID - (int)ci;
#pragma unroll
    for (int k = 0; k < NPT; ++k) mine += (key[k] > cb || (key[k] == cb && k * NT <= lim)) ? 1 : 0;
    int slot = atomicAdd(sh_cnt, mine);
    const float* ap = a + TID;
    int* pp = pos + (size_t)TID * 16 + e;
#pragma unroll 4
    for (int k = 0; k < NPT; ++k) {
        const float av = ap[(size_t)k * NT];
        const unsigned kb = __float_as_uint(av);
        const bool sel = (kb > cb || (kb == cb && k * NT <= lim));
        int ps = -1;
        if (sel) { ps = slot++; idx[ps] = k * NT + TID; gate[ps] = av; }
        pp[(size_t)k * (NT * 16)] = ps;
    }
    __syncthreads();
}
__device__ void topk_phase(const Params& p, char* smem, const int TID) {
    const float* aff = (const float*)(p.ws + M_AFF);
    int* idx = (int*)(p.ws + M_IDX);
    float* gate = (float*)(p.ws + M_GATE);
    int* pos = (int*)(p.ws + M_POS);
    for (int item = blockIdx.x; item < 32; item += gridDim.x) {
        const int trunk = item >> 4, e = item & 15;
        if (trunk == 0) topk_item<64>(aff + (size_t)e * T_PROMPT, CAP_P, idx + (size_t)e * CAP_P, gate + (size_t)e * CAP_P, pos, e, smem, TID);
        else topk_item<32>(aff + (size_t)T_PROMPT * 16 + (size_t)e * T3, CAP_S, idx + (size_t)16 * CAP_P + (size_t)e * CAP_S, gate + (size_t)16 * CAP_P + (size_t)e * CAP_S,
                           pos + (size_t)T_PROMPT * 16, e, smem, TID);
    }
}

typedef unsigned u32x2v __attribute__((ext_vector_type(2)));
__device__ __forceinline__ float xrow_max(float v) {
    u32x2v r = __builtin_amdgcn_permlane16_swap(__float_as_uint(v), __float_as_uint(v), false, false);
    v = fmaxf(__uint_as_float(r[0]), __uint_as_float(r[1]));
    r = __builtin_amdgcn_permlane32_swap(__float_as_uint(v), __float_as_uint(v), false, false);
    return fmaxf(__uint_as_float(r[0]), __uint_as_float(r[1]));
}
__device__ __forceinline__ float xrow_sum(float v) {
    u32x2v r = __builtin_amdgcn_permlane16_swap(__float_as_uint(v), __float_as_uint(v), false, false);
    v = __uint_as_float(r[0]) + __uint_as_float(r[1]);
    r = __builtin_amdgcn_permlane32_swap(__float_as_uint(v), __float_as_uint(v), false, false);
    return __uint_as_float(r[0]) + __uint_as_float(r[1]);
}

constexpr int NA_VSTR = 1936;
constexpr int NA_SK = 0, NA_SV = 61440, NA_SB = 61440 + 32 * NA_VSTR;
__device__ void na_phase(const Params& p, char* smem, const int TID) {
    const bf16_t* Qh = (const bf16_t*)(p.ws + N_Q);
    const bf16_t* Kh = (const bf16_t*)(p.ws + N_K);
    const bf16_t* NVt = (const bf16_t*)(p.ws + N_VT);
    bf16_t* O = (bf16_t*)(p.ws + M_XB2);
    char* sK = smem + NA_SK; char* sV = smem + NA_SV; float* sB = (float*)(smem + NA_SB);
    const int lane = TID & 63, w = TID >> 6, qi = lane & 15, hi = lane >> 4;
    for (int item = blockIdx.x; item < 96 * 32; item += gridDim.x) {
        const int h = item & 31, rgp = item >> 5;
        int seq_base, rows, g;
        if (rgp < 64) { seq_base = (rgp >> 2) * 2048; rows = 32; g = rgp & 3; }
        else { seq_base = T_PROMPT; rows = 256; g = rgp - 64; }
        const int r0 = g * 8;
        const int rs0 = min(max(r0 - 4, 0), rows - 8), rs1 = min(max(r0 + 3, 0), rows - 8);
        const int nrows = rs1 + 8 - rs0;
        __syncthreads();
        {
            const uint4* src = (const uint4*)(Kh + ((size_t)h * T_ALL + seq_base + rs0 * 64) * 32);
            const int nk16 = nrows * 256, nv16 = nrows * 8;
            uint4 kv[8], vv[8];
#pragma unroll
            for (int i = 0; i < 8; ++i) kv[i] = src[min(TID + i * NT, nk16 - 1)];
#pragma unroll
            for (int j = 0; j < 4; ++j) {
                const uint4* vs = (const uint4*)(NVt + (size_t)(h * 32 + w + 8 * j) * T_ALL + seq_base + rs0 * 64);
#pragma unroll
                for (int i = 0; i < 2; ++i) vv[j * 2 + i] = vs[min(lane + 64 * i, nv16 - 1)];
            }
#define NA_PIN4(v) asm volatile("" : "+v"((v).x), "+v"((v).y), "+v"((v).z), "+v"((v).w))
#pragma unroll
            for (int i = 0; i < 8; ++i) { NA_PIN4(kv[i]); NA_PIN4(vv[i]); }
#undef NA_PIN4
#pragma unroll
            for (int i = 0; i < 8; ++i) { const int c = TID + i * NT; if (c < nk16) ((uint4*)sK)[c] = kv[i]; }
#pragma unroll
            for (int j = 0; j < 4; ++j)
#pragma unroll
                for (int i = 0; i < 2; ++i) { const int c = lane + 64 * i; if (c < nv16) *(uint4*)(sV + (w + 8 * j) * NA_VSTR + c * 16) = vv[j * 2 + i]; }
            for (int c = TID; c < 465; c += NT) sB[c] = p.na_rpb[h * 465 + c] * 1.4426950408889634f;
        }
        __syncthreads();
        const int r = r0 + w;
        const int rs = min(max(r - 4, 0), rows - 8);
        const int lr0 = rs - rs0;
#pragma unroll 1
        for (int qb = 0; qb < 4; ++qb) {
            const int c = qb * 16 + qi;
            const int cs = min(max(c - 8, 0), 48);
            const int kb0 = min(max(qb - 1, 0), 1);
            const int tq = seq_base + r * 64 + c;
            const bf16x8 qf = *(const bf16x8*)(Qh + ((size_t)h * T_ALL + tq) * 32 + hi * 8);
            typedef float f32x2v __attribute__((ext_vector_type(2)));
            f32x2v s[24][2];
            f32x2v mk[3][2];
#pragma unroll
            for (int jb = 0; jb < 3; ++jb)
#pragma unroll
                for (int e = 0; e < 4; ++e) {
                    const int kcol = (kb0 + jb) * 16 + 4 * hi + e;
                    mk[jb][e >> 1][e & 1] = ((kcol >= cs) && (kcol < cs + 16)) ? 0.f : -1e30f;
                }
            float mx = -1e30f;
#pragma unroll
            for (int a = 0; a < 8; ++a)
#pragma unroll
                for (int jb = 0; jb < 3; ++jb) {
                    const int kcb = (kb0 + jb) * 16;
                    const bf16x8 kf = *(const bf16x8*)(sK + ((lr0 + a) * 64 + kcb + qi) * 64 + hi * 16);
                    f32x4 z = {0.f, 0.f, 0.f, 0.f};
                    const f32x4 sc = __builtin_amdgcn_mfma_f32_16x16x32_bf16(kf, qf, z, 0, 0, 0);
                    const float* rpr = sB + (rs + a - r + 7) * 31;
                    f32x2v bv[2];
#pragma unroll
                    for (int e = 0; e < 4; ++e) bv[e >> 1][e & 1] = rpr[min(max(kcb + 4 * hi + e - c + 15, 0), 30)];
                    const f32x2v v0 = (f32x2v){sc[0], sc[1]} + (bv[0] + mk[jb][0]);
                    const f32x2v v1 = (f32x2v){sc[2], sc[3]} + (bv[1] + mk[jb][1]);
                    s[a * 3 + jb][0] = v0; s[a * 3 + jb][1] = v1;
                    mx = fmaxf(fmaxf(mx, fmaxf(v0[0], v0[1])), fmaxf(v1[0], v1[1]));
                }
            mx = xrow_max(mx);
            const f32x2v mxv = {mx, mx};
            f32x2v sumv = {0.f, 0.f};
#pragma unroll
            for (int t = 0; t < 24; ++t)
#pragma unroll
                for (int hh = 0; hh < 2; ++hh) {
                    const f32x2v d = s[t][hh] - mxv;
                    f32x2v pv; pv[0] = __builtin_amdgcn_exp2f(d[0]); pv[1] = __builtin_amdgcn_exp2f(d[1]);
                    s[t][hh] = pv; sumv += pv;
                }
            const float inv = __builtin_amdgcn_rcpf(xrow_sum(sumv[0] + sumv[1]));
            const f32x2v invv = {inv, inv};
            f32x4 o0 = {0.f, 0.f, 0.f, 0.f}, o1 = {0.f, 0.f, 0.f, 0.f};
            const char* vr0 = sV + qi * NA_VSTR;
            const char* vr1 = sV + (16 + qi) * NA_VSTR;
#pragma unroll
            for (int pi = 0; pi < 12; ++pi) {
                const int t0 = 2 * pi, t1 = 2 * pi + 1;
                const int ka = ((lr0 + t0 / 3) * 64 + (kb0 + t0 % 3) * 16 + 4 * hi) * 2;
                const int kb = ((lr0 + t1 / 3) * 64 + (kb0 + t1 % 3) * 16 + 4 * hi) * 2;
                union { bf16x8 v; unsigned u[4]; } pf, v0, v1;
                const f32x2v q00 = s[t0][0] * invv, q01 = s[t0][1] * invv, q10 = s[t1][0] * invv, q11 = s[t1][1] * invv;
                pf.u[0] = pk_bf16(q00[0], q00[1]); pf.u[1] = pk_bf16(q01[0], q01[1]);
                pf.u[2] = pk_bf16(q10[0], q10[1]); pf.u[3] = pk_bf16(q11[0], q11[1]);
                const uint2 a0 = *(const uint2*)(vr0 + ka), b0 = *(const uint2*)(vr0 + kb);
                const uint2 a1 = *(const uint2*)(vr1 + ka), b1 = *(const uint2*)(vr1 + kb);
                v0.u[0] = a0.x; v0.u[1] = a0.y; v0.u[2] = b0.x; v0.u[3] = b0.y;
                v1.u[0] = a1.x; v1.u[1] = a1.y; v1.u[2] = b1.x; v1.u[3] = b1.y;
                o0 = __builtin_amdgcn_mfma_f32_16x16x32_bf16(pf.v, v0.v, o0, 0, 0, 0);
                o1 = __builtin_amdgcn_mfma_f32_16x16x32_bf16(pf.v, v1.v, o1, 0, 0, 0);
            }
#pragma unroll
            for (int e = 0; e < 4; ++e) {
                const int q = 4 * hi + e;
                bf16_t* dst = O + (size_t)(seq_base + r * 64 + qb * 16 + q) * 1024 + h * 32 + qi;
                dst[0] = f2bf(o0[e]);
                dst[16] = f2bf(o1[e]);
            }
        }
    }
}

#define XB_TMO      128
#define XB_XCNT(j)  (256  + 64 * (j))
#define XB_XSUB(j)  (1280 + 64 * (j))
#define XB_XGEN(j)  (2304 + 64 * (j))
#define XB_TOP      3328
#define XB_TOPGEN   3392
#define XCD_BAR_WORDS 3456
#define XB_SPIN_CAP (1u << 18)
__device__ __forceinline__ unsigned xb_ld(unsigned* p)              { return __hip_atomic_load(p, __ATOMIC_RELAXED, __HIP_MEMORY_SCOPE_AGENT); }
__device__ __forceinline__ unsigned xb_add(unsigned* p, unsigned v) { return __hip_atomic_fetch_add(p, v, __ATOMIC_RELAXED, __HIP_MEMORY_SCOPE_AGENT); }
__device__ __forceinline__ unsigned xb_xcc_id() { return (unsigned)__builtin_amdgcn_s_getreg((3 << 11) | 20) & 0xFu; }
#define XB_SPIN(cond, bar) do { unsigned _sp = 0; while (cond) { __builtin_amdgcn_s_sleep(1); \
    if ((++_sp & 255u) == 0u) { if (xb_ld(&(bar)[XB_TMO])) break; if (_sp > XB_SPIN_CAP) { atomicAdd(&(bar)[XB_TMO], 1u); break; } } } } while (0)
struct XcdBarrier { unsigned* bar; unsigned x; volatile LAS3 unsigned* st; };
__device__ __forceinline__ XcdBarrier xcd_barrier_post(unsigned* bar, volatile LAS3 unsigned* st, int tid) {
    XcdBarrier b; b.bar = bar; b.x = xb_xcc_id(); b.st = st;
    if (tid == 0) (void)xb_add(&bar[XB_XCNT(b.x)], 1u);
    return b;
}
__device__ __forceinline__ void xcd_barrier_complete(unsigned* bar, unsigned x, unsigned& nloc, unsigned& nx) {
    const unsigned G = gridDim.x * gridDim.y * gridDim.z;
    unsigned sum, cnt, mine, sp = 0u;
    for (;;) {
        sum = 0u; cnt = 0u; mine = 0u;
#pragma unroll
        for (unsigned j = 0; j < 16; ++j) { const unsigned c = xb_ld(&bar[XB_XCNT(j)]); sum += c; cnt += (c > 0u) ? 1u : 0u; mine = (j == x) ? c : mine; }
        if (sum == G) break;
        __builtin_amdgcn_s_sleep(1);
        if ((++sp & 255u) == 0u) { if (xb_ld(&bar[XB_TMO])) break; if (sp > XB_SPIN_CAP) { atomicAdd(&bar[XB_TMO], 1u); break; } }
    }
    nloc = mine > 0u ? mine : 1u; nx = cnt > 0u ? cnt : 1u;
}
__device__ __forceinline__ void xcd_barrier(const XcdBarrier& b, int tid) {
    asm volatile("s_waitcnt vmcnt(0)" ::: "memory");
    __syncthreads();
    if (tid == 0) {
        unsigned* bar = b.bar;
        __builtin_amdgcn_s_waitcnt(0);
        unsigned nloc = b.st[0], nx = b.st[1];
        if (nloc == 0u) { xcd_barrier_complete(bar, b.x, nloc, nx); b.st[0] = nloc; b.st[1] = nx; }
        const unsigned old = xb_add(&bar[XB_XSUB(b.x)], 1u);
        const unsigned gen = old / nloc;
        if (old + 1u == (gen + 1u) * nloc) {
            __builtin_amdgcn_fence(__ATOMIC_RELEASE, "agent");
            asm volatile("s_waitcnt vmcnt(0)" ::: "memory");
            const unsigned og = xb_add(&bar[XB_TOP], 1u);
            const unsigned tg = og / nx;
            if (og + 1u == (tg + 1u) * nx) xb_add(&bar[XB_TOPGEN], 1u);
            else XB_SPIN(xb_ld(&bar[XB_TOPGEN]) == tg, bar);
            __builtin_amdgcn_fence(__ATOMIC_ACQUIRE, "agent");
            xb_add(&bar[XB_XGEN(b.x)], 1u);
            asm volatile("s_waitcnt vmcnt(0)" ::: "memory");
        } else {
            XB_SPIN(xb_ld(&bar[XB_XGEN(b.x)]) == gen, bar);
            __builtin_amdgcn_fence(__ATOMIC_ACQUIRE, "agent");
            asm volatile("s_waitcnt vmcnt(0)" ::: "memory");
        }
    }
    __syncthreads();
}

__device__ __forceinline__ bool tile_map(int k, int MT, int NTN, int MS, int NS, int& m, int& n) {
    const int bid = blockIdx.x;
    if (gridDim.x != 256) { const int t = k * gridDim.x + bid; if (t >= MT * NTN) return false; m = t / NTN; n = t % NTN; return true; }
    const int NG = NTN / NS, total = (MT / MS) * NG;
    const int s = k * 8 + (bid & 7);
    if (s >= total) return false;
    const int j = bid >> 3;
    m = (s / NG) * MS + j / NS; n = (s % NG) * NS + j % NS;
    return true;
}

enum { PH_PRE = 0, PH_R0 = 1  , PH_LN0A = 16, PH_TOPK0, PH_MOE1_0, PH_MOE2_0, PH_LN0B, PH_QKV, PH_NA, PH_NAOUT, PH_LN1A, PH_TOPK1, PH_MOE1_1, PH_MOE2_1, PH_LN1B, PH_COUNT };

namespace pg8 {
#define PG8_LAS __attribute__((address_space(3)))
typedef unsigned short bf16_t;
typedef short bf16x8 __attribute__((ext_vector_type(8)));
typedef float f32x4 __attribute__((ext_vector_type(4)));
typedef unsigned u32x4 __attribute__((ext_vector_type(4)));
constexpr int BM = 256, BK = 64, HALF = 128, HTB = HALF * BK * 2  , STAGE_BYTES = 8 * HTB, NXCD = 8, WGM = 8;

__host__ __device__ __forceinline__ int lds_byte(int r, int c) { const int st = (r >> 4) * 2 + (c >> 5), rr = r & 15, cc = c & 31, ob = rr * 64 + cc * 2; return st * 1024 + (ob ^ (((ob >> 9) & 1) << 5)); }
__host__ __device__ __forceinline__ void stage_rc(int b, int& R, int& C) { const int st = b / 1024, sb = b % 1024, swz = sb ^ (((sb >> 9) & 1) << 5); R = (st >> 1) * 16 + swz / 64; C = (st & 1) * 32 + (swz % 64) / 2; }
__host__ __device__ __forceinline__ int perm32(int rho) { const int n = rho >> 4, i = rho & 15; return 8 * (i >> 2) + 4 * n + (i & 3); }

struct Unit { int pm, pn; };
struct Gemm { const bf16_t* A; const bf16_t* Bt; int M, N, K; };

template <class Epi, class Sched, bool STAMP = false>
__device__ __forceinline__ void gemm_phase(PG8_LAS unsigned char* lds, const Gemm g, const Sched& S, const Epi& E, unsigned long long* stamps, const int tid_in) {
    const int tid = tid_in, wid = __builtin_amdgcn_readfirstlane(tid >> 6), lane = tid & 63, wr = wid >> 2, wc = wid & 3, fr = lane & 15, fq = lane >> 4;
    const int K = g.K, nt = K / BK;
    int ts_lo = 0, ts_hi = 0, nts = 0; const unsigned long long rt_entry = STAMP ? (unsigned long long)wall_clock64() : 0ull;
#define PG8_STAMP() do { if (STAMP && wid == 0 && nts < 64) { const unsigned long long _c = (unsigned long long)clock64(); \
        ts_lo = (lane == nts) ? (int)(unsigned)_c : ts_lo; ts_hi = (lane == nts) ? (int)(unsigned)(_c >> 32) : ts_hi; ++nts; } } while (0)
    PG8_STAMP();
    unsigned voffA[2], voffB[2];
#pragma unroll
    for (int i = 0; i < 2; ++i) { int R, C; stage_rc(tid * 16 + i * 8192, R, C); const int Rb = Epi::PERM ? ((R & ~31) + perm32(R & 31)) : R;
        voffA[i] = (unsigned)(R * K + C) * 2u; voffB[i] = (unsigned)(Rb * K + C) * 2u; }
    const size_t kstep = (size_t)(BK * 2);
    const size_t hstep = (size_t)HALF * K * 2;
    const size_t tstep = 2 * hstep;
    const unsigned ldsw = (unsigned)wid * 1024u;
    const int aoff = lds_byte(wr * 64 + fr, fq * 8), boff = lds_byte(wc * 32 + fr, fq * 8);
#define PG8_SA(b, h) (((b) * 2 + (h)) * HTB)
#define PG8_SB(b, h) ((4 + (b) * 2 + (h)) * HTB)
#define PG8_STAGE(bufoff, gbase, voff) do { _Pragma("unroll") for (int _i = 0; _i < 2; ++_i) \
        __builtin_amdgcn_global_load_lds((const unsigned*)((const char*)(gbase) + (voff)[_i]), (PG8_LAS unsigned*)(lds + (bufoff) + ldsw + _i * 8192), 16, 0, 0); } while (0)
#define PG8_LDA(dst, b, h) do { _Pragma("unroll") for (int m = 0; m < 4; ++m) _Pragma("unroll") for (int k = 0; k < 2; ++k) dst[m][k] = *(const PG8_LAS bf16x8*)(lds + PG8_SA(b, h) + aoff + m * 2048 + k * 1024); } while (0)
#define PG8_LDB(dst, b, h) do { _Pragma("unroll") for (int n = 0; n < 2; ++n) _Pragma("unroll") for (int k = 0; k < 2; ++k) dst[n][k] = *(const PG8_LAS bf16x8*)(lds + PG8_SB(b, h) + boff + n * 2048 + k * 1024); } while (0)
#define PG8_MMA(ai, bj, At, Bt) do { __builtin_amdgcn_s_setprio(1); _Pragma("unroll") for (int m = 0; m < 4; ++m) _Pragma("unroll") for (int n = 0; n < 2; ++n) _Pragma("unroll") for (int k = 0; k < 2; ++k) \
        acc[ai][bj][m][n] = __builtin_amdgcn_mfma_f32_16x16x32_bf16(Bt[n][k], At[m][k], acc[ai][bj][m][n], 0, 0, 0); __builtin_amdgcn_s_setprio(0); } while (0)
#define PG8_WAIT_V(n) asm volatile("s_waitcnt vmcnt(" #n ")" ::: "memory")
#define PG8_WAIT_L(n) asm volatile("s_waitcnt lgkmcnt(" #n ")" ::: "memory")
#define PG8_BAR __builtin_amdgcn_s_barrier()
#define PG8_SCHED __builtin_amdgcn_sched_barrier(0)
    Unit cur, nxt; int ui = 0;
    if (!S.next(0, cur)) return;
    f32x4 acc[2][2][4][2];
#pragma unroll
    for (int a = 0; a < 2; ++a)
#pragma unroll
        for (int b = 0; b < 2; ++b)
#pragma unroll
            for (int m = 0; m < 4; ++m)
#pragma unroll
                for (int n = 0; n < 2; ++n) acc[a][b][m][n] = (f32x4){0.f, 0.f, 0.f, 0.f};
    bf16x8 At[4][2], B0[2][2], B1[2][2];
    const char* cA = (const char*)g.A + (size_t)cur.pm * tstep; const char* cB = (const char*)g.Bt + (size_t)cur.pn * tstep;
    S.a_ready(cur);
    PG8_STAGE(PG8_SB(0, 0), cB, voffB); PG8_STAGE(PG8_SA(0, 0), cA, voffA); PG8_STAGE(PG8_SB(0, 1), cB + hstep, voffB); PG8_STAGE(PG8_SA(0, 1), cA + hstep, voffA);
    if (wr == 1) PG8_BAR;
    PG8_WAIT_V(4); PG8_BAR;
    PG8_STAGE(PG8_SB(1, 0), cB + kstep, voffB); PG8_STAGE(PG8_SA(1, 0), cA + kstep, voffA); PG8_STAGE(PG8_SB(1, 1), cB + hstep + kstep, voffB);
    PG8_WAIT_V(6); PG8_BAR;
    PG8_STAMP();
    for (;;) {
        const bool has_next = S.next(ui + 1, nxt);
        const char* nA = has_next ? (const char*)g.A + (size_t)nxt.pm * tstep : cA; const char* nB = has_next ? (const char*)g.Bt + (size_t)nxt.pn * tstep : cB;
        for (int t = 0; t < nt; t += 2) {
            const bool last = (t == nt - 2);
            const char* a1 = cA + (size_t)(t + 1) * kstep;
            const char* a2 = last ? nA : cA + (size_t)(t + 2) * kstep; const char* b2 = last ? nB : cB + (size_t)(t + 2) * kstep;
            const char* a3 = a2 + kstep; const char* b3 = b2 + kstep;
            if (last && has_next) S.a_ready(nxt);
            PG8_LDB(B0, 0, 0); PG8_SCHED; PG8_LDA(At, 0, 0); PG8_STAGE(PG8_SA(1, 1), a1 + hstep, voffA);
            PG8_WAIT_L(8); PG8_BAR; PG8_WAIT_L(0); PG8_MMA(0, 0, At, B0); PG8_BAR; PG8_SCHED;
            PG8_LDB(B1, 0, 1); PG8_STAGE(PG8_SB(0, 0), b2, voffB);
            PG8_BAR; PG8_WAIT_L(0); PG8_MMA(0, 1, At, B1); PG8_BAR;
            PG8_LDA(At, 0, 1); PG8_STAGE(PG8_SA(0, 0), a2, voffA);
            PG8_BAR; PG8_WAIT_L(0); PG8_MMA(1, 0, At, B0); PG8_BAR; PG8_SCHED;
            PG8_STAGE(PG8_SB(0, 1), b2 + hstep, voffB);
            PG8_WAIT_V(6); PG8_BAR; PG8_MMA(1, 1, At, B1); PG8_BAR;
            PG8_LDB(B0, 1, 0); PG8_SCHED; PG8_LDA(At, 1, 0); PG8_STAGE(PG8_SA(0, 1), a2 + hstep, voffA);
            PG8_WAIT_L(8); PG8_BAR; PG8_WAIT_L(0); PG8_MMA(0, 0, At, B0); PG8_BAR; PG8_SCHED;
            PG8_LDB(B1, 1, 1); PG8_STAGE(PG8_SB(1, 0), b3, voffB);
            PG8_BAR; PG8_WAIT_L(0); PG8_MMA(0, 1, At, B1); PG8_BAR;
            PG8_LDA(At, 1, 1); PG8_STAGE(PG8_SA(1, 0), a3, voffA);
            PG8_BAR; PG8_WAIT_L(0); PG8_MMA(1, 0, At, B0); PG8_BAR; PG8_SCHED;
            PG8_STAGE(PG8_SB(1, 1), b3 + hstep, voffB);
            PG8_WAIT_V(6); PG8_BAR; PG8_MMA(1, 1, At, B1); PG8_BAR;
        }
        PG8_STAMP();
        if constexpr (!Epi::AFTER_DRAIN) { E(acc, cur, wr, wc, fr, fq); S.done(cur); }
        PG8_STAMP();
        if (!has_next) break;
#pragma unroll
        for (int a = 0; a < 2; ++a)
#pragma unroll
            for (int b = 0; b < 2; ++b)
#pragma unroll
                for (int m = 0; m < 4; ++m)
#pragma unroll
                    for (int n = 0; n < 2; ++n) acc[a][b][m][n] = (f32x4){0.f, 0.f, 0.f, 0.f};
        cur = nxt; cA = nA; cB = nB; ++ui;
    }
    PG8_WAIT_V(0);
    if (wr == 0) PG8_BAR;
    PG8_BAR;
    if constexpr (Epi::AFTER_DRAIN) { E.fused(acc, cur, wr, wc, fr, fq, lds, wid, lane); S.done(cur); }
    PG8_STAMP();
    if (STAMP && wid == 0) { stamps[lane] = lane < nts ? (((unsigned long long)(unsigned)ts_hi << 32) | (unsigned)ts_lo) : 0ull;
        if (lane == 62) stamps[62] = rt_entry; if (lane == 63) stamps[63] = (unsigned long long)wall_clock64(); }
#undef PG8_STAMP
#undef PG8_SA
#undef PG8_SB
#undef PG8_STAGE
#undef PG8_LDA
#undef PG8_LDB
#undef PG8_MMA
#undef PG8_WAIT_V
#undef PG8_WAIT_L
#undef PG8_BAR
#undef PG8_SCHED
}
template <class Epi, class Sched, bool STAMP = false>
__device__ __forceinline__ void gemm_phase_gather(PG8_LAS unsigned char* lds, const Gemm g, const Sched& S, const Epi& E, unsigned long long* stamps, const int tid_in, const int* gidx, int split_row, int split_add) {
    const int tid = tid_in, wid = __builtin_amdgcn_readfirstlane(tid >> 6), lane = tid & 63, wr = wid >> 2, wc = wid & 3, fr = lane & 15, fq = lane >> 4;
    const int K = g.K, nt = K / BK;
    int ts_lo = 0, ts_hi = 0, nts = 0; const unsigned long long rt_entry = STAMP ? (unsigned long long)wall_clock64() : 0ull;
#define PG8_STAMP() do { if (STAMP && wid == 0 && nts < 64) { const unsigned long long _c = (unsigned long long)clock64(); \
        ts_lo = (lane == nts) ? (int)(unsigned)_c : ts_lo; ts_hi = (lane == nts) ? (int)(unsigned)(_c >> 32) : ts_hi; ++nts; } } while (0)
    PG8_STAMP();
    unsigned voffA[2], voffB[2];
    int Rg[2], Cg[2];
#pragma unroll
    for (int i = 0; i < 2; ++i) { int R, C; stage_rc(tid * 16 + i * 8192, R, C); const int Rb = Epi::PERM ? ((R & ~31) + perm32(R & 31)) : R;
        voffA[i] = (unsigned)(R * K + C) * 2u; voffB[i] = (unsigned)(Rb * K + C) * 2u; Rg[i] = R; Cg[i] = C; }
    unsigned voffC[2][2], voffN[2][2];
#define PG8_GOFF(dst, unit) do { _Pragma("unroll") for (int _h = 0; _h < 2; ++_h) _Pragma("unroll") for (int _i = 0; _i < 2; ++_i) { \
        const int _r = (unit).pm * BM + _h * HALF + Rg[_i]; const int _src = gidx[_r] + (_r >= split_row ? split_add : 0); dst[_h][_i] = (unsigned)(_src * K + Cg[_i]) * 2u; } } while (0)
#define PG8_STAGE_A(bufoff, kbytes, VO, h) do { _Pragma("unroll") for (int _i = 0; _i < 2; ++_i) \
        __builtin_amdgcn_global_load_lds((const unsigned*)(cA + (kbytes) + (VO)[h][_i]), (PG8_LAS unsigned*)(lds + (bufoff) + ldsw + _i * 8192), 16, 0, 0); } while (0)
    const size_t kstep = (size_t)(BK * 2);
    const size_t hstep = (size_t)HALF * K * 2;
    const size_t tstep = 2 * hstep;
    const unsigned ldsw = (unsigned)wid * 1024u;
    const int aoff = lds_byte(wr * 64 + fr, fq * 8), boff = lds_byte(wc * 32 + fr, fq * 8);
#define PG8_SA(b, h) (((b) * 2 + (h)) * HTB)
#define PG8_SB(b, h) ((4 + (b) * 2 + (h)) * HTB)
#define PG8_STAGE(bufoff, gbase, voff) do { _Pragma("unroll") for (int _i = 0; _i < 2; ++_i) \
        __builtin_amdgcn_global_load_lds((const unsigned*)((const char*)(gbase) + (voff)[_i]), (PG8_LAS unsigned*)(lds + (bufoff) + ldsw + _i * 8192), 16, 0, 0); } while (0)
#define PG8_LDA(dst, b, h) do { _Pragma("unroll") for (int m = 0; m < 4; ++m) _Pragma("unroll") for (int k = 0; k < 2; ++k) dst[m][k] = *(const PG8_LAS bf16x8*)(lds + PG8_SA(b, h) + aoff + m * 2048 + k * 1024); } while (0)
#define PG8_LDB(dst, b, h) do { _Pragma("unroll") for (int n = 0; n < 2; ++n) _Pragma("unroll") for (int k = 0; k < 2; ++k) dst[n][k] = *(const PG8_LAS bf16x8*)(lds + PG8_SB(b, h) + boff + n * 2048 + k * 1024); } while (0)
#define PG8_MMA(ai, bj, At, Bt) do { __builtin_amdgcn_s_setprio(1); _Pragma("unroll") for (int m = 0; m < 4; ++m) _Pragma("unroll") for (int n = 0; n < 2; ++n) _Pragma("unroll") for (int k = 0; k < 2; ++k) \
        acc[ai][bj][m][n] = __builtin_amdgcn_mfma_f32_16x16x32_bf16(Bt[n][k], At[m][k], acc[ai][bj][m][n], 0, 0, 0); __builtin_amdgcn_s_setprio(0); } while (0)
#define PG8_WAIT_V(n) asm volatile("s_waitcnt vmcnt(" #n ")" ::: "memory")
#define PG8_WAIT_L(n) asm volatile("s_waitcnt lgkmcnt(" #n ")" ::: "memory")
#define PG8_BAR __builtin_amdgcn_s_barrier()
#define PG8_SCHED __builtin_amdgcn_sched_barrier(0)
    Unit cur, nxt; int ui = 0;
    if (!S.next(0, cur)) return;
    f32x4 acc[2][2][4][2];
#pragma unroll
    for (int a = 0; a < 2; ++a)
#pragma unroll
        for (int b = 0; b < 2; ++b)
#pragma unroll
            for (int m = 0; m < 4; ++m)
#pragma unroll
                for (int n = 0; n < 2; ++n) acc[a][b][m][n] = (f32x4){0.f, 0.f, 0.f, 0.f};
    bf16x8 At[4][2], B0[2][2], B1[2][2];
    const char* cA = (const char*)g.A; const char* cB = (const char*)g.Bt + (size_t)cur.pn * tstep;
    S.a_ready(cur);
    PG8_GOFF(voffC, cur);
    PG8_STAGE(PG8_SB(0, 0), cB, voffB); PG8_STAGE_A(PG8_SA(0, 0), 0, voffC, 0); PG8_STAGE(PG8_SB(0, 1), cB + hstep, voffB); PG8_STAGE_A(PG8_SA(0, 1), 0, voffC, 1);
    if (wr == 1) PG8_BAR;
    PG8_WAIT_V(4); PG8_BAR;
    PG8_STAGE(PG8_SB(1, 0), cB + kstep, voffB); PG8_STAGE_A(PG8_SA(1, 0), kstep, voffC, 0); PG8_STAGE(PG8_SB(1, 1), cB + hstep + kstep, voffB);
    PG8_WAIT_V(6); PG8_BAR;
    PG8_STAMP();
    for (;;) {
        const bool has_next = S.next(ui + 1, nxt);
        const char* nB = has_next ? (const char*)g.Bt + (size_t)nxt.pn * tstep : cB;
#pragma unroll
        for (int _h = 0; _h < 2; ++_h)
#pragma unroll
            for (int _i = 0; _i < 2; ++_i) voffN[_h][_i] = voffC[_h][_i];
        for (int t = 0; t < nt; t += 2) {
            const bool last = (t == nt - 2);
            const size_t kb1 = (size_t)(t + 1) * kstep;
            const size_t kb2 = last ? 0 : (size_t)(t + 2) * kstep; const char* b2 = last ? nB : cB + (size_t)(t + 2) * kstep;
            const size_t kb3 = kb2 + kstep; const char* b3 = b2 + kstep;
            if (last && has_next) { S.a_ready(nxt); PG8_GOFF(voffN, nxt); }
            unsigned v2[2][2];
#pragma unroll
            for (int _h = 0; _h < 2; ++_h)
#pragma unroll
                for (int _i = 0; _i < 2; ++_i) v2[_h][_i] = last ? voffN[_h][_i] : voffC[_h][_i];
            PG8_LDB(B0, 0, 0); PG8_SCHED; PG8_LDA(At, 0, 0); PG8_STAGE_A(PG8_SA(1, 1), kb1, voffC, 1);
            PG8_WAIT_L(8); PG8_BAR; PG8_WAIT_L(0); PG8_MMA(0, 0, At, B0); PG8_BAR; PG8_SCHED;
            PG8_LDB(B1, 0, 1); PG8_STAGE(PG8_SB(0, 0), b2, voffB);
            PG8_BAR; PG8_WAIT_L(0); PG8_MMA(0, 1, At, B1); PG8_BAR;
            PG8_LDA(At, 0, 1); PG8_STAGE_A(PG8_SA(0, 0), kb2, v2, 0);
            PG8_BAR; PG8_WAIT_L(0); PG8_MMA(1, 0, At, B0); PG8_BAR; PG8_SCHED;
            PG8_STAGE(PG8_SB(0, 1), b2 + hstep, voffB);
            PG8_WAIT_V(6); PG8_BAR; PG8_MMA(1, 1, At, B1); PG8_BAR;
            PG8_LDB(B0, 1, 0); PG8_SCHED; PG8_LDA(At, 1, 0); PG8_STAGE_A(PG8_SA(0, 1), kb2, v2, 1);
            PG8_WAIT_L(8); PG8_BAR; PG8_WAIT_L(0); PG8_MMA(0, 0, At, B0); PG8_BAR; PG8_SCHED;
            PG8_LDB(B1, 1, 1); PG8_STAGE(PG8_SB(1, 0), b3, voffB);
            PG8_BAR; PG8_WAIT_L(0); PG8_MMA(0, 1, At, B1); PG8_BAR;
            PG8_LDA(At, 1, 1); PG8_STAGE_A(PG8_SA(1, 0), kb3, v2, 0);
            PG8_BAR; PG8_WAIT_L(0); PG8_MMA(1, 0, At, B0); PG8_BAR; PG8_SCHED;
            PG8_STAGE(PG8_SB(1, 1), b3 + hstep, voffB);
            PG8_WAIT_V(6); PG8_BAR; PG8_MMA(1, 1, At, B1); PG8_BAR;
        }
        PG8_STAMP();
        if constexpr (!Epi::AFTER_DRAIN) { E(acc, cur, wr, wc, fr, fq); S.done(cur); }
        PG8_STAMP();
        if (!has_next) break;
#pragma unroll
        for (int a = 0; a < 2; ++a)
#pragma unroll
            for (int b = 0; b < 2; ++b)
#pragma unroll
                for (int m = 0; m < 4; ++m)
#pragma unroll
                    for (int n = 0; n < 2; ++n) acc[a][b][m][n] = (f32x4){0.f, 0.f, 0.f, 0.f};
        cur = nxt; cB = nB; ++ui;
#pragma unroll
        for (int _h = 0; _h < 2; ++_h)
#pragma unroll
            for (int _i = 0; _i < 2; ++_i) voffC[_h][_i] = voffN[_h][_i];
    }
    PG8_WAIT_V(0);
    if (wr == 0) PG8_BAR;
    PG8_BAR;
    if constexpr (Epi::AFTER_DRAIN) { E.fused(acc, cur, wr, wc, fr, fq, lds, wid, lane); S.done(cur); }
    PG8_STAMP();
    if (STAMP && wid == 0) { stamps[lane] = lane < nts ? (((unsigned long long)(unsigned)ts_hi << 32) | (unsigned)ts_lo) : 0ull;
        if (lane == 62) stamps[62] = rt_entry; if (lane == 63) stamps[63] = (unsigned long long)wall_clock64(); }
#undef PG8_STAMP
#undef PG8_SA
#undef PG8_SB
#undef PG8_STAGE
#undef PG8_STAGE_A
#undef PG8_GOFF
#undef PG8_LDA
#undef PG8_LDB
#undef PG8_MMA
#undef PG8_WAIT_V
#undef PG8_WAIT_L
#undef PG8_BAR
#undef PG8_SCHED
}
}

struct Pg8SchedMoe2 {
    __device__ bool next(int i, pg8::Unit& u) const {
        int tm, nt; if (!tile_map(i, 384, 4, 8, 4, tm, nt)) return false;
        const int e = (tm < 256) ? (tm >> 4) : ((tm - 256) >> 3);
        u.pm = tm; u.pn = e * 4 + nt; return true;
    }
    __device__ __forceinline__ void a_ready(const pg8::Unit&) const {}
    __device__ __forceinline__ void done(const pg8::Unit&) const {}
};
struct Pg8EpiMoe2 {
    static constexpr bool PERM = false, AFTER_DRAIN = false;
    const float* gate; bf16_t* Y;
    __device__ __forceinline__ void operator()(const pg8::f32x4 (&acc)[2][2][4][2], const pg8::Unit& u, int wr, int wc, int fr, int fq) const {
        const int row0 = u.pm * 256 + wr * 64 + fr, col0 = (u.pn & 3) * 256 + wc * 32 + 4 * fq;
        float gts[2][4];
#pragma unroll
        for (int ai = 0; ai < 2; ++ai)
#pragma unroll
            for (int m = 0; m < 4; ++m) gts[ai][m] = gate[row0 + ai * 128 + m * 16];
#pragma unroll
        for (int ai = 0; ai < 2; ++ai)
#pragma unroll
            for (int m = 0; m < 4; ++m) {
                const int row = row0 + ai * 128 + m * 16;
                const float gt = gts[ai][m];
                bf16_t* rowp = Y + (size_t)row * 1024 + col0;
#pragma unroll
                for (int bj = 0; bj < 2; ++bj)
#pragma unroll
                    for (int n = 0; n < 2; ++n) {
                        const pg8::f32x4 v = acc[ai][bj][m][n];
                        *(uint2*)(rowp + bj * 128 + n * 16) = make_uint2(pk_bf16(v[0] * gt, v[1] * gt), pk_bf16(v[2] * gt, v[3] * gt));
                    }
            }
    }
};

struct Pg8Sched {
    int MT, NTN, MS, NS, wid, nw;
    __device__ bool next(int i, pg8::Unit& u) const {
        if (nw == 256 && gridDim.x == 256) return tile_map(i, MT, NTN, MS, NS, u.pm, u.pn);
        if (wid < 0) return false;
        const int t = wid + i * nw; if (t >= MT * NTN) return false;
        u.pm = t / NTN; u.pn = t % NTN; return true;
    }
    __device__ __forceinline__ void a_ready(const pg8::Unit&) const {}
    __device__ __forceinline__ void done(const pg8::Unit&) const {}
};
struct Pg8EpiResid {
    static constexpr bool PERM = false, AFTER_DRAIN = false;
    const float* res; float* dst;
    __device__ __forceinline__ void operator()(const pg8::f32x4 (&acc)[2][2][4][2], const pg8::Unit& u, int wr, int wc, int fr, int fq) const {
        const int row0 = u.pm * 256 + wr * 64 + fr, col0 = u.pn * 256 + wc * 32 + 4 * fq;
#pragma unroll
        for (int ai = 0; ai < 2; ++ai)
#pragma unroll
            for (int mp = 0; mp < 2; ++mp) {
                float4 x[2][2][2];
#pragma unroll
                for (int mm = 0; mm < 2; ++mm)
#pragma unroll
                    for (int bj = 0; bj < 2; ++bj)
#pragma unroll
                        for (int n = 0; n < 2; ++n)
                            x[mm][bj][n] = *(const float4*)(res + (size_t)(row0 + ai * 128 + (mp * 2 + mm) * 16) * 1024 + col0 + bj * 128 + n * 16);
#pragma unroll
                for (int mm = 0; mm < 2; ++mm)
#pragma unroll
                    for (int bj = 0; bj < 2; ++bj)
#pragma unroll
                        for (int n = 0; n < 2; ++n) {
                            const pg8::f32x4 v = acc[ai][bj][mp * 2 + mm][n];
                            const float4 xx = x[mm][bj][n];
                            *(float4*)(dst + (size_t)(row0 + ai * 128 + (mp * 2 + mm) * 16) * 1024 + col0 + bj * 128 + n * 16) =
                                make_float4(ALPHA * xx.x + v[0], ALPHA * xx.y + v[1], ALPHA * xx.z + v[2], ALPHA * xx.w + v[3]);
                        }
            }
    }
};
struct Pg8EpiQK {
    static constexpr bool PERM = false, AFTER_DRAIN = false;
    char* ws;
    __device__ __forceinline__ void operator()(const pg8::f32x4 (&acc)[2][2][4][2], const pg8::Unit& u, int wr, int wc, int fr, int fq) const {
        const int n0 = u.pn * 256;
        bf16_t* dstb = (bf16_t*)(ws + ((n0 >> 10) ? N_K : N_Q));
        const int row0 = u.pm * 256 + wr * 64 + fr;
#pragma unroll
        for (int ai = 0; ai < 2; ++ai)
#pragma unroll
            for (int m = 0; m < 4; ++m) {
                const int tok = row0 + ai * 128 + m * 16;
#pragma unroll
                for (int bj = 0; bj < 2; ++bj) {
                    const int hh = ((n0 & 1023) + bj * 128 + wc * 32) >> 5;
#pragma unroll
                    for (int n = 0; n < 2; ++n) {
                        const pg8::f32x4 v = acc[ai][bj][m][n];
                        *(uint2*)(dstb + ((size_t)hh * T_ALL + tok) * 32 + n * 16 + 4 * fq) = make_uint2(pk_bf16(v[0], v[1]), pk_bf16(v[2], v[3]));
                    }
                }
            }
    }
};
struct Pg8EpiRows {
    static constexpr bool PERM = false, AFTER_DRAIN = false;
    bf16_t* O; size_t ldc;
    __device__ __forceinline__ void operator()(const pg8::f32x4 (&acc)[2][2][4][2], const pg8::Unit& u, int wr, int wc, int fr, int fq) const {
        const int row0 = u.pm * 256 + wr * 64 + fr, col0 = u.pn * 256 + wc * 32 + 4 * fq;
#pragma unroll
        for (int ai = 0; ai < 2; ++ai)
#pragma unroll
            for (int m = 0; m < 4; ++m) {
                bf16_t* rowp = O + (size_t)(row0 + ai * 128 + m * 16) * ldc + col0;
#pragma unroll
                for (int bj = 0; bj < 2; ++bj)
#pragma unroll
                    for (int n = 0; n < 2; ++n) {
                        const pg8::f32x4 v = acc[ai][bj][m][n];
                        *(uint2*)(rowp + bj * 128 + n * 16) = make_uint2(pk_bf16(v[0], v[1]), pk_bf16(v[2], v[3]));
                    }
            }
    }
};

struct Pg8EpiQKrot {
    static constexpr bool PERM = false, AFTER_DRAIN = false;
    char* ws; int smask;
    __device__ __forceinline__ void operator()(const pg8::f32x4 (&acc)[2][2][4][2], const pg8::Unit& u, int wr, int wc, int fr, int fq) const {
        const int n0 = u.pn * 256;
        const bool isk = (n0 >> 10) != 0;
        bf16_t* nat = (bf16_t*)(ws + (isk ? R_K : R_Q));
        bf16_t* Ktb = (bf16_t*)(ws + R_KT);
        const float2* rot = (const float2*)(ws + R_ROT);
        const int row0 = u.pm * 256 + wr * 64 + fr;
#pragma unroll
        for (int ai = 0; ai < 2; ++ai) {
            float4 csv[4][2][2];
#pragma unroll
            for (int m = 0; m < 4; ++m)
#pragma unroll
                for (int bj = 0; bj < 2; ++bj) {
                    const float2* rr = rot + (size_t)((row0 + ai * 128 + m * 16) & smask) * 128 + ((((n0 & 1023) + bj * 128 + wc * 32) & 255) >> 5) * 16 + 4 * fq;
                    csv[m][bj][0] = *(const float4*)(rr); csv[m][bj][1] = *(const float4*)(rr + 2);
                }
#pragma unroll
            for (int m = 0; m < 4; ++m) {
                const int tok = row0 + ai * 128 + m * 16;
#pragma unroll
                for (int bj = 0; bj < 2; ++bj) {
                    const int cb = (n0 & 1023) + bj * 128 + wc * 32;
                    const float4 cs01 = csv[m][bj][0], cs23 = csv[m][bj][1];
                    const pg8::f32x4 x1 = acc[ai][bj][m][0], x2 = acc[ai][bj][m][1];
                    const float o10 = x1[0] * cs01.x - x2[0] * cs01.y, o20 = x1[0] * cs01.y + x2[0] * cs01.x;
                    const float o11 = x1[1] * cs01.z - x2[1] * cs01.w, o21 = x1[1] * cs01.w + x2[1] * cs01.z;
                    const float o12 = x1[2] * cs23.x - x2[2] * cs23.y, o22 = x1[2] * cs23.y + x2[2] * cs23.x;
                    const float o13 = x1[3] * cs23.z - x2[3] * cs23.w, o23 = x1[3] * cs23.w + x2[3] * cs23.z;
                    const unsigned p10 = pk_bf16(o10, o11), p11 = pk_bf16(o12, o13), p20 = pk_bf16(o20, o21), p21 = pk_bf16(o22, o23);
                    bf16_t* dst = nat + (size_t)tok * 1024 + cb + 4 * fq;
                    *(uint2*)dst = make_uint2(p10, p11);
                    *(uint2*)(dst + 16) = make_uint2(p20, p21);
                    if (isk) {
                        bf16_t* kt = Ktb + ((size_t)(tok >> 7) * 1024 + cb + 4 * fq) * 128 + (tok & 127);
                        kt[0 * 128] = (bf16_t)(p10 & 0xffffu); kt[1 * 128] = (bf16_t)(p10 >> 16); kt[2 * 128] = (bf16_t)(p11 & 0xffffu); kt[3 * 128] = (bf16_t)(p11 >> 16);
                        kt[16 * 128] = (bf16_t)(p20 & 0xffffu); kt[17 * 128] = (bf16_t)(p20 >> 16); kt[18 * 128] = (bf16_t)(p21 & 0xffffu); kt[19 * 128] = (bf16_t)(p21 >> 16);
                    }
                }
            }
        }
    }
};
struct Pg8EpiVtBlk {
    static constexpr bool PERM = false, AFTER_DRAIN = false;
    bf16_t* Vt;
    __device__ __forceinline__ void operator()(const pg8::f32x4 (&acc)[2][2][4][2], const pg8::Unit& u, int wr, int wc, int fr, int fq) const {
        const int row0 = u.pm * 256 + wr * 64 + fr, col0 = u.pn * 256 + wc * 32 + 4 * fq;
#pragma unroll
        for (int ai = 0; ai < 2; ++ai)
#pragma unroll
            for (int m = 0; m < 4; ++m) {
                const int row = row0 + ai * 128 + m * 16;
#pragma unroll
                for (int bj = 0; bj < 2; ++bj)
#pragma unroll
                    for (int n = 0; n < 2; ++n) {
                        const int tok0 = col0 + bj * 128 + n * 16;
                        const pg8::f32x4 v = acc[ai][bj][m][n];
                        *(uint2*)(Vt + ((size_t)(tok0 >> 7) * 2048 + row) * 128 + (tok0 & 127)) = make_uint2(pk_bf16(v[0], v[1]), pk_bf16(v[2], v[3]));
                    }
            }
    }
};

struct Pg8SchedMoe1 {
    __device__ bool next(int i, pg8::Unit& u) const {
        int tm, nt;
        if (gridDim.x == 256) { if (!tile_map(i, 384, 8, 4, 8, tm, nt)) return false; }
        else { const int t = blockIdx.x + i * gridDim.x; if (t >= 384 * 8) return false; tm = t >> 3; nt = t & 7; }
        const int e = (tm < 256) ? (tm >> 4) : ((tm - 256) >> 3);
        u.pm = tm; u.pn = e * 8 + nt; return true;
    }
    __device__ __forceinline__ void a_ready(const pg8::Unit&) const {}
    __device__ __forceinline__ void done(const pg8::Unit&) const {}
};
struct Pg8EpiMoe1 {
    static constexpr bool PERM = false, AFTER_DRAIN = false;
    bf16_t* H;
    __device__ __forceinline__ void operator()(const pg8::f32x4 (&acc)[2][2][4][2], const pg8::Unit& u, int wr, int wc, int fr, int fq) const {
        const int row0 = u.pm * 256 + wr * 64 + fr, f0 = (u.pn & 7) * 128 + wc * 16 + 4 * fq;
#pragma unroll
        for (int ai = 0; ai < 2; ++ai)
#pragma unroll
            for (int m = 0; m < 4; ++m) {
                bf16_t* rowp = H + (size_t)(row0 + ai * 128 + m * 16) * 1024 + f0;
#pragma unroll
                for (int bj = 0; bj < 2; ++bj) {
                    const pg8::f32x4 gt = acc[ai][bj][m][0], up = acc[ai][bj][m][1];
                    *(uint2*)(rowp + bj * 64) = make_uint2(pk_bf16(silu_f(gt[0]) * up[0], silu_f(gt[1]) * up[1]), pk_bf16(silu_f(gt[2]) * up[2], silu_f(gt[3]) * up[3]));
                }
            }
    }
};

__device__ __forceinline__ void g5_tiles(const Params& p, int th, char* smem, const int TID, int wid, int nw) {
    char* ws = p.ws;
    const float* xin = (th < 2) ? (p.x_prompt + (size_t)th * T3 * 1024) : p.x_sample;
    pg8::Gemm g; g.A = (const bf16_t*)(ws + R_O); g.Bt = (const bf16_t*)(ws + R_WOUT); g.M = T3; g.N = 1024; g.K = 2048;
    Pg8Sched S; S.MT = 64; S.NTN = 4; S.MS = 8; S.NS = 4; S.wid = wid; S.nw = nw;
    Pg8EpiResid E; E.res = xin; E.dst = p.out + (size_t)th * T3 * 1024;
    pg8::gemm_phase<Pg8EpiResid, Pg8Sched, false>((LAS3 unsigned char*)smem, g, S, E, nullptr, TID);
}

#ifndef ONLY
#define EN(k) 1
#else
#define EN(k) (ONLY == (k))
#endif
__device__ void run_phase(const Params& p, int ph, char* smem, const int TID) {
    const int bid = blockIdx.x, G = gridDim.x;
    char* ws = p.ws;
    if (EN(0) && ph == PH_PRE) {
        int rot = 0;
        convert_matrix(p.ret_w_in, nullptr, 6144, (bf16_t*)(ws + R_WIN), 6144, 1024, 1, smem, rot, TID, bid, G);
        convert_matrix(p.ret_w_out, nullptr, 1024, (bf16_t*)(ws + R_WOUT), 1024, 2048, 0, smem, rot, TID, bid, G);
        for (int th = 0; th < 3; ++th) {
            const float* xs = (th < 2) ? (p.x_prompt + (size_t)th * T3 * 1024) : p.x_sample;
            bf16_t* xd = (bf16_t*)(p.out + (size_t)th * T3 * 1024);
            for (size_t i = (size_t)bid * NT + TID; i < (size_t)T3 * 1024 / 8; i += (size_t)G * NT) {
                const float4 a = ((const float4*)xs)[2 * i], b = ((const float4*)xs)[2 * i + 1];
                ((uint4*)xd)[i] = make_uint4(pk_bf16(a.x, a.y), pk_bf16(a.z, a.w), pk_bf16(b.x, b.y), pk_bf16(b.z, b.w));
            }
        }
#ifdef PROBE_NULLGEMM
        {
            __syncthreads();
            const unsigned long long t0 = wall_clock64();
            PolNull pn; pn.sink = (float*)(ws + R_O);
            gemm_core<PolNull, C256, true>(pn, smem, 1024, TID);
            __syncthreads();
            const unsigned long long t1 = wall_clock64();
            if (bid == 0 && TID == 0) *(unsigned long long*)(ws + R_O + 64) = t1 - t0;
        }
#endif
#ifdef PROBE_SCANTEST
        for (int var = 0; var < 2; ++var) {
            __syncthreads();
            const unsigned long long t0 = wall_clock64();
            if (bid < 64) {
                const int dkt = bid & 1, dvt = (bid >> 1) & 3, dir = (bid >> 3) & 1, h = (bid >> 4) & 3;
                if (var == 0) {
                    PolUscanT<false, true> pol;
                    pol.A = (const bf16_t*)(ws + R_VT) + ((size_t)h * 512 + dvt * 128) * 128; pol.B = (const bf16_t*)(ws + R_KT) + ((size_t)h * 256 + dkt * 128) * 128;
                    pol.UR = (bf16_t*)(ws + R_UR) + (size_t)dir * (128ull * 4 * 512 * 256) + (size_t)h * (512 * 256) + (size_t)(dvt * 128) * 256 + dkt * 128;
                    pol.nc = 128; pol.dir = dir; pol.lg = -0.01f; pol.dec = 0.5f; pol.st = 1.001f; pol.st2 = 1.002f;
                    gemm_core<PolUscanT<false, true>, C128, false>(pol, smem, 256, TID);
                } else {
                    PolUscanT<true, false> pol;
                    pol.A = (const bf16_t*)(ws + R_VT) + ((size_t)h * 512 + dvt * 128) * 128; pol.B = (const bf16_t*)(ws + R_KT) + ((size_t)h * 256 + dkt * 128) * 128;
                    pol.UR = (bf16_t*)(ws + R_UR) + (size_t)dir * (128ull * 4 * 512 * 256) + (size_t)h * (512 * 256) + (size_t)(dvt * 128) * 256 + dkt * 128;
                    pol.nc = 128; pol.dir = dir; pol.lg = -0.01f; pol.dec = 0.5f; pol.st = 1.001f; pol.st2 = 1.002f;
                    gemm_core<PolUscanT<true, false>, C128, false>(pol, smem, 256, TID);
                }
            }
            __syncthreads();
            const unsigned long long t1 = wall_clock64();
            if (bid == 0 && TID == 0) ((unsigned long long*)(ws + R_END - 64))[var] = (var ? 4 : 1) * (t1 - t0);
        }
#endif
#ifdef PROBE_LOADTEST
        for (int var = 0; var < 2; ++var) {
            __syncthreads();
            const unsigned long long t0 = wall_clock64();
            const int lda = var ? 1024 : 1088;
            for (int k = 0, tm, nt; tile_map(k, 384, 4, 8, 4, tm, nt); ++k) {
                PolLoadTest pol; pol.lda = lda; pol.sink = (float*)(ws + M_AFF);
                pol.A = (const bf16_t*)(ws + M_H) + (size_t)(tm * 256) * lda;
                pol.B = (const bf16_t*)(ws + M_WGU) + (size_t)((tm >> 4) * 1024 + nt * 256) * lda;
                gemm_core<PolLoadTest, C256, true, 1, true>(pol, smem, 16, TID);
            }
            __syncthreads();
            const unsigned long long t1 = wall_clock64();
            if (bid == 0 && TID == 0) ((unsigned long long*)(ws + M_AFF + 1024))[var] = t1 - t0;
        }
#endif
        float2* rt = (float2*)(ws + R_ROT);
        for (int i = bid * NT + TID; i < 16384 * 128; i += G * NT) {
            const int s = i >> 7, fi = i & 127;
            const float inv = exp2f(-(float)fi * (13.287712379549449f / 128.0f));
            const float ang = (float)s * inv;
            const double rev = (double)ang * 0.15915494309189535;
            const float fr = (float)(rev - (double)(long long)(rev + 0.5));
            rt[i] = make_float2(__builtin_amdgcn_cosf(fr), __builtin_amdgcn_sinf(fr));
        }
        return;
    }
    if (ph >= PH_R0 && ph < PH_R0 + 15) {
        const int th = (ph - PH_R0) / 5, sub = (ph - PH_R0) % 5;
        const int nseq = (th < 2) ? 8 : 1, nc = (th < 2) ? 16 : 128, smask = (th < 2) ? 2047 : 16383;
        const float* xin = (th < 2) ? (p.x_prompt + (size_t)th * T3 * 1024) : p.x_sample;
        if (EN(1) && sub == 0) {
            const bf16_t* xbt = (const bf16_t*)(p.out + (size_t)th * T3 * 1024);
            const bf16_t* Wt = (const bf16_t*)(ws + R_WIN);
            {
                pg8::Gemm g; g.A = xbt; g.Bt = Wt; g.M = T3; g.N = 2048; g.K = 1024;
                Pg8Sched S; S.MT = 64; S.NTN = 8; S.MS = 4; S.NS = 8; S.wid = bid; S.nw = G;
                Pg8EpiQKrot E; E.ws = ws; E.smask = smask;
                pg8::gemm_phase<Pg8EpiQKrot, Pg8Sched, false>((LAS3 unsigned char*)smem, g, S, E, nullptr, TID);
            }
            {
                pg8::Gemm g; g.A = Wt + (size_t)2048 * 1024; g.Bt = xbt; g.M = 2048; g.N = T3; g.K = 1024;
                Pg8Sched S; S.MT = 8; S.NTN = 64; S.MS = 4; S.NS = 8; S.wid = bid; S.nw = G;
                Pg8EpiVtBlk E; E.Vt = (bf16_t*)(ws + R_VT);
                pg8::gemm_phase<Pg8EpiVtBlk, Pg8Sched, false>((LAS3 unsigned char*)smem, g, S, E, nullptr, TID);
            }
            {
                pg8::Gemm g; g.A = xbt; g.Bt = Wt + (size_t)4096 * 1024; g.M = T3; g.N = 2048; g.K = 1024;
                Pg8Sched S; S.MT = 64; S.NTN = 8; S.MS = 4; S.NS = 8; S.wid = bid; S.nw = G;
                Pg8EpiRows E; E.O = (bf16_t*)(ws + R_G); E.ldc = 2048;
                pg8::gemm_phase<Pg8EpiRows, Pg8Sched, false>((LAS3 unsigned char*)smem, g, S, E, nullptr, TID);
            }
            if (th == 1 && G == 256 && EN(5)) g5_tiles(p, 0, smem, TID, bid, G);
        } else if (EN(2) && sub == 1) {
            const int nscan = nseq * 4 * 2 * 8;
            const int nscore = NCH3 * 4;
            const int ncr = nc / 2;
            if (th == 2 && G == 256 && EN(5)) g5_tiles(p, 1, smem, TID, bid - 64, 192);
            for (int t = bid; t < nscan + nscore; ) {
                if (t < nscan) {
                    int u = t;
                    if (G == 256) {
                        const int k = t >> 8, b = t & 255, x = b & 7, sl = b >> 3;
                        if (nscan >= 256) u = ((k * 32 + x * 4 + (sl >> 3)) << 3) | (sl & 7);
                        else u = (x << 3) | sl;
                    }
                    const int dkt = u & 1; u >>= 1; const int dvt = u & 3; u >>= 2; const int dir = u & 1; u >>= 1; const int h = u & 3; u >>= 2; const int seq = u;
                    PolUscan pol;
                    pol.A = (const bf16_t*)(ws + R_VT) + ((size_t)(seq * nc) * 2048 + h * 512 + dvt * 128) * 128;
                    pol.B = (const bf16_t*)(ws + R_KT) + ((size_t)(seq * nc) * 1024 + h * 256 + dkt * 128) * 128;
                    pol.UR = (bf16_t*)(ws + R_UR) + (size_t)dir * ((size_t)NCH3 * 4 * 512 * 256) + (size_t)(seq * ncr) * (4ull * 512 * 256) + (size_t)h * (512 * 256) + (size_t)(dvt * 128) * 256 + dkt * 128;
                    pol.nc = ncr; pol.dir = dir;
                    pol.lg = log2_sigmoid(p.ret_decay[dir * 4 + h]);
                    pol.dec = exp2f(pol.lg * (float)RC);
                    pol.st = exp2f(dir ? pol.lg : -pol.lg); pol.st2 = pol.st * pol.st;
                    gemm_core<PolUscan, C128, false>(pol, smem, ncr * 4, TID);
                } else {
                    const int u = t - nscan; const int h = u & 3, cgi = u >> 2;
                    PolScore pol;
                    pol.A = (const bf16_t*)(ws + R_Q) + (size_t)(cgi * RC) * 1024 + h * 256;
                    pol.B = (const bf16_t*)(ws + R_K) + (size_t)(cgi * RC) * 1024 + h * 256;
                    pol.P = (bf16_t*)(ws + R_P) + (size_t)((cgi * 4 + h) * RC) * RC;
                    pol.lgf = log2_sigmoid(p.ret_decay[h]); pol.lgb = log2_sigmoid(p.ret_decay[4 + h]); pol.smem = smem;
                    gemm_core<PolScore, C256, false, 1>(pol, smem, 4, TID);
                }
                if (th == 2 && G == 256) t = (t == bid && bid >= 64 && bid < 128) ? bid + 192 : nscan + nscore;
                else t += G;
            }
        } else if (EN(3) && sub == 2) {
            for (int t = bid; t < NCH3 * 2 * 4 * 2; t += G) {
                int u = t;
                if (G == 256) { const int k = t >> 8, b = t & 255, x = b & 7, sl = b >> 3; u = ((k * 64 + x * 8 + (sl >> 2)) << 2) | (sl & 3); }
                const int dvt = u & 1, half = (u >> 1) & 1, h = (u >> 2) & 3, cgi = u >> 4;
                PolO pol;
                pol.half = half;
                pol.Pp = (const bf16_t*)(ws + R_P) + (size_t)((cgi * 4 + h) * RC + half * 128) * RC;
                pol.Qp = (const bf16_t*)(ws + R_Q) + (size_t)(cgi * RC + half * 128) * 1024 + h * 256;
                pol.Vp = (const bf16_t*)(ws + R_VT) + ((size_t)(cgi * 2) * 2048 + h * 512 + dvt * 256) * 128;
                const size_t ro = (size_t)cgi * (4ull * 512 * 256) + (size_t)h * (512 * 256) + (size_t)(dvt * 256) * 256;
                pol.Rf = (const bf16_t*)(ws + R_UR) + ro;
                pol.Rb = (const bf16_t*)(ws + R_UR) + (size_t)NCH3 * 4 * 512 * 256 + ro;
                pol.O = (bf16_t*)(ws + R_O) + (size_t)(cgi * RC + half * 128) * 2048 + h * 512 + dvt * 256;
                pol.lgf = log2_sigmoid(p.ret_decay[h]); pol.lgb = log2_sigmoid(p.ret_decay[4 + h]);
                gemm_core<PolO, CO, false>(pol, smem, 12, TID);
            }
        } else if (EN(4) && sub == 3) {
            const int lane = TID & 63, w = TID >> 6;
            bf16_t* O = (bf16_t*)(ws + R_O); const bf16_t* Gb = (const bf16_t*)(ws + R_G);
            int it = bid * 8 + w;
            uint4 nov = make_uint4(0, 0, 0, 0), ngv = nov;
            if (it < T3 * 4) { nov = *(const uint4*)(O + (size_t)it * 512 + lane * 8); ngv = *(const uint4*)(Gb + (size_t)it * 512 + lane * 8); }
            for (; it < T3 * 4; it += G * 8) {
                const size_t off = (size_t)it * 512 + lane * 8;
                const uint4 ov = nov, gv = ngv;
                if (it + G * 8 < T3 * 4) { nov = *(const uint4*)(O + off + (size_t)G * 8 * 512); ngv = *(const uint4*)(Gb + off + (size_t)G * 8 * 512); }
                float y[8] = {bf_lo(ov.x), bf_hi(ov.x), bf_lo(ov.y), bf_hi(ov.y), bf_lo(ov.z), bf_hi(ov.z), bf_lo(ov.w), bf_hi(ov.w)};
                const float g[8] = {bf_lo(gv.x), bf_hi(gv.x), bf_lo(gv.y), bf_hi(gv.y), bf_lo(gv.z), bf_hi(gv.z), bf_lo(gv.w), bf_hi(gv.w)};
                float s = 0.f;
#pragma unroll
                for (int e = 0; e < 8; ++e) s += y[e];
                const float mu = wave_sum(s) * (1.f / 512.f);
                float q = 0.f;
#pragma unroll
                for (int e = 0; e < 8; ++e) { y[e] -= mu; q += y[e] * y[e]; }
                const float rstd = rsqrtf(wave_sum(q) * (1.f / 512.f) + GN_EPS);
#pragma unroll
                for (int e = 0; e < 8; ++e) y[e] = y[e] * rstd * silu_f(g[e]);
                *(uint4*)(O + off) = make_uint4(pk_bf16(y[0], y[1]), pk_bf16(y[2], y[3]), pk_bf16(y[4], y[5]), pk_bf16(y[6], y[7]));
            }
        } else if (EN(5) && sub == 4) {
            if (th == 2 || G != 256) g5_tiles(p, th, smem, TID, bid, G);
        }
        return;
    }
    if (EN(6) && (ph == PH_LN0A || ph == PH_LN1A)) {
        const int L = (ph == PH_LN1A);
        ln_phase<0, true, true>(p, p.ln_mix_g + L * 1024, p.ln_mix_b + L * 1024, p.w_router + (size_t)L * 1024 * 16, M_XB, smem, TID);
        return;
    }
    if (EN(7) && (ph == PH_TOPK0 || ph == PH_TOPK1)) {
        const int L = (ph == PH_TOPK1);
        topk_phase(p, smem, TID);
        const int wid = (G > 64) ? bid - 32 : bid, nw = (G > 64) ? G - 32 : G;
        int rot = 0;
        for (int e = 0; e < 16; ++e) {
            const size_t wo = ((size_t)L * 16 + e) * 1024 * 1024;
            convert_matrix(p.w_gate + wo, p.w_up + wo, 1024, (bf16_t*)(ws + M_WGU) + (size_t)e * 2048 * 1024, 2048, 1024, 2, smem, rot, TID, wid, nw);
            convert_matrix(p.w_down + wo, nullptr, 1024, (bf16_t*)(ws + M_WD) + (size_t)e * 1024 * 1024, 1024, 1024, 0, smem, rot, TID, wid, nw);
        }
        if (!L) {
            convert_matrix(p.na_w_in, nullptr, 3072, (bf16_t*)(ws + M_NWIN), 3072, 1024, 3, smem, rot, TID, wid, nw);
            convert_matrix(p.na_w_out, nullptr, 1024, (bf16_t*)(ws + M_NWOUT), 1024, 1024, 0, smem, rot, TID, wid, nw);
        }
        return;
    }
    if (EN(8) && (ph == PH_MOE1_0 || ph == PH_MOE1_1)) {
        pg8::Gemm g; g.A = (const bf16_t*)(ws + M_XB); g.Bt = (const bf16_t*)(ws + M_WGU); g.M = 2 * T_ALL; g.N = 16 * 2048; g.K = 1024;
        Pg8SchedMoe1 S; Pg8EpiMoe1 E; E.H = (bf16_t*)(ws + M_H);
        pg8::gemm_phase_gather<Pg8EpiMoe1, Pg8SchedMoe1, false>((LAS3 unsigned char*)smem, g, S, E, nullptr, TID, (const int*)(ws + M_IDX), 16 * CAP_P, T_PROMPT);
        return;
    }
    if (EN(9) && (ph == PH_MOE2_0 || ph == PH_MOE2_1)) {
        if (G == 256) {
            pg8::Gemm g; g.A = (const bf16_t*)(ws + M_H); g.Bt = (const bf16_t*)(ws + M_WD); g.M = 2 * T_ALL; g.N = 16 * 1024; g.K = 1024;
            Pg8SchedMoe2 S; Pg8EpiMoe2 E; E.gate = (const float*)(ws + M_GATE); E.Y = (bf16_t*)(ws + M_YE);
            pg8::gemm_phase<Pg8EpiMoe2, Pg8SchedMoe2, false>((LAS3 unsigned char*)smem, g, S, E, nullptr, TID);
            return;
        }
        for (int k = 0, tm, nt; tile_map(k, 384, 4, 8, 4, tm, nt); ++k) {
            int trunk, e, mt;
            if (tm < 256) { trunk = 0; mt = tm & 15; e = tm >> 4; }
            else { const int u = tm - 256; trunk = 1; mt = u & 7; e = u >> 3; }
            const int cap = trunk ? CAP_S : CAP_P;
            const size_t rb = (trunk ? (size_t)16 * CAP_P : 0) + (size_t)e * cap + mt * 256;
            PolMoe2 pol;
            pol.A = (const bf16_t*)(ws + M_H) + rb * 1024;
            pol.B = (const bf16_t*)(ws + M_WD) + ((size_t)e * 1024 + nt * 256) * 1024;
            pol.gate = (const float*)(ws + M_GATE) + rb;
            pol.Y = (bf16_t*)(ws + M_YE) + rb * 1024 + nt * 256;
            gemm_core_dma<PolMoe2, C256, false>(pol, smem, 16, TID);
        }
        return;
    }
    if (EN(10) && ph == PH_LN0B) { ln_phase<1, true, false>(p, p.ln_ffn_g, p.ln_ffn_b, nullptr, M_XB2, smem, TID); return; }
    if (EN(10) && ph == PH_LN1B) { ln_phase<1, false, false>(p, p.ln_ffn_g + 1024, p.ln_ffn_b + 1024, nullptr, M_XB2, smem, TID); return; }
    if (EN(11) && ph == PH_QKV) {
        {
            pg8::Gemm g; g.A = (const bf16_t*)(ws + M_XB2); g.Bt = (const bf16_t*)(ws + M_NWIN); g.M = T_ALL; g.N = 2048; g.K = 1024;
            Pg8Sched S; S.MT = 192; S.NTN = 8; S.MS = 4; S.NS = 8; S.wid = bid; S.nw = G;
            Pg8EpiQK E; E.ws = ws;
            pg8::gemm_phase<Pg8EpiQK, Pg8Sched, false>((LAS3 unsigned char*)smem, g, S, E, nullptr, TID);
        }
        {
            pg8::Gemm g; g.A = (const bf16_t*)(ws + M_NWIN) + (size_t)2048 * 1024; g.Bt = (const bf16_t*)(ws + M_XB2); g.M = 1024; g.N = T_ALL; g.K = 1024;
            Pg8Sched S; S.MT = 4; S.NTN = 192; S.MS = 4; S.NS = 8; S.wid = bid; S.nw = G;
            Pg8EpiRows E; E.O = (bf16_t*)(ws + N_VT); E.ldc = T_ALL;
            pg8::gemm_phase<Pg8EpiRows, Pg8Sched, false>((LAS3 unsigned char*)smem, g, S, E, nullptr, TID);
        }
        return;
    }
    if (EN(12) && ph == PH_NA) { na_phase(p, smem, TID); return; }
    if (EN(13) && ph == PH_NAOUT) {
        pg8::Gemm g; g.A = (const bf16_t*)(ws + M_XB2); g.Bt = (const bf16_t*)(ws + M_NWOUT); g.M = T_ALL; g.N = 1024; g.K = 1024;
        Pg8Sched S; S.MT = 192; S.NTN = 4; S.MS = 8; S.NS = 4; S.wid = bid; S.nw = G;
        Pg8EpiResid E; E.res = p.out; E.dst = p.out;
        pg8::gemm_phase<Pg8EpiResid, Pg8Sched, false>((LAS3 unsigned char*)smem, g, S, E, nullptr, TID);
        return;
    }
}

__device__ __forceinline__ int lane_id_opaque() {
    int l;
    asm volatile("v_mbcnt_lo_u32_b32 %0, -1, 0\n\tv_mbcnt_hi_u32_b32 %0, -1, %0" : "=v"(l));
    return l;
}

__global__ void __launch_bounds__(512, 2) fwd_megakernel(Params p) {
    extern __shared__ __attribute__((aligned(16))) char smem_dyn[];
    char* smem = smem_dyn;
    cg::grid_group grid = cg::this_grid();
    const int wave_id = __builtin_amdgcn_readfirstlane((int)(threadIdx.x >> 6));
#define MK_TID() ((wave_id << 6) | lane_id_opaque())
    if (MK_TID() == 0) *(uint4*)(smem_dyn + 131072) = make_uint4(0u, 0u, 0u, 0u);
    __syncthreads();
    (void)xcd_barrier_post((unsigned*)(p.ws + BAR_OFF), (volatile LAS3 unsigned*)(smem_dyn + 131072), MK_TID());
#ifdef PROBE_MASK
    unsigned long long t_prev = wall_clock64(), t_acc = 0, t_accb = 0, t_null = 0, t_sync = 0, t_syncb = 0;
#endif
    for (int ph = p.ph_lo; ph < p.ph_hi; ++ph) {
        Params q = p;
        {
            size_t z = 0;
            asm volatile("" : "+s"(z));
            q.ws = p.ws + z; q.out = p.out + z; q.x_prompt = p.x_prompt + z; q.x_sample = p.x_sample + z; q.ret_decay = p.ret_decay + z;
            q.w_gate = p.w_gate + z; q.w_up = p.w_up + z; q.w_down = p.w_down + z;
        }
        int phv = ph;
        asm volatile("" : "+s"(phv));
        int tidv = MK_TID();
        asm volatile("" : "+v"(tidv));
        const bool empty_ph = (gridDim.x == 256) && (ph == PH_R0 + 4 || ph == PH_R0 + 9);
        if (empty_ph) continue;
        run_phase(q, phv, smem, tidv);
#ifdef PROBE_MASK
        const unsigned long long t_s0 = wall_clock64();
#endif
        if (ph + 1 < p.ph_hi) { if (ph == p.ph_lo) grid.sync(); else { XcdBarrier xb; xb.bar = (unsigned*)(p.ws + BAR_OFF); xb.x = xb_xcc_id(); xb.st = (volatile LAS3 unsigned*)(smem_dyn + 131072); xcd_barrier(xb, MK_TID()); } }
#ifdef PROBE_MASK
        { const unsigned long long dt_ = wall_clock64() - t_s0; if ((PROBE_MASK >> ph) & 1ull) t_sync += dt_; else t_syncb += dt_; }
#endif
#ifdef PROBE_MASK
#if defined(PROBE_LOADTEST) || defined(PROBE_SCANTEST)
        if (ph == 0 && blockIdx.x == 0 && threadIdx.x == 0) { t_acc = ((volatile unsigned long long*)(p.ws + R_END - 64))[0]; t_accb = ((volatile unsigned long long*)(p.ws + R_END - 64))[1]; }
#endif
        { const unsigned long long t_now = wall_clock64(); if ((PROBE_MASK >> ph) & 1ull) t_acc += t_now - t_prev; if ((PROBE_MASK_B >> ph) & 1ull) t_accb += t_now - t_prev; t_prev = t_now; }
#endif
    }
#ifdef PROBE_MASK
    if (blockIdx.x == 0 && threadIdx.x == 0) {
        const float v = (float)t_sync * 0.001f, vb = (float)t_syncb * 0.001f;
        p.out[5] += sqrtf(v);
        p.out[1024 + 5] += sqrtf(vb);
    }
#endif
}

extern "C" void kernel_launch(void* const* d_in, const int* in_sizes, int n_in, void* d_out, int out_size, void* d_ws, size_t ws_size, hipStream_t stream) {
    static int grid_blocks = 0;
    if (!grid_blocks) {
        int dev = 0, cus = 0, per_cu = 0;
        (void)hipGetDevice(&dev);
        (void)hipDeviceGetAttribute(&cus, hipDeviceAttributeMultiprocessorCount, dev);
        (void)hipFuncSetAttribute((const void*)fwd_megakernel, hipFuncAttributeMaxDynamicSharedMemorySize, LDS_BYTES);
        (void)hipOccupancyMaxActiveBlocksPerMultiprocessor(&per_cu, fwd_megakernel, NT, LDS_BYTES);
        if (per_cu < 1) per_cu = 1;
        if (per_cu > 1) per_cu = 1;
        grid_blocks = cus * per_cu;
        if (ws_size < R_END || ws_size < M_END) fprintf(stderr, "kernel_launch: workspace too small: %zu < %zu\n", ws_size, (size_t)(R_END > M_END ? R_END : M_END));
    }
    if (ws_size < R_END || ws_size < M_END || ws_size < BAR_END || R_END > BAR_OFF || M_END > BAR_OFF) return;
    (void)hipMemsetAsync((char*)d_ws + BAR_OFF, 0, 16384, stream);
    Params p{};
    p.x_prompt = (const float*)d_in[0]; p.x_sample = (const float*)d_in[1]; p.ret_w_in = (const float*)d_in[2]; p.ret_decay = (const float*)d_in[3];
    p.ret_w_out = (const float*)d_in[4]; p.na_w_in = (const float*)d_in[5]; p.na_rpb = (const float*)d_in[6]; p.na_w_out = (const float*)d_in[7];
    p.ln_mix_g = (const float*)d_in[8]; p.ln_mix_b = (const float*)d_in[9]; p.ln_ffn_g = (const float*)d_in[10]; p.ln_ffn_b = (const float*)d_in[11];
    p.w_router = (const float*)d_in[12]; p.w_gate = (const float*)d_in[13]; p.w_up = (const float*)d_in[14]; p.w_down = (const float*)d_in[15];
    p.out = (float*)d_out; p.ws = (char*)d_ws; p.ph_lo = 0; p.ph_hi = PH_COUNT;
    void* args[] = {&p};
    hipError_t e = hipLaunchCooperativeKernel((void*)fwd_megakernel, dim3(grid_blocks), dim3(NT), args, LDS_BYTES, stream);
    if (e != hipSuccess) fprintf(stderr, "cooperative launch failed: %s (grid %d)\n", hipGetErrorString(e), grid_blocks);
}
```

```cpp
#include <hip/hip_runtime.h>
#include <hip/hip_cooperative_groups.h>
#include <cstdio>
namespace cg = cooperative_groups;

typedef unsigned short bf16_t;
typedef short bf16x8 __attribute__((ext_vector_type(8)));
typedef float f32x16 __attribute__((ext_vector_type(16)));
typedef float f32x4 __attribute__((ext_vector_type(4)));
typedef unsigned long long u64;

constexpr int D = 1024;
constexpr int T_ALL = 49152;
constexpr int T_PROMPT = 32768;
constexpr int T3 = 16384;
constexpr float ALPHA = 1.41421356237309515f;
constexpr float LN_EPS = 1e-5f, GN_EPS = 1e-6f;
constexpr int CAP_P = 4096, CAP_S = 2048;
constexpr int RC = 256, NCH3 = T3 / RC;

constexpr size_t R_WIN = 0;
constexpr size_t R_WOUT = R_WIN + 6144ull * 1024 * 2;
constexpr size_t R_ROT = R_WOUT + 1024ull * 2048 * 2;
constexpr size_t R_Q = R_ROT + 16384ull * 128 * 8;
constexpr size_t R_K = R_Q + (size_t)T3 * 1024 * 2;
constexpr size_t R_KT = R_K + (size_t)T3 * 1024 * 2;
constexpr size_t R_VT = R_KT + (size_t)T3 * 1024 * 2;
constexpr size_t R_G = R_VT + (size_t)T3 * 2048 * 2;
constexpr size_t R_P = R_G + (size_t)T3 * 2048 * 2;
constexpr size_t R_UR = R_P + (size_t)NCH3 * 4 * RC * RC * 2;
constexpr size_t R_O = R_UR + 2ull * NCH3 * 4 * 512 * 256 * 2;
constexpr size_t R_END = R_O + (size_t)T3 * 2048 * 2;
constexpr size_t UNIT = (size_t)T_ALL * 1024 * 2;
constexpr size_t M_XB = 0;
constexpr size_t M_XB2 = 2 * UNIT;
constexpr size_t M_YE = 0;
constexpr size_t M_H = 2 * UNIT;
constexpr size_t M_WGU = M_H + 2ull * T_ALL * 1024 * 2;
constexpr size_t M_WD = M_WGU + 16ull * 2048 * 1024 * 2;
constexpr size_t M_AFF = M_WD + 16ull * 1024 * 1024 * 2;
constexpr size_t M_IDX = M_AFF + (size_t)T_ALL * 16 * 4;
constexpr size_t M_GATE = M_IDX + 2ull * T_ALL * 4;
constexpr size_t M_POS = M_GATE + 2ull * T_ALL * 4;
constexpr size_t M_NWIN = M_POS + (size_t)T_ALL * 16 * 4;
constexpr size_t M_NWOUT = M_NWIN + 3072ull * 1024 * 2;
constexpr size_t M_END = M_NWOUT + 1024ull * 1024 * 2;
constexpr size_t BAR_OFF = (R_END > M_END ? R_END : M_END);
constexpr size_t BAR_END = BAR_OFF + 16384;
constexpr size_t N_Q = 3 * UNIT;
constexpr size_t N_K = 0;
constexpr size_t N_VT = UNIT;

constexpr int LDS_BYTES = 131072 + 16;
struct Params {
    const float *x_prompt, *x_sample, *ret_w_in, *ret_decay, *ret_w_out, *na_w_in, *na_rpb, *na_w_out;
    const float *ln_mix_g, *ln_mix_b, *ln_ffn_g, *ln_ffn_b, *w_router, *w_gate, *w_up, *w_down;
    float* out;
    char* ws;
    int ph_lo, ph_hi;
};

typedef __bf16 bf16x2_t __attribute__((ext_vector_type(2)));
typedef float f32x2_t __attribute__((ext_vector_type(2)));
__device__ __forceinline__ unsigned pk_bf16(float lo, float hi) {
    f32x2_t v = {lo, hi};
    bf16x2_t b = __builtin_convertvector(v, bf16x2_t);
    return __builtin_bit_cast(unsigned, b);
}
__device__ __forceinline__ bf16_t f2bf(float f) { return (bf16_t)(pk_bf16(f, 0.f) & 0xffffu); }
__device__ __forceinline__ float bf_lo(unsigned u) { return __uint_as_float(u << 16); }
__device__ __forceinline__ float bf_hi(unsigned u) { return __uint_as_float(u & 0xffff0000u); }
__device__ __forceinline__ float silu_f(float g) { return g * __builtin_amdgcn_rcpf(1.f + __expf(-g)); }
template <int CTRL, int RMASK> __device__ __forceinline__ float dpp_mov0(float v) {
    return __builtin_bit_cast(float, __builtin_amdgcn_update_dpp(0, __builtin_bit_cast(int, v), CTRL, RMASK, 0xf, false));
}
__device__ __forceinline__ float wave_sum(float v) {
    v += dpp_mov0<0xB1, 0xf>(v);
    v += dpp_mov0<0x4E, 0xf>(v);
    v += dpp_mov0<0x141, 0xf>(v);
    v += dpp_mov0<0x140, 0xf>(v);
    v += dpp_mov0<0x142, 0xa>(v);
    v += dpp_mov0<0x143, 0xc>(v);
    return __builtin_bit_cast(float, __builtin_amdgcn_readlane(__builtin_bit_cast(int, v), 63));
}
template <int CTRL> __device__ __forceinline__ float dpp_perm(float v) { return __builtin_bit_cast(float, __builtin_amdgcn_update_dpp(0, __builtin_bit_cast(int, v), CTRL, 0xf, 0xf, true)); }
__device__ __forceinline__ float row16_max(float v) {
    v = fmaxf(v, dpp_perm<0xB1>(v)); v = fmaxf(v, dpp_perm<0x4E>(v)); v = fmaxf(v, dpp_perm<0x141>(v)); return fmaxf(v, dpp_perm<0x140>(v));
}
__device__ __forceinline__ float row16_sum(float v) {
    v += dpp_perm<0xB1>(v); v += dpp_perm<0x4E>(v); v += dpp_perm<0x141>(v); return v + dpp_perm<0x140>(v);
}
__device__ __forceinline__ uint4 scale8(uint4 v, float s) {
    uint4 r;
    r.x = pk_bf16(bf_lo(v.x) * s, bf_hi(v.x) * s);
    r.y = pk_bf16(bf_lo(v.y) * s, bf_hi(v.y) * s);
    r.z = pk_bf16(bf_lo(v.z) * s, bf_hi(v.z) * s);
    r.w = pk_bf16(bf_lo(v.w) * s, bf_hi(v.w) * s);
    return r;
}
__device__ __forceinline__ float log2_sigmoid(float x) { return -log1pf(expf(-x)) * 1.44269504088896341f; }

__device__ __forceinline__ int lds_off(int row, int c8) { return row * 128 + ((c8 ^ ((row >> 1) & 7)) << 4); }
constexpr int NT = 512;
template <int MI_, int NI_, int WM_, int WN_, int DEPTH_> struct Cfg {
    static constexpr int DEPTH = DEPTH_;
    static constexpr int MI = MI_, NI = NI_, WM = WM_, WN = WN_, BM = WM_ * MI_ * 32, BN = WN_ * NI_ * 32, LA = BM / 64, LB = BN / 64, STAGE = (BM + BN) * 128;
    static_assert(WM_ * WN_ == 8, "8 waves");
};
typedef Cfg<4, 2, 2, 4, 2> C256;
typedef Cfg<2, 1, 2, 4, 4> C128;
typedef Cfg<2, 2, 2, 4, 3> CO;

template <class P, class C, bool SWAP, int D, int S0, bool NOMATH = false>
__device__ __forceinline__ void gemm_iter(P& p, char* smem, int kt, int nk, uint4 (&va)[D][C::LA], uint4 (&vb)[D][C::LB], f32x16 (&acc)[C::MI][C::NI],
                                          int wm, int wn, int lane, int r0, int c8) {
    constexpr int S = S0 % D, SN = (S0 + 1) % D;
    char* cur = smem + (kt & 1) * C::STAGE;
    char* nxt = smem + ((kt + 1) & 1) * C::STAGE;
    if (kt + D < nk) {
#pragma unroll
        for (int i = 0; i < C::LA; ++i) va[S][i] = p.ldA(r0 + 64 * i, kt + D, c8);
#pragma unroll
        for (int i = 0; i < C::LB; ++i) vb[S][i] = p.ldB(r0 + 64 * i, kt + D, c8);
    }
    __builtin_amdgcn_sched_barrier(0);
    p.template pre<C>(kt, acc, wm, wn, lane);
#pragma unroll
    for (int ks = 0; ks < (NOMATH ? 0 : 4); ++ks) {
        bf16x8 a[C::MI], b[C::NI];
#pragma unroll
        for (int mi = 0; mi < C::MI; ++mi) a[mi] = *(const bf16x8*)(cur + lds_off(wm * (C::MI * 32) + mi * 32 + (lane & 31), ks * 2 + (lane >> 5)));
#pragma unroll
        for (int ni = 0; ni < C::NI; ++ni) b[ni] = *(const bf16x8*)(cur + C::BM * 128 + lds_off(wn * (C::NI * 32) + ni * 32 + (lane & 31), ks * 2 + (lane >> 5)));
#pragma unroll
        for (int mi = 0; mi < C::MI; ++mi)
#pragma unroll
            for (int ni = 0; ni < C::NI; ++ni) {
                if (SWAP) acc[mi][ni] = __builtin_amdgcn_mfma_f32_32x32x16_bf16(b[ni], a[mi], acc[mi][ni], 0, 0, 0);
                else      acc[mi][ni] = __builtin_amdgcn_mfma_f32_32x32x16_bf16(a[mi], b[ni], acc[mi][ni], 0, 0, 0);
            }
    }
    if (kt + 1 < nk) {
#pragma unroll
        for (int i = 0; i < C::LA; ++i) *(uint4*)(nxt + lds_off(r0 + 64 * i, c8)) = p.fixA(va[SN][i], r0 + 64 * i, kt + 1, c8);
#pragma unroll
        for (int i = 0; i < C::LB; ++i) *(uint4*)(nxt + C::BM * 128 + lds_off(r0 + 64 * i, c8)) = p.fixB(vb[SN][i], r0 + 64 * i, kt + 1, c8);
    }
    __syncthreads();
}

template <class P, class C, bool SWAP, int D = C::DEPTH, bool NOMATH = false>
__device__ __forceinline__ void gemm_core(P& p, char* smem, int nk, const int TID) {
    int tid = TID;
    asm volatile("" : "+v"(tid));
    const int lane = tid & 63, w = tid >> 6, wm = w / C::WN, wn = w % C::WN;
    const int c8 = tid & 7, r0 = tid >> 3;
    f32x16 acc[C::MI][C::NI];
#pragma unroll
    for (int i = 0; i < C::MI; ++i)
#pragma unroll
        for (int j = 0; j < C::NI; ++j)
#pragma unroll
            for (int r = 0; r < 16; ++r) acc[i][j][r] = 0.f;
    uint4 va[D][C::LA], vb[D][C::LB];
#pragma unroll
    for (int d = 0; d < D; ++d) {
        if (d < nk) {
#pragma unroll
            for (int i = 0; i < C::LA; ++i) va[d][i] = p.ldA(r0 + 64 * i, d, c8);
#pragma unroll
            for (int i = 0; i < C::LB; ++i) vb[d][i] = p.ldB(r0 + 64 * i, d, c8);
        }
    }
#pragma unroll
    for (int i = 0; i < C::LA; ++i) *(uint4*)(smem + lds_off(r0 + 64 * i, c8)) = p.fixA(va[0][i], r0 + 64 * i, 0, c8);
#pragma unroll
    for (int i = 0; i < C::LB; ++i) *(uint4*)(smem + C::BM * 128 + lds_off(r0 + 64 * i, c8)) = p.fixB(vb[0][i], r0 + 64 * i, 0, c8);
    __syncthreads();
    for (int kt = 0; kt < nk; kt += D) {
        gemm_iter<P, C, SWAP, D, 0, NOMATH>(p, smem, kt, nk, va, vb, acc, wm, wn, lane, r0, c8);
        if (D > 1 && kt + 1 < nk) gemm_iter<P, C, SWAP, D, 1, NOMATH>(p, smem, kt + 1, nk, va, vb, acc, wm, wn, lane, r0, c8);
        if (D > 2 && kt + 2 < nk) gemm_iter<P, C, SWAP, D, 2, NOMATH>(p, smem, kt + 2, nk, va, vb, acc, wm, wn, lane, r0, c8);
        if (D > 3 && kt + 3 < nk) gemm_iter<P, C, SWAP, D, 3, NOMATH>(p, smem, kt + 3, nk, va, vb, acc, wm, wn, lane, r0, c8);
    }
    int tid2 = tid;
    asm volatile("" : "+v"(tid2));
    p.template epi<C>(acc, (tid2 >> 6) / C::WN, (tid2 >> 6) % C::WN, tid2 & 63);
}

#define LAS3 __attribute__((address_space(3)))
template <class P, class C>
__device__ __forceinline__ void dma_stage(P& p, char* stage, int kt, int w, int lane) {
    const int rl = lane >> 3, cs = lane & 7;
#pragma unroll
    for (int i = 0; i < C::LA; ++i) {
        const int row = 64 * i + 8 * w + rl;
        __builtin_amdgcn_global_load_lds((const unsigned*)p.adA(row, kt, cs ^ ((row >> 1) & 7)), (LAS3 unsigned*)(stage + (64 * i + 8 * w) * 128), 16, 0, 0);
    }
#pragma unroll
    for (int i = 0; i < C::LB; ++i) {
        const int row = 64 * i + 8 * w + rl;
        __builtin_amdgcn_global_load_lds((const unsigned*)p.adB(row, kt, cs ^ ((row >> 1) & 7)), (LAS3 unsigned*)(stage + C::BM * 128 + (64 * i + 8 * w) * 128), 16, 0, 0);
    }
}
template <class P, class C, bool SWAP>
__device__ __forceinline__ void gemm_core_dma(P& p, char* smem, int nk, const int TID) {
    int tid = TID;
    asm volatile("" : "+v"(tid));
    const int lane = tid & 63, w = __builtin_amdgcn_readfirstlane(tid >> 6), wm = w / C::WN, wn = w % C::WN;
    f32x16 acc[C::MI][C::NI];
#pragma unroll
    for (int i = 0; i < C::MI; ++i)
#pragma unroll
        for (int j = 0; j < C::NI; ++j)
#pragma unroll
            for (int r = 0; r < 16; ++r) acc[i][j][r] = 0.f;
    dma_stage<P, C>(p, smem, 0, w, lane);
    __syncthreads();
    for (int kt = 0; kt < nk; ++kt) {
        char* cur = smem + (kt & 1) * C::STAGE;
        if (kt + 1 < nk) dma_stage<P, C>(p, smem + ((kt + 1) & 1) * C::STAGE, kt + 1, w, lane);
        __builtin_amdgcn_sched_barrier(0);
        bf16x8 a[2][C::MI], b[2][C::NI];
#pragma unroll
        for (int mi = 0; mi < C::MI; ++mi) a[0][mi] = *(const bf16x8*)(cur + lds_off(wm * (C::MI * 32) + mi * 32 + (lane & 31), (lane >> 5)));
#pragma unroll
        for (int ni = 0; ni < C::NI; ++ni) b[0][ni] = *(const bf16x8*)(cur + C::BM * 128 + lds_off(wn * (C::NI * 32) + ni * 32 + (lane & 31), (lane >> 5)));
#pragma unroll
        for (int ks = 0; ks < 4; ++ks) {
            if (ks < 3) {
#pragma unroll
                for (int mi = 0; mi < C::MI; ++mi) a[(ks + 1) & 1][mi] = *(const bf16x8*)(cur + lds_off(wm * (C::MI * 32) + mi * 32 + (lane & 31), (ks + 1) * 2 + (lane >> 5)));
#pragma unroll
                for (int ni = 0; ni < C::NI; ++ni) b[(ks + 1) & 1][ni] = *(const bf16x8*)(cur + C::BM * 128 + lds_off(wn * (C::NI * 32) + ni * 32 + (lane & 31), (ks + 1) * 2 + (lane >> 5)));
            }
            __builtin_amdgcn_sched_barrier(0);
#pragma unroll
            for (int mi = 0; mi < C::MI; ++mi)
#pragma unroll
                for (int ni = 0; ni < C::NI; ++ni) {
                    if (SWAP) acc[mi][ni] = __builtin_amdgcn_mfma_f32_32x32x16_bf16(b[ks & 1][ni], a[ks & 1][mi], acc[mi][ni], 0, 0, 0);
                    else      acc[mi][ni] = __builtin_amdgcn_mfma_f32_32x32x16_bf16(a[ks & 1][mi], b[ks & 1][ni], acc[mi][ni], 0, 0, 0);
                }
            __builtin_amdgcn_sched_barrier(0);
        }
        __syncthreads();
    }
    int tid2 = tid;
    asm volatile("" : "+v"(tid2));
    p.template epi<C>(acc, (tid2 >> 6) / C::WN, (tid2 >> 6) % C::WN, tid2 & 63);
}

__device__ __forceinline__ int lds_off64(int row, int c4) { return row * 64 + ((c4 ^ ((row >> 2) & 3)) << 4); }
template <class P, class C, bool SWAP>
__device__ __forceinline__ void gemm_core_dma4(P& p, char* smem, int nk, const int TID) {
    static_assert(C::BM == 256 && C::BN == 256, "sized for 256 x 256 tiles: 4 stages x 32 KiB");
    constexpr int STG = (C::BM + C::BN) * 64;
    int tid = TID;
    asm volatile("" : "+v"(tid));
    const int lane = tid & 63, w = __builtin_amdgcn_readfirstlane(tid >> 6), wm = w / C::WN, wn = w % C::WN;
    const int nsteps = nk * 2;
    f32x16 acc[C::MI][C::NI];
#pragma unroll
    for (int i = 0; i < C::MI; ++i)
#pragma unroll
        for (int j = 0; j < C::NI; ++j)
#pragma unroll
            for (int r = 0; r < 16; ++r) acc[i][j][r] = 0.f;
    const char* pa[2]; const char* pb[2];
#pragma unroll
    for (int i = 0; i < 2; ++i) {
        const int row = 32 * w + 16 * i + (lane >> 2);
        const int ch = (lane & 3) ^ ((row >> 2) & 3);
        pa[i] = (const char*)p.adA(row, 0, 0) + ch * 16;
        pb[i] = (const char*)p.adB(row, 0, 0) + ch * 16;
    }
#define DMA4_ISSUE(j) do { char* st_ = smem + ((j) & 3) * STG + (32 * w) * 64; _Pragma("unroll") for (int i_ = 0; i_ < 2; ++i_) { \
        __builtin_amdgcn_global_load_lds((const unsigned*)(pa[i_] + (size_t)(j) * 64), (LAS3 unsigned*)(st_ + i_ * 1024), 16, 0, 0); \
        __builtin_amdgcn_global_load_lds((const unsigned*)(pb[i_] + (size_t)(j) * 64), (LAS3 unsigned*)(st_ + C::BM * 64 + i_ * 1024), 16, 0, 0); } } while (0)
    DMA4_ISSUE(0);
    DMA4_ISSUE(1);
    for (int j = 0; j < nsteps; ++j) {
        if (j + 2 < nsteps) { DMA4_ISSUE(j + 2); asm volatile("s_waitcnt vmcnt(8)" ::: "memory"); }
        else if (j + 1 < nsteps) asm volatile("s_waitcnt vmcnt(4)" ::: "memory");
        else asm volatile("s_waitcnt vmcnt(0)" ::: "memory");
        __builtin_amdgcn_s_barrier();
        __builtin_amdgcn_sched_barrier(0);
        const char* cur = smem + (j & 3) * STG;
#pragma unroll
        for (int ks = 0; ks < 2; ++ks) {
            bf16x8 a[C::MI], b[C::NI];
#pragma unroll
            for (int mi = 0; mi < C::MI; ++mi) a[mi] = *(const bf16x8*)(cur + lds_off64(wm * (C::MI * 32) + mi * 32 + (lane & 31), ks * 2 + (lane >> 5)));
#pragma unroll
            for (int ni = 0; ni < C::NI; ++ni) b[ni] = *(const bf16x8*)(cur + C::BM * 64 + lds_off64(wn * (C::NI * 32) + ni * 32 + (lane & 31), ks * 2 + (lane >> 5)));
#pragma unroll
            for (int mi = 0; mi < C::MI; ++mi)
#pragma unroll
                for (int ni = 0; ni < C::NI; ++ni) {
                    if (SWAP) acc[mi][ni] = __builtin_amdgcn_mfma_f32_32x32x16_bf16(b[ni], a[mi], acc[mi][ni], 0, 0, 0);
                    else      acc[mi][ni] = __builtin_amdgcn_mfma_f32_32x32x16_bf16(a[mi], b[ni], acc[mi][ni], 0, 0, 0);
                }
        }
        __builtin_amdgcn_sched_barrier(0);
    }
#undef DMA4_ISSUE
    __syncthreads();
    int tid2 = tid;
    asm volatile("" : "+v"(tid2));
    p.template epi<C>(acc, (tid2 >> 6) / C::WN, (tid2 >> 6) % C::WN, tid2 & 63);
}

struct NoFix {
    __device__ __forceinline__ uint4 fixA(uint4 v, int, int, int) const { return v; }
    __device__ __forceinline__ uint4 fixB(uint4 v, int, int, int) const { return v; }
};
struct NoPre : NoFix { template <class C> __device__ __forceinline__ void pre(int, f32x16 (&)[C::MI][C::NI], int, int, int) {} };

#define PK4(A, g) make_uint2(pk_bf16((A)[(g) * 4 + 0], (A)[(g) * 4 + 1]), pk_bf16((A)[(g) * 4 + 2], (A)[(g) * 4 + 3]))

template <bool SWAP> struct PolProj : NoPre {
    const bf16_t* xA; const bf16_t* Bt; char* ws; int m0, n0, smask;
    __device__ __forceinline__ const bf16_t* adA(int row, int kt, int c8) const { return xA + (size_t)(m0 + row) * 1024 + kt * 64 + c8 * 8; }
    __device__ __forceinline__ const bf16_t* adB(int row, int kt, int c8) const { return Bt + (size_t)(n0 + row) * 1024 + kt * 64 + c8 * 8; }
    __device__ __forceinline__ uint4 ldA(int row, int kt, int c8) const { return *(const uint4*)adA(row, kt, c8); }
    __device__ __forceinline__ uint4 ldB(int row, int kt, int c8) const { return *(const uint4*)adB(row, kt, c8); }
    template <class C> __device__ __forceinline__ void epi(f32x16 (&acc)[C::MI][C::NI], int wm, int wn, int lane) const {
        static_assert(C::NI == 2, "rotary pairs need a 64-column wave tile");
        const int sec = n0 >> 10;
        bf16_t* Qb = (bf16_t*)(ws + R_Q); bf16_t* Kb = (bf16_t*)(ws + R_K); bf16_t* Ktb = (bf16_t*)(ws + R_KT);
        bf16_t* Vtb = (bf16_t*)(ws + R_VT); bf16_t* Gb = (bf16_t*)(ws + R_G);
        const float2* rot = (const float2*)(ws + R_ROT);
        const int mb = m0 + wm * (C::MI * 32);
        if (sec == 0) {
            const int cb = (n0 & 1023) + wn * 64;
            const int ib = ((cb & 255) >> 6) * 32 + (lane & 31);
            const int c1 = cb + (lane & 31);
#pragma unroll
            for (int mi = 0; mi < C::MI; ++mi)
#pragma unroll
                for (int r = 0; r < 16; ++r) {
                    const int tok = mb + mi * 32 + 8 * (r >> 2) + 4 * (lane >> 5) + (r & 3);
                    const float2 cs = rot[(size_t)(tok & smask) * 128 + ib];
                    const float x1 = acc[mi][0][r], x2 = acc[mi][1][r];
                    Qb[(size_t)tok * 1024 + c1] = f2bf(x1 * cs.x - x2 * cs.y);
                    Qb[(size_t)tok * 1024 + c1 + 32] = f2bf(x1 * cs.y + x2 * cs.x);
                }
        } else if (sec == 1) {
            const int cb = (n0 & 1023) + wn * 64;
            const int ib = ((cb & 255) >> 6) * 32 + (lane & 31);
            const int c1 = cb + (lane & 31);
#pragma unroll
            for (int mi = 0; mi < C::MI; ++mi)
#pragma unroll
                for (int g = 0; g < 4; ++g) {
                    const int tok0 = mb + mi * 32 + 8 * g + 4 * (lane >> 5);
                    float o1[4], o2[4];
#pragma unroll
                    for (int e = 0; e < 4; ++e) {
                        float2 cs = rot[(size_t)((tok0 + e) & smask) * 128 + ib];
                        float x1 = acc[mi][0][g * 4 + e], x2 = acc[mi][1][g * 4 + e];
                        o1[e] = x1 * cs.x - x2 * cs.y; o2[e] = x1 * cs.y + x2 * cs.x;
                        Kb[(size_t)(tok0 + e) * 1024 + c1] = f2bf(o1[e]);
                        Kb[(size_t)(tok0 + e) * 1024 + c1 + 32] = f2bf(o2[e]);
                    }
                    *(uint2*)(Ktb + ((size_t)(tok0 >> 7) * 1024 + c1) * 128 + (tok0 & 127)) = make_uint2(pk_bf16(o1[0], o1[1]), pk_bf16(o1[2], o1[3]));
                    *(uint2*)(Ktb + ((size_t)(tok0 >> 7) * 1024 + c1 + 32) * 128 + (tok0 & 127)) = make_uint2(pk_bf16(o2[0], o2[1]), pk_bf16(o2[2], o2[3]));
                    __builtin_amdgcn_sched_barrier(0);
                }
        } else if (sec < 4) {
#pragma unroll
            for (int mi = 0; mi < C::MI; ++mi) {
                const int tok = mb + mi * 32 + (lane & 31);
#pragma unroll
                for (int ni = 0; ni < 2; ++ni)
#pragma unroll
                    for (int r = 0; r < 16; ++r) {
                        const int col = n0 - 2048 + wn * 64 + ni * 32 + 8 * (r >> 2) + 4 * (lane >> 5) + (r & 3);
                        Vtb[((size_t)(tok >> 7) * 2048 + col) * 128 + (tok & 127)] = f2bf(acc[mi][ni][r]);
                    }
            }
        } else {
#pragma unroll
            for (int mi = 0; mi < C::MI; ++mi)
#pragma unroll
                for (int ni = 0; ni < 2; ++ni) {
                    const int col = n0 - 4096 + wn * 64 + ni * 32 + (lane & 31);
#pragma unroll
                    for (int r = 0; r < 16; ++r) {
                        const int tok = mb + mi * 32 + 8 * (r >> 2) + 4 * (lane >> 5) + (r & 3);
                        Gb[(size_t)tok * 2048 + col] = f2bf(acc[mi][ni][r]);
                    }
                }
        }
    }
};

#ifdef PROBE_MASK
struct PolNull : NoPre {
    float* sink;
    __device__ __forceinline__ uint4 ldA(int row, int kt, int c8) const { return make_uint4(row, kt, c8, 0x3f803f80u); }
    __device__ __forceinline__ uint4 ldB(int row, int kt, int c8) const { return make_uint4(0x3f803f80u, row ^ kt, c8, 0x3f803f80u); }
    template <class C> __device__ __forceinline__ void epi(f32x16 (&acc)[C::MI][C::NI], int wm, int wn, int lane) const {
        float t = 0.f;
#pragma unroll
        for (int mi = 0; mi < C::MI; ++mi)
#pragma unroll
            for (int ni = 0; ni < C::NI; ++ni)
#pragma unroll
                for (int r = 0; r < 16; ++r) t += acc[mi][ni][r];
        if (t == 123456.789f) *sink = t;
    }
};
#endif

#ifdef PROBE_MASK
struct PolLoadTest : NoPre {
    const bf16_t *A, *B; int lda; float* sink;
    __device__ __forceinline__ uint4 ldA(int row, int kt, int c8) const { return *(const uint4*)(A + (size_t)row * lda + kt * 64 + c8 * 8); }
    __device__ __forceinline__ uint4 ldB(int row, int kt, int c8) const { return *(const uint4*)(B + (size_t)row * lda + kt * 64 + c8 * 8); }
    template <class C> __device__ __forceinline__ void epi(f32x16 (&acc)[C::MI][C::NI], int, int, int) const { if (acc[0][0][0] == 123456.789f) *sink = 1.f; }
};
#endif

struct PolScore : NoPre {
    const bf16_t *A, *B; bf16_t* P; float lgf, lgb; char* smem;
    __device__ __forceinline__ const bf16_t* adA(int row, int kt, int c8) const { return A + (size_t)row * 1024 + kt * 64 + c8 * 8; }
    __device__ __forceinline__ const bf16_t* adB(int row, int kt, int c8) const { return B + (size_t)row * 1024 + kt * 64 + c8 * 8; }
    __device__ __forceinline__ uint4 ldA(int row, int kt, int c8) const { return *(const uint4*)adA(row, kt, c8); }
    __device__ __forceinline__ uint4 ldB(int row, int kt, int c8) const { return *(const uint4*)adB(row, kt, c8); }
    template <class C> __device__ __forceinline__ void epi(f32x16 (&acc)[C::MI][C::NI], int wm, int wn, int lane) const {
        float* tab = (float*)smem;
        const int tid = (wm * C::WN + wn) * 64 + lane;
        if (tid < 2 * RC - 1) { const int d = tid - (RC - 1); tab[tid] = (d >= 0) ? exp2f(lgf * (float)d) : exp2f(lgb * (float)(-d)); }
        __syncthreads();
#pragma unroll
        for (int mi = 0; mi < C::MI; ++mi)
#pragma unroll
            for (int ni = 0; ni < C::NI; ++ni) {
                const int j = wn * (C::NI * 32) + ni * 32 + (lane & 31);
#pragma unroll
                for (int r = 0; r < 16; ++r) {
                    const int i = wm * (C::MI * 32) + mi * 32 + 8 * (r >> 2) + 4 * (lane >> 5) + (r & 3);
                    P[(size_t)i * RC + j] = f2bf(acc[mi][ni][r] * tab[i - j + (RC - 1)]);
                }
            }
        __syncthreads();
    }
};

template <bool EMIT = true, bool SCALE = true> struct PolUscanT {
    const bf16_t *A, *B;
    bf16_t* UR;
    int nc, dir; float lg, dec, st, st2;
    __device__ __forceinline__ int rchunk(int kt) const { const int ci = kt >> 2; return dir ? (nc - 1 - ci) : ci; }
    __device__ __forceinline__ int chunk(int kt) const { return rchunk(kt) * 2 + ((kt & 3) >> 1); }
    __device__ __forceinline__ uint4 ldA(int row, int kt, int c8) const { return *(const uint4*)(A + (size_t)chunk(kt) * (2048 * 128) + (kt & 1) * 64 + (unsigned)(row * 128 + c8 * 8)); }
    __device__ __forceinline__ uint4 ldB(int row, int kt, int c8) const { return *(const uint4*)(B + (size_t)chunk(kt) * (1024 * 128) + (kt & 1) * 64 + (unsigned)(row * 128 + c8 * 8)); }
    __device__ __forceinline__ uint4 fixA(uint4 v, int, int, int) const { return v; }
    __device__ __forceinline__ uint4 fixB(uint4 v, int row, int kt, int c8) const {
        if (!SCALE) return v;
        const int j0 = (kt & 3) * 64 + c8 * 8;
        float w0 = exp2f(lg * (float)(dir ? j0 : (RC - 1 - j0)));
        float w1 = w0 * st;
        uint4 r;
        r.x = pk_bf16(bf_lo(v.x) * w0, bf_hi(v.x) * w1); w0 *= st2; w1 *= st2;
        r.y = pk_bf16(bf_lo(v.y) * w0, bf_hi(v.y) * w1); w0 *= st2; w1 *= st2;
        r.z = pk_bf16(bf_lo(v.z) * w0, bf_hi(v.z) * w1); w0 *= st2; w1 *= st2;
        r.w = pk_bf16(bf_lo(v.w) * w0, bf_hi(v.w) * w1);
        return r;
    }
    template <class C> __device__ __forceinline__ void pre(int kt, f32x16 (&acc)[C::MI][C::NI], int wm, int wn, int lane) const {
        if (kt & 3) return;
        const int ch = rchunk(kt);
        bf16_t* dst = UR + (size_t)ch * (4ull * 512 * 256);
#pragma unroll
        for (int mi = 0; mi < (EMIT ? C::MI : 0); ++mi)
#pragma unroll
            for (int ni = 0; ni < C::NI; ++ni) {
                const int n = wn * (C::NI * 32) + ni * 32 + (lane & 31);
#pragma unroll
                for (int r = 0; r < 16; ++r) {
                    const int m = wm * (C::MI * 32) + mi * 32 + 8 * (r >> 2) + 4 * (lane >> 5) + (r & 3);
                    dst[(size_t)m * 256 + n] = f2bf(acc[mi][ni][r]);
                }
            }
#pragma unroll
        for (int mi = 0; mi < C::MI; ++mi)
#pragma unroll
            for (int ni = 0; ni < C::NI; ++ni)
#pragma unroll
                for (int r = 0; r < 16; ++r) acc[mi][ni][r] *= dec;
    }
    template <class C> __device__ __forceinline__ void epi(f32x16 (&)[C::MI][C::NI], int, int, int) const {}
};

typedef PolUscanT<true, true> PolUscan;

struct PolO : NoPre {
    const bf16_t *Pp, *Qp, *Vp, *Rf, *Rb; bf16_t* O; float lgf, lgb; int half;
    __device__ __forceinline__ uint4 ldA(int row, int kt, int c8) const {
        if (kt < 4) return *(const uint4*)(Pp + kt * 64 + (unsigned)(row * RC + c8 * 8));
        const int kk = (kt - 4) & 3;
        return *(const uint4*)(Qp + kk * 64 + (unsigned)(row * 1024 + c8 * 8));
    }
    __device__ __forceinline__ uint4 fixA(uint4 v, int row, int kt, int) const {
        if (kt < 4) return v;
        const int seg = (kt - 4) >> 2, i = half * 128 + row;
        const float s = seg ? exp2f(lgb * (float)(RC - i)) : exp2f(lgf * (float)(i + 1));
        return scale8(v, s);
    }
    __device__ __forceinline__ uint4 ldB(int row, int kt, int c8) const {
        if (kt < 4) return *(const uint4*)(Vp + (size_t)(kt >> 1) * (2048 * 128) + (kt & 1) * 64 + (unsigned)(row * 128 + c8 * 8));
        const int seg = (kt - 4) >> 2, kk = (kt - 4) & 3;
        return *(const uint4*)((seg ? Rb : Rf) + kk * 64 + (unsigned)(row * 256 + c8 * 8));
    }
    template <class C> __device__ __forceinline__ void epi(f32x16 (&acc)[C::MI][C::NI], int wm, int wn, int lane) const {
#pragma unroll
        for (int mi = 0; mi < C::MI; ++mi)
#pragma unroll
            for (int ni = 0; ni < C::NI; ++ni) {
                const int n = wn * (C::NI * 32) + ni * 32 + (lane & 31);
#pragma unroll
                for (int r = 0; r < 16; ++r) {
                    const int m = wm * (C::MI * 32) + mi * 32 + 8 * (r >> 2) + 4 * (lane >> 5) + (r & 3);
                    O[(size_t)m * 2048 + n] = f2bf(acc[mi][ni][r]);
                }
            }
    }
};

struct PolResid : NoPre {
    const bf16_t *A, *B; int lda, ldb; const float* res; float* dst;
    __device__ __forceinline__ const bf16_t* adA(int row, int kt, int c8) const { return A + (size_t)row * lda + kt * 64 + c8 * 8; }
    __device__ __forceinline__ const bf16_t* adB(int row, int kt, int c8) const { return B + (size_t)row * ldb + kt * 64 + c8 * 8; }
    __device__ __forceinline__ uint4 ldA(int row, int kt, int c8) const { return *(const uint4*)adA(row, kt, c8); }
    __device__ __forceinline__ uint4 ldB(int row, int kt, int c8) const { return *(const uint4*)adB(row, kt, c8); }
    template <class C> __device__ __forceinline__ void epi(f32x16 (&acc)[C::MI][C::NI], int wm, int wn, int lane) const {
#pragma unroll
        for (int mi = 0; mi < C::MI; ++mi)
#pragma unroll
            for (int ni = 0; ni < C::NI; ++ni) {
                const int n = wn * (C::NI * 32) + ni * 32 + (lane & 31);
#pragma unroll
                for (int r = 0; r < 16; ++r) {
                    const int m = wm * (C::MI * 32) + mi * 32 + 8 * (r >> 2) + 4 * (lane >> 5) + (r & 3);
                    dst[(size_t)m * 1024 + n] = ALPHA * res[(size_t)m * 1024 + n] + acc[mi][ni][r];
                }
            }
    }
};

struct PolMoe1 : NoPre {
    const bf16_t *xb, *B; const int* idx; bf16_t* H; int n0;
    __device__ __forceinline__ const bf16_t* adA(int row, int kt, int c8) const { return xb + (size_t)idx[row] * 1024 + kt * 64 + c8 * 8; }
    __device__ __forceinline__ const bf16_t* adB(int row, int kt, int c8) const { return B + (size_t)row * 1024 + kt * 64 + c8 * 8; }
    __device__ __forceinline__ uint4 ldA(int row, int kt, int c8) const { return *(const uint4*)adA(row, kt, c8); }
    __device__ __forceinline__ uint4 ldB(int row, int kt, int c8) const { return *(const uint4*)adB(row, kt, c8); }
    template <class C> __device__ __forceinline__ void epi(f32x16 (&acc)[C::MI][C::NI], int wm, int wn, int lane) const {
        static_assert(C::NI == 2, "gate/up pairs need a 64-column wave tile");
        const int f = ((n0 + wn * 64) >> 1) + (lane & 31);
#pragma unroll
        for (int mi = 0; mi < C::MI; ++mi)
#pragma unroll
            for (int r = 0; r < 16; ++r) {
                const int m = wm * (C::MI * 32) + mi * 32 + 8 * (r >> 2) + 4 * (lane >> 5) + (r & 3);
                H[(size_t)m * 1024 + f] = f2bf(silu_f(acc[mi][0][r]) * acc[mi][1][r]);
            }
    }
};
struct PolMoe2 : NoPre {
    const bf16_t *A, *B; const float* gate; bf16_t* Y;
    __device__ __forceinline__ const bf16_t* adA(int row, int kt, int c8) const { return A + (size_t)row * 1024 + kt * 64 + c8 * 8; }
    __device__ __forceinline__ const bf16_t* adB(int row, int kt, int c8) const { return B + (size_t)row * 1024 + kt * 64 + c8 * 8; }
    __device__ __forceinline__ uint4 ldA(int row, int kt, int c8) const { return *(const uint4*)adA(row, kt, c8); }
    __device__ __forceinline__ uint4 ldB(int row, int kt, int c8) const { return *(const uint4*)adB(row, kt, c8); }
    template <class C> __device__ __forceinline__ void epi(f32x16 (&acc)[C::MI][C::NI], int wm, int wn, int lane) const {
#pragma unroll
        for (int mi = 0; mi < C::MI; ++mi)
#pragma unroll
            for (int r = 0; r < 16; ++r) {
                const int m = wm * (C::MI * 32) + mi * 32 + 8 * (r >> 2) + 4 * (lane >> 5) + (r & 3);
                const float gt = gate[m];
#pragma unroll
                for (int ni = 0; ni < C::NI; ++ni) Y[(size_t)m * 1024 + wn * (C::NI * 32) + ni * 32 + (lane & 31)] = f2bf(acc[mi][ni][r] * gt);
            }
    }
};
template <bool SWAP> struct PolQkv : NoPre {
    const bf16_t *A, *B; char* ws; int m0, n0;
    __device__ __forceinline__ const bf16_t* adA(int row, int kt, int c8) const { return A + (size_t)row * 1024 + kt * 64 + c8 * 8; }
    __device__ __forceinline__ const bf16_t* adB(int row, int kt, int c8) const { return B + (size_t)row * 1024 + kt * 64 + c8 * 8; }
    __device__ __forceinline__ uint4 ldA(int row, int kt, int c8) const { return *(const uint4*)adA(row, kt, c8); }
    __device__ __forceinline__ uint4 ldB(int row, int kt, int c8) const { return *(const uint4*)adB(row, kt, c8); }
    template <class C> __device__ __forceinline__ void epi(f32x16 (&acc)[C::MI][C::NI], int wm, int wn, int lane) const {
        const int mb = m0 + wm * (C::MI * 32);
        if (!SWAP) {
            bf16_t* dstb = (bf16_t*)(ws + ((n0 >> 10) ? N_K : N_Q));
#pragma unroll
            for (int mi = 0; mi < C::MI; ++mi)
#pragma unroll
                for (int ni = 0; ni < C::NI; ++ni) {
                    const int hh = ((n0 & 1023) + wn * (C::NI * 32) + ni * 32) >> 5;
#pragma unroll
                    for (int r = 0; r < 16; ++r) {
                        const int tok = mb + mi * 32 + 8 * (r >> 2) + 4 * (lane >> 5) + (r & 3);
                        dstb[((size_t)hh * T_ALL + tok) * 32 + (lane & 31)] = f2bf(acc[mi][ni][r]);
                    }
                }
        } else {
            bf16_t* Vt = (bf16_t*)(ws + N_VT);
#pragma unroll
            for (int mi = 0; mi < C::MI; ++mi) {
                const int tok = mb + mi * 32 + (lane & 31);
#pragma unroll
                for (int ni = 0; ni < C::NI; ++ni)
#pragma unroll
                    for (int r = 0; r < 16; ++r) {
                        const int col = n0 - 2048 + wn * (C::NI * 32) + ni * 32 + 8 * (r >> 2) + 4 * (lane >> 5) + (r & 3);
                        Vt[(size_t)col * T_ALL + tok] = f2bf(acc[mi][ni][r]);
                    }
            }
        }
    }
};

__device__ __forceinline__ void transpose_tile(const float* src0, const float* src1, int ld, bf16_t* dst, int K, int n0, int k0, int mode, char* smem, const int TID) {
    float* tile = (float*)smem;
    const int t = TID;
    {
        const int n4 = (t & 15) * 4, kr = t >> 4;
        const int np = n0 + n4;
        const float* s = src0; int col = np;
        if (mode == 1 && np < 2048) {
            const int base = np & ~255, r = np & 255, g = r >> 5, u = r & 31;
            const int i = g * 16 + (u & 15);
            col = base + ((u < 16) ? i : (i + 128));
        } else if (mode == 2) {
            const int g = np >> 5, u = np & 31;
            if (u >= 16) s = src1;
            col = g * 16 + (u & 15);
        }
#pragma unroll
        for (int kk = 0; kk < 4; ++kk) {
            const int k = kr + 32 * kk;
            const f32x4 vv = __builtin_nontemporal_load((const f32x4*)(s + (size_t)(k0 + k) * ld + col));
            const float4 v = make_float4(vv[0], vv[1], vv[2], vv[3]);
            tile[k * 65 + n4 + 0] = v.x; tile[k * 65 + n4 + 1] = v.y; tile[k * 65 + n4 + 2] = v.z; tile[k * 65 + n4 + 3] = v.w;
        }
    }
    __syncthreads();
    {
        const int n = t >> 3, kc = (t & 7) * 16;
        const int np = n0 + n;
        float sc = 1.f;
        if (mode == 1 && np >= 1024 && np < 2048) sc = 0.0625f;
        if (mode == 3 && np < 1024) sc = 0.17677669529663687f * 1.4426950408889634f;
        unsigned o[8];
#pragma unroll
        for (int j = 0; j < 8; ++j) o[j] = pk_bf16(tile[(kc + 2 * j) * 65 + n] * sc, tile[(kc + 2 * j + 1) * 65 + n] * sc);
        uint4* d = (uint4*)(dst + (size_t)np * K + k0 + kc);
        d[0] = make_uint4(o[0], o[1], o[2], o[3]);
        d[1] = make_uint4(o[4], o[5], o[6], o[7]);
    }
    __syncthreads();
}
__device__ void convert_matrix(const float* src0, const float* src1, int ld, bf16_t* dst, int N, int K, int mode, char* smem, int& rot, const int TID, int wid, int nw) {
    const int ntn = N / 64, ntk = K / 128, nt = ntn * ntk;
    if (wid >= 0) {
        int start = (wid + nw - (rot % nw)) % nw;
        for (int t = start; t < nt; t += nw) transpose_tile(src0, src1, ld, dst, K, (t % ntn) * 64, (t / ntn) * 128, mode, smem, TID);
    }
    rot += nt;
}

template <int MODE_SRC, bool WRITE_XB, bool ROUTER>
__device__ void ln_phase(const Params& p, const float* gam, const float* bet, const float* wr, size_t xb_off, char* smem, const int TID) {
    float* wrT = (float*)smem;
    if (ROUTER) {
        for (int i = TID; i < 16 * 1024; i += NT) { const int d = i >> 4, e = i & 15; wrT[e * 1024 + d] = wr[i]; }
        __syncthreads();
    }
    const int lane = TID & 63, w = TID >> 6;
    bf16_t* xb = (bf16_t*)(p.ws + xb_off);
    const bf16_t* ye = (const bf16_t*)(p.ws + M_YE);
    const int* pos = (const int*)(p.ws + M_POS);
    float* aff = (float*)(p.ws + M_AFF);
    const int tstride = gridDim.x * 8;
    int tok = blockIdx.x * 8 + w;
    float4 nv[4]; int npos = -1;
    if (tok < T_ALL) {
#pragma unroll
        for (int k = 0; k < 4; ++k) nv[k] = *(const float4*)(p.out + (size_t)tok * 1024 + k * 256 + lane * 4);
        if (MODE_SRC == 1) npos = pos[(size_t)tok * 16 + (lane & 15)];
    }
    for (; tok < T_ALL; tok += tstride) {
        float* xr = p.out + (size_t)tok * 1024;
        float4 v[4];
#pragma unroll
        for (int k = 0; k < 4; ++k) v[k] = nv[k];
        const int cpos = npos;
        if (tok + tstride < T_ALL) {
#pragma unroll
            for (int k = 0; k < 4; ++k) nv[k] = *(const float4*)(p.out + (size_t)(tok + tstride) * 1024 + k * 256 + lane * 4);
            if (MODE_SRC == 1) npos = pos[(size_t)(tok + tstride) * 16 + (lane & 15)];
        }
        if (MODE_SRC == 1) {
#pragma unroll
            for (int k = 0; k < 4; ++k) { v[k].x *= ALPHA; v[k].y *= ALPHA; v[k].z *= ALPHA; v[k].w *= ALPHA; }
            const int trunk = tok >= T_PROMPT;
            const int cap = trunk ? CAP_S : CAP_P;
            const size_t rb = trunk ? (size_t)16 * CAP_P : 0;
            unsigned long long m = __ballot(cpos >= 0) & 0xffffull;
            while (m) {
                const int e0 = __builtin_ctzll(m); m &= m - 1;
                const int e1 = m ? __builtin_ctzll(m) : -1; if (m) m &= m - 1;
                const int p0 = __builtin_amdgcn_readlane(cpos, e0);
                const int p1 = __builtin_amdgcn_readlane(cpos, e1 >= 0 ? e1 : e0);
                const bf16_t* y0 = ye + (rb + (size_t)e0 * cap + p0) * 1024;
                const bf16_t* y1 = ye + (rb + (size_t)(e1 >= 0 ? e1 : e0) * cap + (e1 >= 0 ? p1 : p0)) * 1024;
                uint2 u0[4], u1[4];
#pragma unroll
                for (int k = 0; k < 4; ++k) { u0[k] = *(const uint2*)(y0 + k * 256 + lane * 4); u1[k] = *(const uint2*)(y1 + k * 256 + lane * 4); }
                const float s1 = (e1 >= 0) ? 1.f : 0.f;
#pragma unroll
                for (int k = 0; k < 4; ++k) {
                    v[k].x += bf_lo(u0[k].x); v[k].y += bf_hi(u0[k].x); v[k].z += bf_lo(u0[k].y); v[k].w += bf_hi(u0[k].y);
                    v[k].x += s1 * bf_lo(u1[k].x); v[k].y += s1 * bf_hi(u1[k].x); v[k].z += s1 * bf_lo(u1[k].y); v[k].w += s1 * bf_hi(u1[k].y);
                }
            }
        }
        float s = 0.f;
#pragma unroll
        for (int k = 0; k < 4; ++k) s += v[k].x + v[k].y + v[k].z + v[k].w;
        const float mu = wave_sum(s) * (1.f / 1024.f);
        float q = 0.f;
#pragma unroll
        for (int k = 0; k < 4; ++k) {
            v[k].x -= mu; v[k].y -= mu; v[k].z -= mu; v[k].w -= mu;
            q += v[k].x * v[k].x + v[k].y * v[k].y + v[k].z * v[k].z + v[k].w * v[k].w;
        }
        const float rstd = rsqrtf(wave_sum(q) * (1.f / 1024.f) + LN_EPS);
#pragma unroll
        for (int k = 0; k < 4; ++k) {
            const float4 g = *(const float4*)(gam + k * 256 + lane * 4);
            const float4 b = *(const float4*)(bet + k * 256 + lane * 4);
            v[k].x = v[k].x * rstd * g.x + b.x; v[k].y = v[k].y * rstd * g.y + b.y;
            v[k].z = v[k].z * rstd * g.z + b.z; v[k].w = v[k].w * rstd * g.w + b.w;
            *(float4*)(xr + k * 256 + lane * 4) = v[k];
            if (WRITE_XB) *(uint2*)(xb + (size_t)tok * 1024 + k * 256 + lane * 4) = make_uint2(pk_bf16(v[k].x, v[k].y), pk_bf16(v[k].z, v[k].w));
        }
        if (ROUTER) {
            float mylog = -1e30f;
#pragma unroll 2
            for (int e = 0; e < 16; ++e) {
                float a = 0.f;
#pragma unroll
                for (int k = 0; k < 4; ++k) {
                    const float4 wv = *(const float4*)(wrT + e * 1024 + k * 256 + lane * 4);
                    a += v[k].x * wv.x + v[k].y * wv.y + v[k].z * wv.z + v[k].w * wv.w;
                }
                a = wave_sum(a);
                if (lane == e) mylog = a;
            }
            const float mx = row16_max(mylog);
            const float ex = (lane < 16) ? expf(mylog - mx) : 0.f;
            const float mine = ex / row16_sum(ex);
            if (lane < 16) {
                const int trunk = tok >= T_PROMPT;
                const int tt = trunk ? T3 : T_PROMPT;
                const int tl = trunk ? tok - T_PROMPT : tok;
                aff[(trunk ? (size_t)T_PROMPT * 16 : 0) + (size_t)lane * tt + tl] = mine;
            }
        }
    }
    __syncthreads();
}

template <int NPT>
__device__ __forceinline__ void topk_item(const float* a, int cap, int* idx, float* gate, int* pos, int e, char* smem, const int TID) {
    int* part = (int*)smem;
    int* sh_cnt = (int*)(smem + 64);
    unsigned key[NPT];
#pragma unroll
    for (int k = 0; k < NPT; ++k) key[k] = __float_as_uint(a[k * NT + TID]);
    if (TID == 0) *sh_cnt = 0;
    const int lane = TID & 63, w = TID >> 6;
    u64 pref = 0ull;
    for (int bit = 45; bit >= 0; --bit) {
        const u64 cand = pref | (1ull << bit);
        const unsigned cb = (unsigned)(cand >> 15), ci = (unsigned)(cand & 32767ull);
        int c = 0;
        const int lim = 32767 - TID - (int)ci;
#pragma unroll
        for (int k = 0; k < NPT; ++k) c += (key[k] > cb || (key[k] == cb && k * NT <= lim)) ? 1 : 0;
#pragma unroll
        for (int o = 32; o > 0; o >>= 1) c += __shfl_xor(c, o, 64);
        int* pp = part + (bit & 1) * 8;
        if (lane == 0) pp[w] = c;
        __syncthreads();
        const int tot = pp[0] + pp[1] + pp[2] + pp[3] + pp[4] + pp[5] + pp[6] + pp[7];
        if (tot >= cap) pref = cand;
    }
    const unsigned cb = (unsigned)(pref >> 15), ci = (unsigned)(pref & 32767ull);
    int mine = 0;
    const int lim = 32767 - TID - (int)ci;
#pragma unroll
    for (int k = 0; k < NPT; ++k) mine += (key[k] > cb || (key[k] == cb && k * NT <= lim)) ? 1 : 0;
    int slot = atomicAdd(sh_cnt, mine);
    const float* ap = a + TID;
    int* pp = pos + (size_t)TID * 16 + e;
#pragma unroll 4
    for (int k = 0; k < NPT; ++k) {
        const float av = ap[(size_t)k * NT];
        const unsigned kb = __float_as_uint(av);
        const bool sel = (kb > cb || (kb == cb && k * NT <= lim));
        int ps = -1;
        if (sel) { ps = slot++; idx[ps] = k * NT + TID; gate[ps] = av; }
        pp[(size_t)k * (NT * 16)] = ps;
    }
    __syncthreads();
}
__device__ void topk_phase(const Params& p, char* smem, const int TID) {
    const float* aff = (const float*)(p.ws + M_AFF);
    int* idx = (int*)(p.ws + M_IDX);
    float* gate = (float*)(p.ws + M_GATE);
    int* pos = (int*)(p.ws + M_POS);
    for (int item = blockIdx.x; item < 32; item += gridDim.x) {
        const int trunk = item >> 4, e = item & 15;
        if (trunk == 0) topk_item<64>(aff + (size_t)e * T_PROMPT, CAP_P, idx + (size_t)e * CAP_P, gate + (size_t)e * CAP_P, pos, e, smem, TID);
        else topk_item<32>(aff + (size_t)T_PROMPT * 16 + (size_t)e * T3, CAP_S, idx + (size_t)16 * CAP_P + (size_t)e * CAP_S, gate + (size_t)16 * CAP_P + (size_t)e * CAP_S,
                           pos + (size_t)T_PROMPT * 16, e, smem, TID);
    }
}

typedef unsigned u32x2v __attribute__((ext_vector_type(2)));
__device__ __forceinline__ float xrow_max(float v) {
    u32x2v r = __builtin_amdgcn_permlane16_swap(__float_as_uint(v), __float_as_uint(v), false, false);
    v = fmaxf(__uint_as_float(r[0]), __uint_as_float(r[1]));
    r = __builtin_amdgcn_permlane32_swap(__float_as_uint(v), __float_as_uint(v), false, false);
    return fmaxf(__uint_as_float(r[0]), __uint_as_float(r[1]));
}
__device__ __forceinline__ float xrow_sum(float v) {
    u32x2v r = __builtin_amdgcn_permlane16_swap(__float_as_uint(v), __float_as_uint(v), false, false);
    v = __uint_as_float(r[0]) + __uint_as_float(r[1]);
    r = __builtin_amdgcn_permlane32_swap(__float_as_uint(v), __float_as_uint(v), false, false);
    return __uint_as_float(r[0]) + __uint_as_float(r[1]);
}

constexpr int NA_VSTR = 1936;
constexpr int NA_SK = 0, NA_SV = 61440, NA_SB = 61440 + 32 * NA_VSTR;
__device__ void na_phase(const Params& p, char* smem, const int TID) {
    const bf16_t* Qh = (const bf16_t*)(p.ws + N_Q);
    const bf16_t* Kh = (const bf16_t*)(p.ws + N_K);
    const bf16_t* NVt = (const bf16_t*)(p.ws + N_VT);
    bf16_t* O = (bf16_t*)(p.ws + M_XB2);
    char* sK = smem + NA_SK; char* sV = smem + NA_SV; float* sB = (float*)(smem + NA_SB);
    const int lane = TID & 63, w = TID >> 6, qi = lane & 15, hi = lane >> 4;
    for (int item = blockIdx.x; item < 96 * 32; item += gridDim.x) {
        const int h = item & 31, rgp = item >> 5;
        int seq_base, rows, g;
        if (rgp < 64) { seq_base = (rgp >> 2) * 2048; rows = 32; g = rgp & 3; }
        else { seq_base = T_PROMPT; rows = 256; g = rgp - 64; }
        const int r0 = g * 8;
        const int rs0 = min(max(r0 - 4, 0), rows - 8), rs1 = min(max(r0 + 3, 0), rows - 8);
        const int nrows = rs1 + 8 - rs0;
        __syncthreads();
        {
            const uint4* src = (const uint4*)(Kh + ((size_t)h * T_ALL + seq_base + rs0 * 64) * 32);
            const int nk16 = nrows * 256, nv16 = nrows * 8;
            uint4 kv[8], vv[8];
#pragma unroll
            for (int i = 0; i < 8; ++i) kv[i] = src[min(TID + i * NT, nk16 - 1)];
#pragma unroll
            for (int j = 0; j < 4; ++j) {
                const uint4* vs = (const uint4*)(NVt + (size_t)(h * 32 + w + 8 * j) * T_ALL + seq_base + rs0 * 64);
#pragma unroll
                for (int i = 0; i < 2; ++i) vv[j * 2 + i] = vs[min(lane + 64 * i, nv16 - 1)];
            }
#define NA_PIN4(v) asm volatile("" : "+v"((v).x), "+v"((v).y), "+v"((v).z), "+v"((v).w))
#pragma unroll
            for (int i = 0; i < 8; ++i) { NA_PIN4(kv[i]); NA_PIN4(vv[i]); }
#undef NA_PIN4
#pragma unroll
            for (int i = 0; i < 8; ++i) { const int c = TID + i * NT; if (c < nk16) ((uint4*)sK)[c] = kv[i]; }
#pragma unroll
            for (int j = 0; j < 4; ++j)
#pragma unroll
                for (int i = 0; i < 2; ++i) { const int c = lane + 64 * i; if (c < nv16) *(uint4*)(sV + (w + 8 * j) * NA_VSTR + c * 16) = vv[j * 2 + i]; }
            for (int c = TID; c < 465; c += NT) sB[c] = p.na_rpb[h * 465 + c] * 1.4426950408889634f;
        }
        __syncthreads();
        const int r = r0 + w;
        const int rs = min(max(r - 4, 0), rows - 8);
        const int lr0 = rs - rs0;
#pragma unroll 1
        for (int qb = 0; qb < 4; ++qb) {
            const int c = qb * 16 + qi;
            const int cs = min(max(c - 8, 0), 48);
            const int kb0 = min(max(qb - 1, 0), 1);
            const int tq = seq_base + r * 64 + c;
            const bf16x8 qf = *(const bf16x8*)(Qh + ((size_t)h * T_ALL + tq) * 32 + hi * 8);
            typedef float f32x2v __attribute__((ext_vector_type(2)));
            f32x2v s[24][2];
            f32x2v mk[3][2];
#pragma unroll
            for (int jb = 0; jb < 3; ++jb)
#pragma unroll
                for (int e = 0; e < 4; ++e) {
                    const int kcol = (kb0 + jb) * 16 + 4 * hi + e;
                    mk[jb][e >> 1][e & 1] = ((kcol >= cs) && (kcol < cs + 16)) ? 0.f : -1e30f;
                }
            float mx = -1e30f;
#pragma unroll
            for (int a = 0; a < 8; ++a)
#pragma unroll
                for (int jb = 0; jb < 3; ++jb) {
                    const int kcb = (kb0 + jb) * 16;
                    const bf16x8 kf = *(const bf16x8*)(sK + ((lr0 + a) * 64 + kcb + qi) * 64 + hi * 16);
                    f32x4 z = {0.f, 0.f, 0.f, 0.f};
                    const f32x4 sc = __builtin_amdgcn_mfma_f32_16x16x32_bf16(kf, qf, z, 0, 0, 0);
                    const float* rpr = sB + (rs + a - r + 7) * 31;
                    f32x2v bv[2];
#pragma unroll
                    for (int e = 0; e < 4; ++e) bv[e >> 1][e & 1] = rpr[min(max(kcb + 4 * hi + e - c + 15, 0), 30)];
                    const f32x2v v0 = (f32x2v){sc[0], sc[1]} + (bv[0] + mk[jb][0]);
                    const f32x2v v1 = (f32x2v){sc[2], sc[3]} + (bv[1] + mk[jb][1]);
                    s[a * 3 + jb][0] = v0; s[a * 3 + jb][1] = v1;
                    mx = fmaxf(fmaxf(mx, fmaxf(v0[0], v0[1])), fmaxf(v1[0], v1[1]));
                }
            mx = xrow_max(mx);
            const f32x2v mxv = {mx, mx};
            f32x2v sumv = {0.f, 0.f};
#pragma unroll
            for (int t = 0; t < 24; ++t)
#pragma unroll
                for (int hh = 0; hh < 2; ++hh) {
                    const f32x2v d = s[t][hh] - mxv;
                    f32x2v pv; pv[0] = __builtin_amdgcn_exp2f(d[0]); pv[1] = __builtin_amdgcn_exp2f(d[1]);
                    s[t][hh] = pv; sumv += pv;
                }
            const float inv = __builtin_amdgcn_rcpf(xrow_sum(sumv[0] + sumv[1]));
            const f32x2v invv = {inv, inv};
            f32x4 o0 = {0.f, 0.f, 0.f, 0.f}, o1 = {0.f, 0.f, 0.f, 0.f};
            const char* vr0 = sV + qi * NA_VSTR;
            const char* vr1 = sV + (16 + qi) * NA_VSTR;
#pragma unroll
            for (int pi = 0; pi < 12; ++pi) {
                const int t0 = 2 * pi, t1 = 2 * pi + 1;
                const int ka = ((lr0 + t0 / 3) * 64 + (kb0 + t0 % 3) * 16 + 4 * hi) * 2;
                const int kb = ((lr0 + t1 / 3) * 64 + (kb0 + t1 % 3) * 16 + 4 * hi) * 2;
                union { bf16x8 v; unsigned u[4]; } pf, v0, v1;
                const f32x2v q00 = s[t0][0] * invv, q01 = s[t0][1] * invv, q10 = s[t1][0] * invv, q11 = s[t1][1] * invv;
                pf.u[0] = pk_bf16(q00[0], q00[1]); pf.u[1] = pk_bf16(q01[0], q01[1]);
                pf.u[2] = pk_bf16(q10[0], q10[1]); pf.u[3] = pk_bf16(q11[0], q11[1]);
                const uint2 a0 = *(const uint2*)(vr0 + ka), b0 = *(const uint2*)(vr0 + kb);
                const uint2 a1 = *(const uint2*)(vr1 + ka), b1 = *(const uint2*)(vr1 + kb);
                v0.u[0] = a0.x; v0.u[1] = a0.y; v0.u[2] = b0.x; v0.u[3] = b0.y;
                v1.u[0] = a1.x; v1.u[1] = a1.y; v1.u[2] = b1.x; v1.u[3] = b1.y;
                o0 = __builtin_amdgcn_mfma_f32_16x16x32_bf16(pf.v, v0.v, o0, 0, 0, 0);
                o1 = __builtin_amdgcn_mfma_f32_16x16x32_bf16(pf.v, v1.v, o1, 0, 0, 0);
            }
#pragma unroll
            for (int e = 0; e < 4; ++e) {
                const int q = 4 * hi + e;
                bf16_t* dst = O + (size_t)(seq_base + r * 64 + qb * 16 + q) * 1024 + h * 32 + qi;
                dst[0] = f2bf(o0[e]);
                dst[16] = f2bf(o1[e]);
            }
        }
    }
}

#define XB_TMO      128
#define XB_XCNT(j)  (256  + 64 * (j))
#define XB_XSUB(j)  (1280 + 64 * (j))
#define XB_XGEN(j)  (2304 + 64 * (j))
#define XB_TOP      3328
#define XB_TOPGEN   3392
#define XCD_BAR_WORDS 3456
#define XB_SPIN_CAP (1u << 18)
__device__ __forceinline__ unsigned xb_ld(unsigned* p)              { return __hip_atomic_load(p, __ATOMIC_RELAXED, __HIP_MEMORY_SCOPE_AGENT); }
__device__ __forceinline__ unsigned xb_add(unsigned* p, unsigned v) { return __hip_atomic_fetch_add(p, v, __ATOMIC_RELAXED, __HIP_MEMORY_SCOPE_AGENT); }
__device__ __forceinline__ unsigned xb_xcc_id() { return (unsigned)__builtin_amdgcn_s_getreg((3 << 11) | 20) & 0xFu; }
#define XB_SPIN(cond, bar) do { unsigned _sp = 0; while (cond) { __builtin_amdgcn_s_sleep(1); \
    if ((++_sp & 255u) == 0u) { if (xb_ld(&(bar)[XB_TMO])) break; if (_sp > XB_SPIN_CAP) { atomicAdd(&(bar)[XB_TMO], 1u); break; } } } } while (0)
struct XcdBarrier { unsigned* bar; unsigned x; volatile LAS3 unsigned* st; };
__device__ __forceinline__ XcdBarrier xcd_barrier_post(unsigned* bar, volatile LAS3 unsigned* st, int tid) {
    XcdBarrier b; b.bar = bar; b.x = xb_xcc_id(); b.st = st;
    if (tid == 0) (void)xb_add(&bar[XB_XCNT(b.x)], 1u);
    return b;
}
__device__ __forceinline__ void xcd_barrier_complete(unsigned* bar, unsigned x, unsigned& nloc, unsigned& nx) {
    const unsigned G = gridDim.x * gridDim.y * gridDim.z;
    unsigned sum, cnt, mine, sp = 0u;
    for (;;) {
        sum = 0u; cnt = 0u; mine = 0u;
#pragma unroll
        for (unsigned j = 0; j < 16; ++j) { const unsigned c = xb_ld(&bar[XB_XCNT(j)]); sum += c; cnt += (c > 0u) ? 1u : 0u; mine = (j == x) ? c : mine; }
        if (sum == G) break;
        __builtin_amdgcn_s_sleep(1);
        if ((++sp & 255u) == 0u) { if (xb_ld(&bar[XB_TMO])) break; if (sp > XB_SPIN_CAP) { atomicAdd(&bar[XB_TMO], 1u); break; } }
    }
    nloc = mine > 0u ? mine : 1u; nx = cnt > 0u ? cnt : 1u;
}
__device__ __forceinline__ void xcd_barrier(const XcdBarrier& b, int tid) {
    asm volatile("s_waitcnt vmcnt(0)" ::: "memory");
    __syncthreads();
    if (tid == 0) {
        unsigned* bar = b.bar;
        __builtin_amdgcn_s_waitcnt(0);
        unsigned nloc = b.st[0], nx = b.st[1];
        if (nloc == 0u) { xcd_barrier_complete(bar, b.x, nloc, nx); b.st[0] = nloc; b.st[1] = nx; }
        const unsigned old = xb_add(&bar[XB_XSUB(b.x)], 1u);
        const unsigned gen = old / nloc;
        if (old + 1u == (gen + 1u) * nloc) {
            __builtin_amdgcn_fence(__ATOMIC_RELEASE, "agent");
            asm volatile("s_waitcnt vmcnt(0)" ::: "memory");
            const unsigned og = xb_add(&bar[XB_TOP], 1u);
            const unsigned tg = og / nx;
            if (og + 1u == (tg + 1u) * nx) xb_add(&bar[XB_TOPGEN], 1u);
            else XB_SPIN(xb_ld(&bar[XB_TOPGEN]) == tg, bar);
            __builtin_amdgcn_fence(__ATOMIC_ACQUIRE, "agent");
            xb_add(&bar[XB_XGEN(b.x)], 1u);
            asm volatile("s_waitcnt vmcnt(0)" ::: "memory");
        } else {
            XB_SPIN(xb_ld(&bar[XB_XGEN(b.x)]) == gen, bar);
            __builtin_amdgcn_fence(__ATOMIC_ACQUIRE, "agent");
            asm volatile("s_waitcnt vmcnt(0)" ::: "memory");
        }
    }
    __syncthreads();
}

__device__ __forceinline__ bool tile_map(int k, int MT, int NTN, int MS, int NS, int& m, int& n) {
    const int bid = blockIdx.x;
    if (gridDim.x != 256) { const int t = k * gridDim.x + bid; if (t >= MT * NTN) return false; m = t / NTN; n = t % NTN; return true; }
    const int NG = NTN / NS, total = (MT / MS) * NG;
    const int s = k * 8 + (bid & 7);
    if (s >= total) return false;
    const int j = bid >> 3;
    m = (s / NG) * MS + j / NS; n = (s % NG) * NS + j % NS;
    return true;
}

enum { PH_PRE = 0, PH_R0 = 1  , PH_LN0A = 16, PH_TOPK0, PH_MOE1_0, PH_MOE2_0, PH_LN0B, PH_QKV, PH_NA, PH_NAOUT, PH_LN1A, PH_TOPK1, PH_MOE1_1, PH_MOE2_1, PH_LN1B, PH_COUNT };

namespace pg8 {
#define PG8_LAS __attribute__((address_space(3)))
typedef unsigned short bf16_t;
typedef short bf16x8 __attribute__((ext_vector_type(8)));
typedef float f32x4 __attribute__((ext_vector_type(4)));
typedef unsigned u32x4 __attribute__((ext_vector_type(4)));
constexpr int BM = 256, BK = 64, HALF = 128, HTB = HALF * BK * 2  , STAGE_BYTES = 8 * HTB, NXCD = 8, WGM = 8;

__host__ __device__ __forceinline__ int lds_byte(int r, int c) { const int st = (r >> 4) * 2 + (c >> 5), rr = r & 15, cc = c & 31, ob = rr * 64 + cc * 2; return st * 1024 + (ob ^ (((ob >> 9) & 1) << 5)); }
__host__ __device__ __forceinline__ void stage_rc(int b, int& R, int& C) { const int st = b / 1024, sb = b % 1024, swz = sb ^ (((sb >> 9) & 1) << 5); R = (st >> 1) * 16 + swz / 64; C = (st & 1) * 32 + (swz % 64) / 2; }
__host__ __device__ __forceinline__ int perm32(int rho) { const int n = rho >> 4, i = rho & 15; return 8 * (i >> 2) + 4 * n + (i & 3); }

struct Unit { int pm, pn; };
struct Gemm { const bf16_t* A; const bf16_t* Bt; int M, N, K; };

template <class Epi, class Sched, bool STAMP = false>
__device__ __forceinline__ void gemm_phase(PG8_LAS unsigned char* lds, const Gemm g, const Sched& S, const Epi& E, unsigned long long* stamps, const int tid_in) {
    const int tid = tid_in, wid = __builtin_amdgcn_readfirstlane(tid >> 6), lane = tid & 63, wr = wid >> 2, wc = wid & 3, fr = lane & 15, fq = lane >> 4;
    const int K = g.K, nt = K / BK;
    int ts_lo = 0, ts_hi = 0, nts = 0; const unsigned long long rt_entry = STAMP ? (unsigned long long)wall_clock64() : 0ull;
#define PG8_STAMP() do { if (STAMP && wid == 0 && nts < 64) { const unsigned long long _c = (unsigned long long)clock64(); \
        ts_lo = (lane == nts) ? (int)(unsigned)_c : ts_lo; ts_hi = (lane == nts) ? (int)(unsigned)(_c >> 32) : ts_hi; ++nts; } } while (0)
    PG8_STAMP();
    unsigned voffA[2], voffB[2];
#pragma unroll
    for (int i = 0; i < 2; ++i) { int R, C; stage_rc(tid * 16 + i * 8192, R, C); const int Rb = Epi::PERM ? ((R & ~31) + perm32(R & 31)) : R;
        voffA[i] = (unsigned)(R * K + C) * 2u; voffB[i] = (unsigned)(Rb * K + C) * 2u; }
    const size_t kstep = (size_t)(BK * 2);
    const size_t hstep = (size_t)HALF * K * 2;
    const size_t tstep = 2 * hstep;
    const unsigned ldsw = (unsigned)wid * 1024u;
    const int aoff = lds_byte(wr * 64 + fr, fq * 8), boff = lds_byte(wc * 32 + fr, fq * 8);
#define PG8_SA(b, h) (((b) * 2 + (h)) * HTB)
#define PG8_SB(b, h) ((4 + (b) * 2 + (h)) * HTB)
#define PG8_STAGE(bufoff, gbase, voff) do { _Pragma("unroll") for (int _i = 0; _i < 2; ++_i) \
        __builtin_amdgcn_global_load_lds((const unsigned*)((const char*)(gbase) + (voff)[_i]), (PG8_LAS unsigned*)(lds + (bufoff) + ldsw + _i * 8192), 16, 0, 0); } while (0)
#define PG8_LDA(dst, b, h) do { _Pragma("unroll") for (int m = 0; m < 4; ++m) _Pragma("unroll") for (int k = 0; k < 2; ++k) dst[m][k] = *(const PG8_LAS bf16x8*)(lds + PG8_SA(b, h) + aoff + m * 2048 + k * 1024); } while (0)
#define PG8_LDB(dst, b, h) do { _Pragma("unroll") for (int n = 0; n < 2; ++n) _Pragma("unroll") for (int k = 0; k < 2; ++k) dst[n][k] = *(const PG8_LAS bf16x8*)(lds + PG8_SB(b, h) + boff + n * 2048 + k * 1024); } while (0)
#define PG8_MMA(ai, bj, At, Bt) do { __builtin_amdgcn_s_setprio(1); _Pragma("unroll") for (int m = 0; m < 4; ++m) _Pragma("unroll") for (int n = 0; n < 2; ++n) _Pragma("unroll") for (int k = 0; k < 2; ++k) \
        acc[ai][bj][m][n] = __builtin_amdgcn_mfma_f32_16x16x32_bf16(Bt[n][k], At[m][k], acc[ai][bj][m][n], 0, 0, 0); __builtin_amdgcn_s_setprio(0); } while (0)
#define PG8_WAIT_V(n) asm volatile("s_waitcnt vmcnt(" #n ")" ::: "memory")
#define PG8_WAIT_L(n) asm volatile("s_waitcnt lgkmcnt(" #n ")" ::: "memory")
#define PG8_BAR __builtin_amdgcn_s_barrier()
#define PG8_SCHED __builtin_amdgcn_sched_barrier(0)
    Unit cur, nxt; int ui = 0;
    if (!S.next(0, cur)) return;
    f32x4 acc[2][2][4][2];
#pragma unroll
    for (int a = 0; a < 2; ++a)
#pragma unroll
        for (int b = 0; b < 2; ++b)
#pragma unroll
            for (int m = 0; m < 4; ++m)
#pragma unroll
                for (int n = 0; n < 2; ++n) acc[a][b][m][n] = (f32x4){0.f, 0.f, 0.f, 0.f};
    bf16x8 At[4][2], B0[2][2], B1[2][2];
    const char* cA = (const char*)g.A + (size_t)cur.pm * tstep; const char* cB = (const char*)g.Bt + (size_t)cur.pn * tstep;
    S.a_ready(cur);
    PG8_STAGE(PG8_SB(0, 0), cB, voffB); PG8_STAGE(PG8_SA(0, 0), cA, voffA); PG8_STAGE(PG8_SB(0, 1), cB + hstep, voffB); PG8_STAGE(PG8_SA(0, 1), cA + hstep, voffA);
    if (wr == 1) PG8_BAR;
    PG8_WAIT_V(4); PG8_BAR;
    PG8_STAGE(PG8_SB(1, 0), cB + kstep, voffB); PG8_STAGE(PG8_SA(1, 0), cA + kstep, voffA); PG8_STAGE(PG8_SB(1, 1), cB + hstep + kstep, voffB);
    PG8_WAIT_V(6); PG8_BAR;
    PG8_STAMP();
    for (;;) {
        const bool has_next = S.next(ui + 1, nxt);
        const char* nA = has_next ? (const char*)g.A + (size_t)nxt.pm * tstep : cA; const char* nB = has_next ? (const char*)g.Bt + (size_t)nxt.pn * tstep : cB;
        for (int t = 0; t < nt; t += 2) {
            const bool last = (t == nt - 2);
            const char* a1 = cA + (size_t)(t + 1) * kstep;
            const char* a2 = last ? nA : cA + (size_t)(t + 2) * kstep; const char* b2 = last ? nB : cB + (size_t)(t + 2) * kstep;
            const char* a3 = a2 + kstep; const char* b3 = b2 + kstep;
            if (last && has_next) S.a_ready(nxt);
            PG8_LDB(B0, 0, 0); PG8_SCHED; PG8_LDA(At, 0, 0); PG8_STAGE(PG8_SA(1, 1), a1 + hstep, voffA);
            PG8_WAIT_L(8); PG8_BAR; PG8_WAIT_L(0); PG8_MMA(0, 0, At, B0); PG8_BAR; PG8_SCHED;
            PG8_LDB(B1, 0, 1); PG8_STAGE(PG8_SB(0, 0), b2, voffB);
            PG8_BAR; PG8_WAIT_L(0); PG8_MMA(0, 1, At, B1); PG8_BAR;
            PG8_LDA(At, 0, 1); PG8_STAGE(PG8_SA(0, 0), a2, voffA);
            PG8_BAR; PG8_WAIT_L(0); PG8_MMA(1, 0, At, B0); PG8_BAR; PG8_SCHED;
            PG8_STAGE(PG8_SB(0, 1), b2 + hstep, voffB);
            PG8_WAIT_V(6); PG8_BAR; PG8_MMA(1, 1, At, B1); PG8_BAR;
            PG8_LDB(B0, 1, 0); PG8_SCHED; PG8_LDA(At, 1, 0); PG8_STAGE(PG8_SA(0, 1), a2 + hstep, voffA);
            PG8_WAIT_L(8); PG8_BAR; PG8_WAIT_L(0); PG8_MMA(0, 0, At, B0); PG8_BAR; PG8_SCHED;
            PG8_LDB(B1, 1, 1); PG8_STAGE(PG8_SB(1, 0), b3, voffB);
            PG8_BAR; PG8_WAIT_L(0); PG8_MMA(0, 1, At, B1); PG8_BAR;
            PG8_LDA(At, 1, 1); PG8_STAGE(PG8_SA(1, 0), a3, voffA);
            PG8_BAR; PG8_WAIT_L(0); PG8_MMA(1, 0, At, B0); PG8_BAR; PG8_SCHED;
            PG8_STAGE(PG8_SB(1, 1), b3 + hstep, voffB);
            PG8_WAIT_V(6); PG8_BAR; PG8_MMA(1, 1, At, B1); PG8_BAR;
        }
        PG8_STAMP();
        if constexpr (!Epi::AFTER_DRAIN) { E(acc, cur, wr, wc, fr, fq); S.done(cur); }
        PG8_STAMP();
        if (!has_next) break;
#pragma unroll
        for (int a = 0; a < 2; ++a)
#pragma unroll
            for (int b = 0; b < 2; ++b)
#pragma unroll
                for (int m = 0; m < 4; ++m)
#pragma unroll
                    for (int n = 0; n < 2; ++n) acc[a][b][m][n] = (f32x4){0.f, 0.f, 0.f, 0.f};
        cur = nxt; cA = nA; cB = nB; ++ui;
    }
    PG8_WAIT_V(0);
    if (wr == 0) PG8_BAR;
    PG8_BAR;
    if constexpr (Epi::AFTER_DRAIN) { E.fused(acc, cur, wr, wc, fr, fq, lds, wid, lane); S.done(cur); }
    PG8_STAMP();
    if (STAMP && wid == 0) { stamps[lane] = lane < nts ? (((unsigned long long)(unsigned)ts_hi << 32) | (unsigned)ts_lo) : 0ull;
        if (lane == 62) stamps[62] = rt_entry; if (lane == 63) stamps[63] = (unsigned long long)wall_clock64(); }
#undef PG8_STAMP
#undef PG8_SA
#undef PG8_SB
#undef PG8_STAGE
#undef PG8_LDA
#undef PG8_LDB
#undef PG8_MMA
#undef PG8_WAIT_V
#undef PG8_WAIT_L
#undef PG8_BAR
#undef PG8_SCHED
}
template <class Epi, class Sched, bool STAMP = false>
__device__ __forceinline__ void gemm_phase_gather(PG8_LAS unsigned char* lds, const Gemm g, const Sched& S, const Epi& E, unsigned long long* stamps, const int tid_in, const int* gidx, int split_row, int split_add) {
    const int tid = tid_in, wid = __builtin_amdgcn_readfirstlane(tid >> 6), lane = tid & 63, wr = wid >> 2, wc = wid & 3, fr = lane & 15, fq = lane >> 4;
    const int K = g.K, nt = K / BK;
    int ts_lo = 0, ts_hi = 0, nts = 0; const unsigned long long rt_entry = STAMP ? (unsigned long long)wall_clock64() : 0ull;
#define PG8_STAMP() do { if (STAMP && wid == 0 && nts < 64) { const unsigned long long _c = (unsigned long long)clock64(); \
        ts_lo = (lane == nts) ? (int)(unsigned)_c : ts_lo; ts_hi = (lane == nts) ? (int)(unsigned)(_c >> 32) : ts_hi; ++nts; } } while (0)
    PG8_STAMP();
    unsigned voffA[2], voffB[2];
    int Rg[2], Cg[2];
#pragma unroll
    for (int i = 0; i < 2; ++i) { int R, C; stage_rc(tid * 16 + i * 8192, R, C); const int Rb = Epi::PERM ? ((R & ~31) + perm32(R & 31)) : R;
        voffA[i] = (unsigned)(R * K + C) * 2u; voffB[i] = (unsigned)(Rb * K + C) * 2u; Rg[i] = R; Cg[i] = C; }
    unsigned voffC[2][2], voffN[2][2];
#define PG8_GOFF(dst, unit) do { _Pragma("unroll") for (int _h = 0; _h < 2; ++_h) _Pragma("unroll") for (int _i = 0; _i < 2; ++_i) { \
        const int _r = (unit).pm * BM + _h * HALF + Rg[_i]; const int _src = gidx[_r] + (_r >= split_row ? split_add : 0); dst[_h][_i] = (unsigned)(_src * K + Cg[_i]) * 2u; } } while (0)
#define PG8_STAGE_A(bufoff, kbytes, VO, h) do { _Pragma("unroll") for (int _i = 0; _i < 2; ++_i) \
        __builtin_amdgcn_global_load_lds((const unsigned*)(cA + (kbytes) + (VO)[h][_i]), (PG8_LAS unsigned*)(lds + (bufoff) + ldsw + _i * 8192), 16, 0, 0); } while (0)
    const size_t kstep = (size_t)(BK * 2);
    const size_t hstep = (size_t)HALF * K * 2;
    const size_t tstep = 2 * hstep;
    const unsigned ldsw = (unsigned)wid * 1024u;
    const int aoff = lds_byte(wr * 64 + fr, fq * 8), boff = lds_byte(wc * 32 + fr, fq * 8);
#define PG8_SA(b, h) (((b) * 2 + (h)) * HTB)
#define PG8_SB(b, h) ((4 + (b) * 2 + (h)) * HTB)
#define PG8_STAGE(bufoff, gbase, voff) do { _Pragma("unroll") for (int _i = 0; _i < 2; ++_i) \
        __builtin_amdgcn_global_load_lds((const unsigned*)((const char*)(gbase) + (voff)[_i]), (PG8_LAS unsigned*)(lds + (bufoff) + ldsw + _i * 8192), 16, 0, 0); } while (0)
#define PG8_LDA(dst, b, h) do { _Pragma("unroll") for (int m = 0; m < 4; ++m) _Pragma("unroll") for (int k = 0; k < 2; ++k) dst[m][k] = *(const PG8_LAS bf16x8*)(lds + PG8_SA(b, h) + aoff + m * 2048 + k * 1024); } while (0)
#define PG8_LDB(dst, b, h) do { _Pragma("unroll") for (int n = 0; n < 2; ++n) _Pragma("unroll") for (int k = 0; k < 2; ++k) dst[n][k] = *(const PG8_LAS bf16x8*)(lds + PG8_SB(b, h) + boff + n * 2048 + k * 1024); } while (0)
#define PG8_MMA(ai, bj, At, Bt) do { __builtin_amdgcn_s_setprio(1); _Pragma("unroll") for (int m = 0; m < 4; ++m) _Pragma("unroll") for (int n = 0; n < 2; ++n) _Pragma("unroll") for (int k = 0; k < 2; ++k) \
        acc[ai][bj][m][n] = __builtin_amdgcn_mfma_f32_16x16x32_bf16(Bt[n][k], At[m][k], acc[ai][bj][m][n], 0, 0, 0); __builtin_amdgcn_s_setprio(0); } while (0)
#define PG8_WAIT_V(n) asm volatile("s_waitcnt vmcnt(" #n ")" ::: "memory")
#define PG8_WAIT_L(n) asm volatile("s_waitcnt lgkmcnt(" #n ")" ::: "memory")
#define PG8_BAR __builtin_amdgcn_s_barrier()
#define PG8_SCHED __builtin_amdgcn_sched_barrier(0)
    Unit cur, nxt; int ui = 0;
    if (!S.next(0, cur)) return;
    f32x4 acc[2][2][4][2];
#pragma unroll
    for (int a = 0; a < 2; ++a)
#pragma unroll
        for (int b = 0; b < 2; ++b)
#pragma unroll
            for (int m = 0; m < 4; ++m)
#pragma unroll
                for (int n = 0; n < 2; ++n) acc[a][b][m][n] = (f32x4){0.f, 0.f, 0.f, 0.f};
    bf16x8 At[4][2], B0[2][2], B1[2][2];
    const char* cA = (const char*)g.A; const char* cB = (const char*)g.Bt + (size_t)cur.pn * tstep;
    S.a_ready(cur);
    PG8_GOFF(voffC, cur);
    PG8_STAGE(PG8_SB(0, 0), cB, voffB); PG8_STAGE_A(PG8_SA(0, 0), 0, voffC, 0); PG8_STAGE(PG8_SB(0, 1), cB + hstep, voffB); PG8_STAGE_A(PG8_SA(0, 1), 0, voffC, 1);
    if (wr == 1) PG8_BAR;
    PG8_WAIT_V(4); PG8_BAR;
    PG8_STAGE(PG8_SB(1, 0), cB + kstep, voffB); PG8_STAGE_A(PG8_SA(1, 0), kstep, voffC, 0); PG8_STAGE(PG8_SB(1, 1), cB + hstep + kstep, voffB);
    PG8_WAIT_V(6); PG8_BAR;
    PG8_STAMP();
    for (;;) {
        const bool has_next = S.next(ui + 1, nxt);
        const char* nB = has_next ? (const char*)g.Bt + (size_t)nxt.pn * tstep : cB;
#pragma unroll
        for (int _h = 0; _h < 2; ++_h)
#pragma unroll
            for (int _i = 0; _i < 2; ++_i) voffN[_h][_i] = voffC[_h][_i];
        for (int t = 0; t < nt; t += 2) {
            const bool last = (t == nt - 2);
            const size_t kb1 = (size_t)(t + 1) * kstep;
            const size_t kb2 = last ? 0 : (size_t)(t + 2) * kstep; const char* b2 = last ? nB : cB + (size_t)(t + 2) * kstep;
            const size_t kb3 = kb2 + kstep; const char* b3 = b2 + kstep;
            if (last && has_next) { S.a_ready(nxt); PG8_GOFF(voffN, nxt); }
            unsigned v2[2][2];
#pragma unroll
            for (int _h = 0; _h < 2; ++_h)
#pragma unroll
                for (int _i = 0; _i < 2; ++_i) v2[_h][_i] = last ? voffN[_h][_i] : voffC[_h][_i];
            PG8_LDB(B0, 0, 0); PG8_SCHED; PG8_LDA(At, 0, 0); PG8_STAGE_A(PG8_SA(1, 1), kb1, voffC, 1);
            PG8_WAIT_L(8); PG8_BAR; PG8_WAIT_L(0); PG8_MMA(0, 0, At, B0); PG8_BAR; PG8_SCHED;
            PG8_LDB(B1, 0, 1); PG8_STAGE(PG8_SB(0, 0), b2, voffB);
            PG8_BAR; PG8_WAIT_L(0); PG8_MMA(0, 1, At, B1); PG8_BAR;
            PG8_LDA(At, 0, 1); PG8_STAGE_A(PG8_SA(0, 0), kb2, v2, 0);
            PG8_BAR; PG8_WAIT_L(0); PG8_MMA(1, 0, At, B0); PG8_BAR; PG8_SCHED;
            PG8_STAGE(PG8_SB(0, 1), b2 + hstep, voffB);
            PG8_WAIT_V(6); PG8_BAR; PG8_MMA(1, 1, At, B1); PG8_BAR;
            PG8_LDB(B0, 1, 0); PG8_SCHED; PG8_LDA(At, 1, 0); PG8_STAGE_A(PG8_SA(0, 1), kb2, v2, 1);
            PG8_WAIT_L(8); PG8_BAR; PG8_WAIT_L(0); PG8_MMA(0, 0, At, B0); PG8_BAR; PG8_SCHED;
            PG8_LDB(B1, 1, 1); PG8_STAGE(PG8_SB(1, 0), b3, voffB);
            PG8_BAR; PG8_WAIT_L(0); PG8_MMA(0, 1, At, B1); PG8_BAR;
            PG8_LDA(At, 1, 1); PG8_STAGE_A(PG8_SA(1, 0), kb3, v2, 0);
            PG8_BAR; PG8_WAIT_L(0); PG8_MMA(1, 0, At, B0); PG8_BAR; PG8_SCHED;
            PG8_STAGE(PG8_SB(1, 1), b3 + hstep, voffB);
            PG8_WAIT_V(6); PG8_BAR; PG8_MMA(1, 1, At, B1); PG8_BAR;
        }
        PG8_STAMP();
        if constexpr (!Epi::AFTER_DRAIN) { E(acc, cur, wr, wc, fr, fq); S.done(cur); }
        PG8_STAMP();
        if (!has_next) break;
#pragma unroll
        for (int a = 0; a < 2; ++a)
#pragma unroll
            for (int b = 0; b < 2; ++b)
#pragma unroll
                for (int m = 0; m < 4; ++m)
#pragma unroll
                    for (int n = 0; n < 2; ++n) acc[a][b][m][n] = (f32x4){0.f, 0.f, 0.f, 0.f};
        cur = nxt; cB = nB; ++ui;
#pragma unroll
        for (int _h = 0; _h < 2; ++_h)
#pragma unroll
            for (int _i = 0; _i < 2; ++_i) voffC[_h][_i] = voffN[_h][_i];
    }
    PG8_WAIT_V(0);
    if (wr == 0) PG8_BAR;
    PG8_BAR;
    if constexpr (Epi::AFTER_DRAIN) { E.fused(acc, cur, wr, wc, fr, fq, lds, wid, lane); S.done(cur); }
    PG8_STAMP();
    if (STAMP && wid == 0) { stamps[lane] = lane < nts ? (((unsigned long long)(unsigned)ts_hi << 32) | (unsigned)ts_lo) : 0ull;
        if (lane == 62) stamps[62] = rt_entry; if (lane == 63) stamps[63] = (unsigned long long)wall_clock64(); }
#undef PG8_STAMP
#undef PG8_SA
#undef PG8_SB
#undef PG8_STAGE
#undef PG8_STAGE_A
#undef PG8_GOFF
#undef PG8_LDA
#undef PG8_LDB
#undef PG8_MMA
#undef PG8_WAIT_V
#undef PG8_WAIT_L
#undef PG8_BAR
#undef PG8_SCHED
}
}

struct Pg8SchedMoe2 {
    __device__ bool next(int i, pg8::Unit& u) const {
        int tm, nt; if (!tile_map(i, 384, 4, 8, 4, tm, nt)) return false;
        const int e = (tm < 256) ? (tm >> 4) : ((tm - 256) >> 3);
        u.pm = tm; u.pn = e * 4 + nt; return true;
    }
    __device__ __forceinline__ void a_ready(const pg8::Unit&) const {}
    __device__ __forceinline__ void done(const pg8::Unit&) const {}
};
struct Pg8EpiMoe2 {
    static constexpr bool PERM = false, AFTER_DRAIN = false;
    const float* gate; bf16_t* Y;
    __device__ __forceinline__ void operator()(const pg8::f32x4 (&acc)[2][2][4][2], const pg8::Unit& u, int wr, int wc, int fr, int fq) const {
        const int row0 = u.pm * 256 + wr * 64 + fr, col0 = (u.pn & 3) * 256 + wc * 32 + 4 * fq;
        float gts[2][4];
#pragma unroll
        for (int ai = 0; ai < 2; ++ai)
#pragma unroll
            for (int m = 0; m < 4; ++m) gts[ai][m] = gate[row0 + ai * 128 + m * 16];
#pragma unroll
        for (int ai = 0; ai < 2; ++ai)
#pragma unroll
            for (int m = 0; m < 4; ++m) {
                const int row = row0 + ai * 128 + m * 16;
                const float gt = gts[ai][m];
                bf16_t* rowp = Y + (size_t)row * 1024 + col0;
#pragma unroll
                for (int bj = 0; bj < 2; ++bj)
#pragma unroll
                    for (int n = 0; n < 2; ++n) {
                        const pg8::f32x4 v = acc[ai][bj][m][n];
                        *(uint2*)(rowp + bj * 128 + n * 16) = make_uint2(pk_bf16(v[0] * gt, v[1] * gt), pk_bf16(v[2] * gt, v[3] * gt));
                    }
            }
    }
};

struct Pg8Sched {
    int MT, NTN, MS, NS, wid, nw;
    __device__ bool next(int i, pg8::Unit& u) const {
        if (nw == 256 && gridDim.x == 256) return tile_map(i, MT, NTN, MS, NS, u.pm, u.pn);
        if (wid < 0) return false;
        const int t = wid + i * nw; if (t >= MT * NTN) return false;
        u.pm = t / NTN; u.pn = t % NTN; return true;
    }
    __device__ __forceinline__ void a_ready(const pg8::Unit&) const {}
    __device__ __forceinline__ void done(const pg8::Unit&) const {}
};
struct Pg8EpiResid {
    static constexpr bool PERM = false, AFTER_DRAIN = false;
    const float* res; float* dst;
    __device__ __forceinline__ void operator()(const pg8::f32x4 (&acc)[2][2][4][2], const pg8::Unit& u, int wr, int wc, int fr, int fq) const {
        const int row0 = u.pm * 256 + wr * 64 + fr, col0 = u.pn * 256 + wc * 32 + 4 * fq;
#pragma unroll
        for (int ai = 0; ai < 2; ++ai)
#pragma unroll
            for (int mp = 0; mp < 2; ++mp) {
                float4 x[2][2][2];
#pragma unroll
                for (int mm = 0; mm < 2; ++mm)
#pragma unroll
                    for (int bj = 0; bj < 2; ++bj)
#pragma unroll
                        for (int n = 0; n < 2; ++n)
                            x[mm][bj][n] = *(const float4*)(res + (size_t)(row0 + ai * 128 + (mp * 2 + mm) * 16) * 1024 + col0 + bj * 128 + n * 16);
#pragma unroll
                for (int mm = 0; mm < 2; ++mm)
#pragma unroll
                    for (int bj = 0; bj < 2; ++bj)
#pragma unroll
                        for (int n = 0; n < 2; ++n) {
                            const pg8::f32x4 v = acc[ai][bj][mp * 2 + mm][n];
                            const float4 xx = x[mm][bj][n];
                            *(float4*)(dst + (size_t)(row0 + ai * 128 + (mp * 2 + mm) * 16) * 1024 + col0 + bj * 128 + n * 16) =
                                make_float4(ALPHA * xx.x + v[0], ALPHA * xx.y + v[1], ALPHA * xx.z + v[2], ALPHA * xx.w + v[3]);
                        }
            }
    }
};
struct Pg8EpiQK {
    static constexpr bool PERM = false, AFTER_DRAIN = false;
    char* ws;
    __device__ __forceinline__ void operator()(const pg8::f32x4 (&acc)[2][2][4][2], const pg8::Unit& u, int wr, int wc, int fr, int fq) const {
        const int n0 = u.pn * 256;
        bf16_t* dstb = (bf16_t*)(ws + ((n0 >> 10) ? N_K : N_Q));
        const int row0 = u.pm * 256 + wr * 64 + fr;
#pragma unroll
        for (int ai = 0; ai < 2; ++ai)
#pragma unroll
            for (int m = 0; m < 4; ++m) {
                const int tok = row0 + ai * 128 + m * 16;
#pragma unroll
                for (int bj = 0; bj < 2; ++bj) {
                    const int hh = ((n0 & 1023) + bj * 128 + wc * 32) >> 5;
#pragma unroll
                    for (int n = 0; n < 2; ++n) {
                        const pg8::f32x4 v = acc[ai][bj][m][n];
                        *(uint2*)(dstb + ((size_t)hh * T_ALL + tok) * 32 + n * 16 + 4 * fq) = make_uint2(pk_bf16(v[0], v[1]), pk_bf16(v[2], v[3]));
                    }
                }
            }
    }
};
struct Pg8EpiRows {
    static constexpr bool PERM = false, AFTER_DRAIN = false;
    bf16_t* O; size_t ldc;
    __device__ __forceinline__ void operator()(const pg8::f32x4 (&acc)[2][2][4][2], const pg8::Unit& u, int wr, int wc, int fr, int fq) const {
        const int row0 = u.pm * 256 + wr * 64 + fr, col0 = u.pn * 256 + wc * 32 + 4 * fq;
#pragma unroll
        for (int ai = 0; ai < 2; ++ai)
#pragma unroll
            for (int m = 0; m < 4; ++m) {
                bf16_t* rowp = O + (size_t)(row0 + ai * 128 + m * 16) * ldc + col0;
#pragma unroll
                for (int bj = 0; bj < 2; ++bj)
#pragma unroll
                    for (int n = 0; n < 2; ++n) {
                        const pg8::f32x4 v = acc[ai][bj][m][n];
                        *(uint2*)(rowp + bj * 128 + n * 16) = make_uint2(pk_bf16(v[0], v[1]), pk_bf16(v[2], v[3]));
                    }
            }
    }
};

struct Pg8EpiQKrot {
    static constexpr bool PERM = false, AFTER_DRAIN = false;
    char* ws; int smask;
    __device__ __forceinline__ void operator()(const pg8::f32x4 (&acc)[2][2][4][2], const pg8::Unit& u, int wr, int wc, int fr, int fq) const {
        const int n0 = u.pn * 256;
        const bool isk = (n0 >> 10) != 0;
        bf16_t* nat = (bf16_t*)(ws + (isk ? R_K : R_Q));
        bf16_t* Ktb = (bf16_t*)(ws + R_KT);
        const float2* rot = (const float2*)(ws + R_ROT);
        const int row0 = u.pm * 256 + wr * 64 + fr;
#pragma unroll
        for (int ai = 0; ai < 2; ++ai) {
            float4 csv[4][2][2];
#pragma unroll
            for (int m = 0; m < 4; ++m)
#pragma unroll
                for (int bj = 0; bj < 2; ++bj) {
                    const float2* rr = rot + (size_t)((row0 + ai * 128 + m * 16) & smask) * 128 + ((((n0 & 1023) + bj * 128 + wc * 32) & 255) >> 5) * 16 + 4 * fq;
                    csv[m][bj][0] = *(const float4*)(rr); csv[m][bj][1] = *(const float4*)(rr + 2);
                }
#pragma unroll
            for (int m = 0; m < 4; ++m) {
                const int tok = row0 + ai * 128 + m * 16;
#pragma unroll
                for (int bj = 0; bj < 2; ++bj) {
                    const int cb = (n0 & 1023) + bj * 128 + wc * 32;
                    const float4 cs01 = csv[m][bj][0], cs23 = csv[m][bj][1];
                    const pg8::f32x4 x1 = acc[ai][bj][m][0], x2 = acc[ai][bj][m][1];
                    const float o10 = x1[0] * cs01.x - x2[0] * cs01.y, o20 = x1[0] * cs01.y + x2[0] * cs01.x;
                    const float o11 = x1[1] * cs01.z - x2[1] * cs01.w, o21 = x1[1] * cs01.w + x2[1] * cs01.z;
                    const float o12 = x1[2] * cs23.x - x2[2] * cs23.y, o22 = x1[2] * cs23.y + x2[2] * cs23.x;
                    const float o13 = x1[3] * cs23.z - x2[3] * cs23.w, o23 = x1[3] * cs23.w + x2[3] * cs23.z;
                    const unsigned p10 = pk_bf16(o10, o11), p11 = pk_bf16(o12, o13), p20 = pk_bf16(o20, o21), p21 = pk_bf16(o22, o23);
                    bf16_t* dst = nat + (size_t)tok * 1024 + cb + 4 * fq;
                    *(uint2*)dst = make_uint2(p10, p11);
                    *(uint2*)(dst + 16) = make_uint2(p20, p21);
                    if (isk) {
                        bf16_t* kt = Ktb + ((size_t)(tok >> 7) * 1024 + cb + 4 * fq) * 128 + (tok & 127);
                        kt[0 * 128] = (bf16_t)(p10 & 0xffffu); kt[1 * 128] = (bf16_t)(p10 >> 16); kt[2 * 128] = (bf16_t)(p11 & 0xffffu); kt[3 * 128] = (bf16_t)(p11 >> 16);
                        kt[16 * 128] = (bf16_t)(p20 & 0xffffu); kt[17 * 128] = (bf16_t)(p20 >> 16); kt[18 * 128] = (bf16_t)(p21 & 0xffffu); kt[19 * 128] = (bf16_t)(p21 >> 16);
                    }
                }
            }
        }
    }
};
struct Pg8EpiVtBlk {
    static constexpr bool PERM = false, AFTER_DRAIN = false;
    bf16_t* Vt;
    __device__ __forceinline__ void operator()(const pg8::f32x4 (&acc)[2][2][4][2], const pg8::Unit& u, int wr, int wc, int fr, int fq) const {
        const int row0 = u.pm * 256 + wr * 64 + fr, col0 = u.pn * 256 + wc * 32 + 4 * fq;
#pragma unroll
        for (int ai = 0; ai < 2; ++ai)
#pragma unroll
            for (int m = 0; m < 4; ++m) {
                const int row = row0 + ai * 128 + m * 16;
#pragma unroll
                for (int bj = 0; bj < 2; ++bj)
#pragma unroll
                    for (int n = 0; n < 2; ++n) {
                        const int tok0 = col0 + bj * 128 + n * 16;
                        const pg8::f32x4 v = acc[ai][bj][m][n];
                        *(uint2*)(Vt + ((size_t)(tok0 >> 7) * 2048 + row) * 128 + (tok0 & 127)) = make_uint2(pk_bf16(v[0], v[1]), pk_bf16(v[2], v[3]));
                    }
            }
    }
};

struct Pg8SchedMoe1 {
    __device__ bool next(int i, pg8::Unit& u) const {
        int tm, nt;
        if (gridDim.x == 256) { if (!tile_map(i, 384, 8, 4, 8, tm, nt)) return false; }
        else { const int t = blockIdx.x + i * gridDim.x; if (t >= 384 * 8) return false; tm = t >> 3; nt = t & 7; }
        const int e = (tm < 256) ? (tm >> 4) : ((tm - 256) >> 3);
        u.pm = tm; u.pn = e * 8 + nt; return true;
    }
    __device__ __forceinline__ void a_ready(const pg8::Unit&) const {}
    __device__ __forceinline__ void done(const pg8::Unit&) const {}
};
struct Pg8EpiMoe1 {
    static constexpr bool PERM = false, AFTER_DRAIN = false;
    bf16_t* H;
    __device__ __forceinline__ void operator()(const pg8::f32x4 (&acc)[2][2][4][2], const pg8::Unit& u, int wr, int wc, int fr, int fq) const {
        const int row0 = u.pm * 256 + wr * 64 + fr, f0 = (u.pn & 7) * 128 + wc * 16 + 4 * fq;
#pragma unroll
        for (int ai = 0; ai < 2; ++ai)
#pragma unroll
            for (int m = 0; m < 4; ++m) {
                bf16_t* rowp = H + (size_t)(row0 + ai * 128 + m * 16) * 1024 + f0;
#pragma unroll
                for (int bj = 0; bj < 2; ++bj) {
                    const pg8::f32x4 gt = acc[ai][bj][m][0], up = acc[ai][bj][m][1];
                    *(uint2*)(rowp + bj * 64) = make_uint2(pk_bf16(silu_f(gt[0]) * up[0], silu_f(gt[1]) * up[1]), pk_bf16(silu_f(gt[2]) * up[2], silu_f(gt[3]) * up[3]));
                }
            }
    }
};

__device__ __forceinline__ void g5_tiles(const Params& p, int th, char* smem, const int TID, int wid, int nw) {
    char* ws = p.ws;
    const float* xin = (th < 2) ? (p.x_prompt + (size_t)th * T3 * 1024) : p.x_sample;
    pg8::Gemm g; g.A = (const bf16_t*)(ws + R_O); g.Bt = (const bf16_t*)(ws + R_WOUT); g.M = T3; g.N = 1024; g.K = 2048;
    Pg8Sched S; S.MT = 64; S.NTN = 4; S.MS = 8; S.NS = 4; S.wid = wid; S.nw = nw;
    Pg8EpiResid E; E.res = xin; E.dst = p.out + (size_t)th * T3 * 1024;
    pg8::gemm_phase<Pg8EpiResid, Pg8Sched, false>((LAS3 unsigned char*)smem, g, S, E, nullptr, TID);
}

#ifndef ONLY
#define EN(k) 1
#else
#define EN(k) (ONLY == (k))
#endif
__device__ void run_phase(const Params& p, int ph, char* smem, const int TID) {
    const int bid = blockIdx.x, G = gridDim.x;
    char* ws = p.ws;
    if (EN(0) && ph == PH_PRE) {
        int rot = 0;
        convert_matrix(p.ret_w_in, nullptr, 6144, (bf16_t*)(ws + R_WIN), 6144, 1024, 1, smem, rot, TID, bid, G);
        convert_matrix(p.ret_w_out, nullptr, 1024, (bf16_t*)(ws + R_WOUT), 1024, 2048, 0, smem, rot, TID, bid, G);
        for (int th = 0; th < 3; ++th) {
            const float* xs = (th < 2) ? (p.x_prompt + (size_t)th * T3 * 1024) : p.x_sample;
            bf16_t* xd = (bf16_t*)(p.out + (size_t)th * T3 * 1024);
            for (size_t i = (size_t)bid * NT + TID; i < (size_t)T3 * 1024 / 8; i += (size_t)G * NT) {
                const float4 a = ((const float4*)xs)[2 * i], b = ((const float4*)xs)[2 * i + 1];
                ((uint4*)xd)[i] = make_uint4(pk_bf16(a.x, a.y), pk_bf16(a.z, a.w), pk_bf16(b.x, b.y), pk_bf16(b.z, b.w));
            }
        }
#ifdef PROBE_NULLGEMM
        {
            __syncthreads();
            const unsigned long long t0 = wall_clock64();
            PolNull pn; pn.sink = (float*)(ws + R_O);
            gemm_core<PolNull, C256, true>(pn, smem, 1024, TID);
            __syncthreads();
            const unsigned long long t1 = wall_clock64();
            if (bid == 0 && TID == 0) *(unsigned long long*)(ws + R_O + 64) = t1 - t0;
        }
#endif
#ifdef PROBE_SCANTEST
        for (int var = 0; var < 2; ++var) {
            __syncthreads();
            const unsigned long long t0 = wall_clock64();
            if (bid < 64) {
                const int dkt = bid & 1, dvt = (bid >> 1) & 3, dir = (bid >> 3) & 1, h = (bid >> 4) & 3;
                if (var == 0) {
                    PolUscanT<false, true> pol;
                    pol.A = (const bf16_t*)(ws + R_VT) + ((size_t)h * 512 + dvt * 128) * 128; pol.B = (const bf16_t*)(ws + R_KT) + ((size_t)h * 256 + dkt * 128) * 128;
                    pol.UR = (bf16_t*)(ws + R_UR) + (size_t)dir * (128ull * 4 * 512 * 256) + (size_t)h * (512 * 256) + (size_t)(dvt * 128) * 256 + dkt * 128;
                    pol.nc = 128; pol.dir = dir; pol.lg = -0.01f; pol.dec = 0.5f; pol.st = 1.001f; pol.st2 = 1.002f;
                    gemm_core<PolUscanT<false, true>, C128, false>(pol, smem, 256, TID);
                } else {
                    PolUscanT<true, false> pol;
                    pol.A = (const bf16_t*)(ws + R_VT) + ((size_t)h * 512 + dvt * 128) * 128; pol.B = (const bf16_t*)(ws + R_KT) + ((size_t)h * 256 + dkt * 128) * 128;
                    pol.UR = (bf16_t*)(ws + R_UR) + (size_t)dir * (128ull * 4 * 512 * 256) + (size_t)h * (512 * 256) + (size_t)(dvt * 128) * 256 + dkt * 128;
                    pol.nc = 128; pol.dir = dir; pol.lg = -0.01f; pol.dec = 0.5f; pol.st = 1.001f; pol.st2 = 1.002f;
                    gemm_core<PolUscanT<true, false>, C128, false>(pol, smem, 256, TID);
                }
            }
            __syncthreads();
            const unsigned long long t1 = wall_clock64();
            if (bid == 0 && TID == 0) ((unsigned long long*)(ws + R_END - 64))[var] = (var ? 4 : 1) * (t1 - t0);
        }
#endif
#ifdef PROBE_LOADTEST
        for (int var = 0; var < 2; ++var) {
            __syncthreads();
            const unsigned long long t0 = wall_clock64();
            const int lda = var ? 1024 : 1088;
            for (int k = 0, tm, nt; tile_map(k, 384, 4, 8, 4, tm, nt); ++k) {
                PolLoadTest pol; pol.lda = lda; pol.sink = (float*)(ws + M_AFF);
                pol.A = (const bf16_t*)(ws + M_H) + (size_t)(tm * 256) * lda;
                pol.B = (const bf16_t*)(ws + M_WGU) + (size_t)((tm >> 4) * 1024 + nt * 256) * lda;
                gemm_core<PolLoadTest, C256, true, 1, true>(pol, smem, 16, TID);
            }
            __syncthreads();
            const unsigned long long t1 = wall_clock64();
            if (bid == 0 && TID == 0) ((unsigned long long*)(ws + M_AFF + 1024))[var] = t1 - t0;
        }
#endif
        float2* rt = (float2*)(ws + R_ROT);
        for (int i = bid * NT + TID; i < 16384 * 128; i += G * NT) {
            const int s = i >> 7, fi = i & 127;
            const float inv = exp2f(-(float)fi * (13.287712379549449f / 128.0f));
            const float ang = (float)s * inv;
            const double rev = (double)ang * 0.15915494309189535;
            const float fr = (float)(rev - (double)(long long)(rev + 0.5));
            rt[i] = make_float2(__builtin_amdgcn_cosf(fr), __builtin_amdgcn_sinf(fr));
        }
        return;
    }
    if (ph >= PH_R0 && ph < PH_R0 + 15) {
        const int th = (ph - PH_R0) / 5, sub = (ph - PH_R0) % 5;
        const int nseq = (th < 2) ? 8 : 1, nc = (th < 2) ? 16 : 128, smask = (th < 2) ? 2047 : 16383;
        const float* xin = (th < 2) ? (p.x_prompt + (size_t)th * T3 * 1024) : p.x_sample;
        if (EN(1) && sub == 0) {
            const bf16_t* xbt = (const bf16_t*)(p.out + (size_t)th * T3 * 1024);
            const bf16_t* Wt = (const bf16_t*)(ws + R_WIN);
            {
                pg8::Gemm g; g.A = xbt; g.Bt = Wt; g.M = T3; g.N = 2048; g.K = 1024;
                Pg8Sched S; S.MT = 64; S.NTN = 8; S.MS = 4; S.NS = 8; S.wid = bid; S.nw = G;
                Pg8EpiQKrot E; E.ws = ws; E.smask = smask;
                pg8::gemm_phase<Pg8EpiQKrot, Pg8Sched, false>((LAS3 unsigned char*)smem, g, S, E, nullptr, TID);
            }
            {
                pg8::Gemm g; g.A = Wt + (size_t)2048 * 1024; g.Bt = xbt; g.M = 2048; g.N = T3; g.K = 1024;
                Pg8Sched S; S.MT = 8; S.NTN = 64; S.MS = 4; S.NS = 8; S.wid = bid; S.nw = G;
                Pg8EpiVtBlk E; E.Vt = (bf16_t*)(ws + R_VT);
                pg8::gemm_phase<Pg8EpiVtBlk, Pg8Sched, false>((LAS3 unsigned char*)smem, g, S, E, nullptr, TID);
            }
            {
                pg8::Gemm g; g.A = xbt; g.Bt = Wt + (size_t)4096 * 1024; g.M = T3; g.N = 2048; g.K = 1024;
                Pg8Sched S; S.MT = 64; S.NTN = 8; S.MS = 4; S.NS = 8; S.wid = bid; S.nw = G;
                Pg8EpiRows E; E.O = (bf16_t*)(ws + R_G); E.ldc = 2048;
                pg8::gemm_phase<Pg8EpiRows, Pg8Sched, false>((LAS3 unsigned char*)smem, g, S, E, nullptr, TID);
            }
            if (th == 1 && G == 256 && EN(5)) g5_tiles(p, 0, smem, TID, bid, G);
        } else if (EN(2) && sub == 1) {
            const int nscan = nseq * 4 * 2 * 8;
            const int nscore = NCH3 * 4;
            const int ncr = nc / 2;
            if (th == 2 && G == 256 && EN(5)) g5_tiles(p, 1, smem, TID, bid - 64, 192);
            for (int t = bid; t < nscan + nscore; ) {
                if (t < nscan) {
                    int u = t;
                    if (G == 256) {
                        const int k = t >> 8, b = t & 255, x = b & 7, sl = b >> 3;
                        if (nscan >= 256) u = ((k * 32 + x * 4 + (sl >> 3)) << 3) | (sl & 7);
                        else u = (x << 3) | sl;
                    }
                    const int dkt = u & 1; u >>= 1; const int dvt = u & 3; u >>= 2; const int dir = u & 1; u >>= 1; const int h = u & 3; u >>= 2; const int seq = u;
                    PolUscan pol;
                    pol.A = (const bf16_t*)(ws + R_VT) + ((size_t)(seq * nc) * 2048 + h * 512 + dvt * 128) * 128;
                    pol.B = (const bf16_t*)(ws + R_KT) + ((size_t)(seq * nc) * 1024 + h * 256 + dkt * 128) * 128;
                    pol.UR = (bf16_t*)(ws + R_UR) + (size_t)dir * ((size_t)NCH3 * 4 * 512 * 256) + (size_t)(seq * ncr) * (4ull * 512 * 256) + (size_t)h * (512 * 256) + (size_t)(dvt * 128) * 256 + dkt * 128;
                    pol.nc = ncr; pol.dir = dir;
                    pol.lg = log2_sigmoid(p.ret_decay[dir * 4 + h]);
                    pol.dec = exp2f(pol.lg * (float)RC);
                    pol.st = exp2f(dir ? pol.lg : -pol.lg); pol.st2 = pol.st * pol.st;
                    gemm_core<PolUscan, C128, false>(pol, smem, ncr * 4, TID);
                } else {
                    const int u = t - nscan; const int h = u & 3, cgi = u >> 2;
                    PolScore pol;
                    pol.A = (const bf16_t*)(ws + R_Q) + (size_t)(cgi * RC) * 1024 + h * 256;
                    pol.B = (const bf16_t*)(ws + R_K) + (size_t)(cgi * RC) * 1024 + h * 256;
                    pol.P = (bf16_t*)(ws + R_P) + (size_t)((cgi * 4 + h) * RC) * RC;
                    pol.lgf = log2_sigmoid(p.ret_decay[h]); pol.lgb = log2_sigmoid(p.ret_decay[4 + h]); pol.smem = smem;
                    gemm_core<PolScore, C256, false, 1>(pol, smem, 4, TID);
                }
                if (th == 2 && G == 256) t = (t == bid && bid >= 64 && bid < 128) ? bid + 192 : nscan + nscore;
                else t += G;
            }
        } else if (EN(3) && sub == 2) {
            for (int t = bid; t < NCH3 * 2 * 4 * 2; t += G) {
                int u = t;
                if (G == 256) { const int k = t >> 8, b = t & 255, x = b & 7, sl = b >> 3; u = ((k * 64 + x * 8 + (sl >> 2)) << 2) | (sl & 3); }
                const int dvt = u & 1, half = (u >> 1) & 1, h = (u >> 2) & 3, cgi = u >> 4;
                PolO pol;
                pol.half = half;
                pol.Pp = (const bf16_t*)(ws + R_P) + (size_t)((cgi * 4 + h) * RC + half * 128) * RC;
                pol.Qp = (const bf16_t*)(ws + R_Q) + (size_t)(cgi * RC + half * 128) * 1024 + h * 256;
                pol.Vp = (const bf16_t*)(ws + R_VT) + ((size_t)(cgi * 2) * 2048 + h * 512 + dvt * 256) * 128;
                const size_t ro = (size_t)cgi * (4ull * 512 * 256) + (size_t)h * (512 * 256) + (size_t)(dvt * 256) * 256;
                pol.Rf = (const bf16_t*)(ws + R_UR) + ro;
                pol.Rb = (const bf16_t*)(ws + R_UR) + (size_t)NCH3 * 4 * 512 * 256 + ro;
                pol.O = (bf16_t*)(ws + R_O) + (size_t)(cgi * RC + half * 128) * 2048 + h * 512 + dvt * 256;
                pol.lgf = log2_sigmoid(p.ret_decay[h]); pol.lgb = log2_sigmoid(p.ret_decay[4 + h]);
                gemm_core<PolO, CO, false>(pol, smem, 12, TID);
            }
        } else if (EN(4) && sub == 3) {
            const int lane = TID & 63, w = TID >> 6;
            bf16_t* O = (bf16_t*)(ws + R_O); const bf16_t* Gb = (const bf16_t*)(ws + R_G);
            int it = bid * 8 + w;
            uint4 nov = make_uint4(0, 0, 0, 0), ngv = nov;
            if (it < T3 * 4) { nov = *(const uint4*)(O + (size_t)it * 512 + lane * 8); ngv = *(const uint4*)(Gb + (size_t)it * 512 + lane * 8); }
            for (; it < T3 * 4; it += G * 8) {
                const size_t off = (size_t)it * 512 + lane * 8;
                const uint4 ov = nov, gv = ngv;
                if (it + G * 8 < T3 * 4) { nov = *(const uint4*)(O + off + (size_t)G * 8 * 512); ngv = *(const uint4*)(Gb + off + (size_t)G * 8 * 512); }
                float y[8] = {bf_lo(ov.x), bf_hi(ov.x), bf_lo(ov.y), bf_hi(ov.y), bf_lo(ov.z), bf_hi(ov.z), bf_lo(ov.w), bf_hi(ov.w)};
                const float g[8] = {bf_lo(gv.x), bf_hi(gv.x), bf_lo(gv.y), bf_hi(gv.y), bf_lo(gv.z), bf_hi(gv.z), bf_lo(gv.w), bf_hi(gv.w)};
                float s = 0.f;
#pragma unroll
                for (int e = 0; e < 8; ++e) s += y[e];
                const float mu = wave_sum(s) * (1.f / 512.f);
                float q = 0.f;
#pragma unroll
                for (int e = 0; e < 8; ++e) { y[e] -= mu; q += y[e] * y[e]; }
                const float rstd = rsqrtf(wave_sum(q) * (1.f / 512.f) + GN_EPS);
#pragma unroll
                for (int e = 0; e < 8; ++e) y[e] = y[e] * rstd * silu_f(g[e]);
                *(uint4*)(O + off) = make_uint4(pk_bf16(y[0], y[1]), pk_bf16(y[2], y[3]), pk_bf16(y[4], y[5]), pk_bf16(y[6], y[7]));
            }
        } else if (EN(5) && sub == 4) {
            if (th == 2 || G != 256) g5_tiles(p, th, smem, TID, bid, G);
        }
        return;
    }
    if (EN(6) && (ph == PH_LN0A || ph == PH_LN1A)) {
        const int L = (ph == PH_LN1A);
        ln_phase<0, true, true>(p, p.ln_mix_g + L * 1024, p.ln_mix_b + L * 1024, p.w_router + (size_t)L * 1024 * 16, M_XB, smem, TID);
        return;
    }
    if (EN(7) && (ph == PH_TOPK0 || ph == PH_TOPK1)) {
        const int L = (ph == PH_TOPK1);
        topk_phase(p, smem, TID);
        const int wid = (G > 64) ? bid - 32 : bid, nw = (G > 64) ? G - 32 : G;
        int rot = 0;
        for (int e = 0; e < 16; ++e) {
            const size_t wo = ((size_t)L * 16 + e) * 1024 * 1024;
            convert_matrix(p.w_gate + wo, p.w_up + wo, 1024, (bf16_t*)(ws + M_WGU) + (size_t)e * 2048 * 1024, 2048, 1024, 2, smem, rot, TID, wid, nw);
            convert_matrix(p.w_down + wo, nullptr, 1024, (bf16_t*)(ws + M_WD) + (size_t)e * 1024 * 1024, 1024, 1024, 0, smem, rot, TID, wid, nw);
        }
        if (!L) {
            convert_matrix(p.na_w_in, nullptr, 3072, (bf16_t*)(ws + M_NWIN), 3072, 1024, 3, smem, rot, TID, wid, nw);
            convert_matrix(p.na_w_out, nullptr, 1024, (bf16_t*)(ws + M_NWOUT), 1024, 1024, 0, smem, rot, TID, wid, nw);
        }
        return;
    }
    if (EN(8) && (ph == PH_MOE1_0 || ph == PH_MOE1_1)) {
        pg8::Gemm g; g.A = (const bf16_t*)(ws + M_XB); g.Bt = (const bf16_t*)(ws + M_WGU); g.M = 2 * T_ALL; g.N = 16 * 2048; g.K = 1024;
        Pg8SchedMoe1 S; Pg8EpiMoe1 E; E.H = (bf16_t*)(ws + M_H);
        pg8::gemm_phase_gather<Pg8EpiMoe1, Pg8SchedMoe1, false>((LAS3 unsigned char*)smem, g, S, E, nullptr, TID, (const int*)(ws + M_IDX), 16 * CAP_P, T_PROMPT);
        return;
    }
    if (EN(9) && (ph == PH_MOE2_0 || ph == PH_MOE2_1)) {
        if (G == 256) {
            pg8::Gemm g; g.A = (const bf16_t*)(ws + M_H); g.Bt = (const bf16_t*)(ws + M_WD); g.M = 2 * T_ALL; g.N = 16 * 1024; g.K = 1024;
            Pg8SchedMoe2 S; Pg8EpiMoe2 E; E.gate = (const float*)(ws + M_GATE); E.Y = (bf16_t*)(ws + M_YE);
            pg8::gemm_phase<Pg8EpiMoe2, Pg8SchedMoe2, false>((LAS3 unsigned char*)smem, g, S, E, nullptr, TID);
            return;
        }
        for (int k = 0, tm, nt; tile_map(k, 384, 4, 8, 4, tm, nt); ++k) {
            int trunk, e, mt;
            if (tm < 256) { trunk = 0; mt = tm & 15; e = tm >> 4; }
            else { const int u = tm - 256; trunk = 1; mt = u & 7; e = u >> 3; }
            const int cap = trunk ? CAP_S : CAP_P;
            const size_t rb = (trunk ? (size_t)16 * CAP_P : 0) + (size_t)e * cap + mt * 256;
            PolMoe2 pol;
            pol.A = (const bf16_t*)(ws + M_H) + rb * 1024;
            pol.B = (const bf16_t*)(ws + M_WD) + ((size_t)e * 1024 + nt * 256) * 1024;
            pol.gate = (const float*)(ws + M_GATE) + rb;
            pol.Y = (bf16_t*)(ws + M_YE) + rb * 1024 + nt * 256;
            gemm_core_dma<PolMoe2, C256, false>(pol, smem, 16, TID);
        }
        return;
    }
    if (EN(10) && ph == PH_LN0B) { ln_phase<1, true, false>(p, p.ln_ffn_g, p.ln_ffn_b, nullptr, M_XB2, smem, TID); return; }
    if (EN(10) && ph == PH_LN1B) { ln_phase<1, false, false>(p, p.ln_ffn_g + 1024, p.ln_ffn_b + 1024, nullptr, M_XB2, smem, TID); return; }
    if (EN(11) && ph == PH_QKV) {
        {
            pg8::Gemm g; g.A = (const bf16_t*)(ws + M_XB2); g.Bt = (const bf16_t*)(ws + M_NWIN); g.M = T_ALL; g.N = 2048; g.K = 1024;
            Pg8Sched S; S.MT = 192; S.NTN = 8; S.MS = 4; S.NS = 8; S.wid = bid; S.nw = G;
            Pg8EpiQK E; E.ws = ws;
            pg8::gemm_phase<Pg8EpiQK, Pg8Sched, false>((LAS3 unsigned char*)smem, g, S, E, nullptr, TID);
        }
        {
            pg8::Gemm g; g.A = (const bf16_t*)(ws + M_NWIN) + (size_t)2048 * 1024; g.Bt = (const bf16_t*)(ws + M_XB2); g.M = 1024; g.N = T_ALL; g.K = 1024;
            Pg8Sched S; S.MT = 4; S.NTN = 192; S.MS = 4; S.NS = 8; S.wid = bid; S.nw = G;
            Pg8EpiRows E; E.O = (bf16_t*)(ws + N_VT); E.ldc = T_ALL;
            pg8::gemm_phase<Pg8EpiRows, Pg8Sched, false>((LAS3 unsigned char*)smem, g, S, E, nullptr, TID);
        }
        return;
    }
    if (EN(12) && ph == PH_NA) { na_phase(p, smem, TID); return; }
    if (EN(13) && ph == PH_NAOUT) {
        pg8::Gemm g; g.A = (const bf16_t*)(ws + M_XB2); g.Bt = (const bf16_t*)(ws + M_NWOUT); g.M = T_ALL; g.N = 1024; g.K = 1024;
        Pg8Sched S; S.MT = 192; S.NTN = 4; S.MS = 8; S.NS = 4; S.wid = bid; S.nw = G;
        Pg8EpiResid E; E.res = p.out; E.dst = p.out;
        pg8::gemm_phase<Pg8EpiResid, Pg8Sched, false>((LAS3 unsigned char*)smem, g, S, E, nullptr, TID);
        return;
    }
}

__device__ __forceinline__ int lane_id_opaque() {
    int l;
    asm volatile("v_mbcnt_lo_u32_b32 %0, -1, 0\n\tv_mbcnt_hi_u32_b32 %0, -1, %0" : "=v"(l));
    return l;
}

__global__ void __launch_bounds__(512, 2) fwd_megakernel(Params p) {
    extern __shared__ __attribute__((aligned(16))) char smem_dyn[];
    char* smem = smem_dyn;
    cg::grid_group grid = cg::this_grid();
    const int wave_id = __builtin_amdgcn_readfirstlane((int)(threadIdx.x >> 6));
#define MK_TID() ((wave_id << 6) | lane_id_opaque())
    if (MK_TID() == 0) *(uint4*)(smem_dyn + 131072) = make_uint4(0u, 0u, 0u, 0u);
    __syncthreads();
    (void)xcd_barrier_post((unsigned*)(p.ws + BAR_OFF), (volatile LAS3 unsigned*)(smem_dyn + 131072), MK_TID());
#ifdef PROBE_MASK
    unsigned long long t_prev = wall_clock64(), t_acc = 0, t_accb = 0, t_null = 0, t_sync = 0, t_syncb = 0;
#endif
    for (int ph = p.ph_lo; ph < p.ph_hi; ++ph) {
        Params q = p;
        {
            size_t z = 0;
            asm volatile("" : "+s"(z));
            q.ws = p.ws + z; q.out = p.out + z; q.x_prompt = p.x_prompt + z; q.x_sample = p.x_sample + z; q.ret_decay = p.ret_decay + z;
            q.w_gate = p.w_gate + z; q.w_up = p.w_up + z; q.w_down = p.w_down + z;
        }
        int phv = ph;
        asm volatile("" : "+s"(phv));
        int tidv = MK_TID();
        asm volatile("" : "+v"(tidv));
        const bool empty_ph = (gridDim.x == 256) && (ph == PH_R0 + 4 || ph == PH_R0 + 9);
        if (empty_ph) continue;
        run_phase(q, phv, smem, tidv);
#ifdef PROBE_MASK
        const unsigned long long t_s0 = wall_clock64();
#endif
        if (ph + 1 < p.ph_hi) { if (ph == p.ph_lo) grid.sync(); else { XcdBarrier xb; xb.bar = (unsigned*)(p.ws + BAR_OFF); xb.x = xb_xcc_id(); xb.st = (volatile LAS3 unsigned*)(smem_dyn + 131072); xcd_barrier(xb, MK_TID()); } }
#ifdef PROBE_MASK
        { const unsigned long long dt_ = wall_clock64() - t_s0; if ((PROBE_MASK >> ph) & 1ull) t_sync += dt_; else t_syncb += dt_; }
#endif
#ifdef PROBE_MASK
#if defined(PROBE_LOADTEST) || defined(PROBE_SCANTEST)
        if (ph == 0 && blockIdx.x == 0 && threadIdx.x == 0) { t_acc = ((volatile unsigned long long*)(p.ws + R_END - 64))[0]; t_accb = ((volatile unsigned long long*)(p.ws + R_END - 64))[1]; }
#endif
        { const unsigned long long t_now = wall_clock64(); if ((PROBE_MASK >> ph) & 1ull) t_acc += t_now - t_prev; if ((PROBE_MASK_B >> ph) & 1ull) t_accb += t_now - t_prev; t_prev = t_now; }
#endif
    }
#ifdef PROBE_MASK
    if (blockIdx.x == 0 && threadIdx.x == 0) {
        const float v = (float)t_sync * 0.001f, vb = (float)t_syncb * 0.001f;
        p.out[5] += sqrtf(v);
        p.out[1024 + 5] += sqrtf(vb);
    }
#endif
}

extern "C" void kernel_launch(void* const* d_in, const int* in_sizes, int n_in, void* d_out, int out_size, void* d_ws, size_t ws_size, hipStream_t stream) {
    static int grid_blocks = 0;
    if (!grid_blocks) {
        int dev = 0, cus = 0, per_cu = 0;
        (void)hipGetDevice(&dev);
        (void)hipDeviceGetAttribute(&cus, hipDeviceAttributeMultiprocessorCount, dev);
        (void)hipFuncSetAttribute((const void*)fwd_megakernel, hipFuncAttributeMaxDynamicSharedMemorySize, LDS_BYTES);
        (void)hipOccupancyMaxActiveBlocksPerMultiprocessor(&per_cu, fwd_megakernel, NT, LDS_BYTES);
        if (per_cu < 1) per_cu = 1;
        if (per_cu > 1) per_cu = 1;
        grid_blocks = cus * per_cu;
        if (ws_size < R_END || ws_size < M_END) fprintf(stderr, "kernel_launch: workspace too small: %zu < %zu\n", ws_size, (size_t)(R_END > M_END ? R_END : M_END));
    }
    if (ws_size < R_END || ws_size < M_END || ws_size < BAR_END || R_END > BAR_OFF || M_END > BAR_OFF) return;
    (void)hipMemsetAsync((char*)d_ws + BAR_OFF, 0, 16384, stream);
    Params p{};
    p.x_prompt = (const float*)d_in[0]; p.x_sample = (const float*)d_in[1]; p.ret_w_in = (const float*)d_in[2]; p.ret_decay = (const float*)d_in[3];
    p.ret_w_out = (const float*)d_in[4]; p.na_w_in = (const float*)d_in[5]; p.na_rpb = (const float*)d_in[6]; p.na_w_out = (const float*)d_in[7];
    p.ln_mix_g = (const float*)d_in[8]; p.ln_mix_b = (const float*)d_in[9]; p.ln_ffn_g = (const float*)d_in[10]; p.ln_ffn_b = (const float*)d_in[11];
    p.w_router = (const float*)d_in[12]; p.w_gate = (const float*)d_in[13]; p.w_up = (const float*)d_in[14]; p.w_down = (const float*)d_in[15];
    p.out = (float*)d_out; p.ws = (char*)d_ws; p.ph_lo = 0; p.ph_hi = PH_COUNT;
    void* args[] = {&p};
    hipError_t e = hipLaunchCooperativeKernel((void*)fwd_megakernel, dim3(grid_blocks), dim3(NT), args, LDS_BYTES, stream);
    if (e != hipSuccess) fprintf(stderr, "cooperative launch failed: %s (grid %d)\n", hipGetErrorString(e), grid_blocks);
}
```
